# Optimizing an MI355X kernel written in HIP

```python
import jax, jax.numpy as jnp
from jax import lax
import numpy as np

D_MODEL = 1024
BATCH = 8
SEQ = 4096
DEPTH = 2

HEAD_DIM = 64
ROPE_THETA = 10000.0
NORM_EPS = 1e-6
N_BRANCH = 4
BRANCH_W = 4 * HEAD_DIM

A_HEADS = 4
A_BLOCK = 256
A_TOPK = 3
B_HEADS = 4
B_CMP_LEN = 32
B_CMP_STRIDE = 16
B_CMP_HIDDEN = 256
B_SLC_LEN = 64
B_SLC_TOPN = 16
B_WINDOW = 512
C_HEADS = 4
D_HEADS = 4
D_PATTERNS = ((128, 1), (512, 4), (2048, 16))

GATHER_QBLOCK = 32
DENSE_QBLOCK = 128

IN_SIZES = (
    BRANCH_W, BRANCH_W, BRANCH_W, BRANCH_W,
    BRANCH_W, 6 * HEAD_DIM, BRANCH_W, 3 * B_HEADS,
    3 * BRANCH_W, BRANCH_W,
    3 * len(D_PATTERNS) * D_HEADS * HEAD_DIM, BRANCH_W,
    N_BRANCH * D_MODEL,
)
IN_WIDTH = sum(IN_SIZES)

kernel_name = 'hybrid_moba_nsa_stickbreak_dilated'


def _rmsnorm(x, w):
    xf = x.astype(jnp.float32)
    y = xf * lax.rsqrt(jnp.mean(xf * xf, axis=-1, keepdims=True) + NORM_EPS)
    return (y * w.astype(jnp.float32)).astype(x.dtype)


def _rope(x, pos):
    half = HEAD_DIM // 2
    inv = ROPE_THETA ** (-jnp.arange(half, dtype=jnp.float32) / half)
    ang = pos.astype(jnp.float32)[:, None] * inv[None, :]
    cos = jnp.cos(ang).astype(x.dtype)
    sin = jnp.sin(ang).astype(x.dtype)
    x1, x2 = x[..., :half], x[..., half:]
    return jnp.concatenate([x1 * cos - x2 * sin, x1 * sin + x2 * cos], axis=-1)


def _heads(x, n):
    b, s = x.shape[:2]
    return x.reshape(b, s, n, HEAD_DIM).transpose(0, 2, 1, 3)


def _merge_heads(x):
    b, h, s, d = x.shape
    return x.transpose(0, 2, 1, 3).reshape(b, s, h * d)


def _masked_softmax(s, mask):
    s = jnp.where(mask, s, -jnp.inf)
    mx = jnp.max(s, axis=-1, keepdims=True)
    mx = jnp.where(jnp.isfinite(mx), mx, 0.0)
    e = jnp.where(mask, jnp.exp(s - mx), 0.0)
    den = jnp.maximum(jnp.sum(e, axis=-1, keepdims=True), 1e-30)
    return e / den, (mx + jnp.log(den))[..., 0]


def _unblock(y):
    nb, b, h, qb, d = y.shape
    return jnp.moveaxis(y, 0, 2).reshape(b, h, nb * qb, d)


def _banded_attention(q, k, v, window):
    b, h, L, d = q.shape
    hk = k.shape[1]
    g = h // hk
    qb = min(DENSE_QBLOCK, L)
    nblk = -(-L // qb)
    lp = nblk * qb
    q = jnp.pad(q, ((0, 0), (0, 0), (0, lp - L), (0, 0))).reshape(b, hk, g, lp, d)
    kpad = ((0, 0), (0, 0), (window, lp - L), (0, 0))
    k = jnp.pad(k, kpad)
    v = jnp.pad(v, kpad)
    span = window + qb
    scale = d ** -0.5

    def block(q0):
        qs = lax.dynamic_slice_in_dim(q, q0, qb, axis=3)
        ks = lax.dynamic_slice_in_dim(k, q0, span, axis=2)
        vs = lax.dynamic_slice_in_dim(v, q0, span, axis=2)
        s = jnp.einsum('bhgqd,bhkd->bhgqk', qs, ks, preferred_element_type=jnp.float32) * scale
        tq = q0 + jnp.arange(qb)
        tk = q0 - window + jnp.arange(span)
        dist = tq[:, None] - tk[None, :]
        mask = (dist >= 0) & (dist <= window) & (tk[None, :] >= 0)
        p, lse = _masked_softmax(s, mask)
        return jnp.einsum('bhgqk,bhkd->bhgqd', p.astype(vs.dtype), vs), lse

    o, lse = lax.map(block, jnp.arange(nblk) * qb)
    o = jnp.moveaxis(o, 0, 3).reshape(b, h, lp, d)[:, :, :L]
    lse = jnp.moveaxis(lse, 0, 3).reshape(b, h, lp)[:, :, :L]
    return o, lse


def _moba_attention(q, k, v):
    b, h, S, d = q.shape
    nb = -(-S // A_BLOCK)
    sp = nb * A_BLOCK
    pad = ((0, 0), (0, 0), (0, sp - S), (0, 0))
    k = jnp.pad(k, pad)
    v = jnp.pad(v, pad)
    kb = k.reshape(b, h, nb, A_BLOCK, d)
    vb = v.reshape(b, h, nb, A_BLOCK, d)
    k_mean = jnp.mean(kb.astype(jnp.float32), axis=3)
    gate = jnp.einsum('bhsd,bhnd->bhsn', q.astype(jnp.float32), k_mean)
    past = jnp.arange(nb)[None, :] < (jnp.arange(S) // A_BLOCK)[:, None]
    gate = jnp.where(past, gate, -jnp.inf)
    top_score, top_idx = lax.top_k(gate, min(A_TOPK, nb))
    top_ok = top_score > -jnp.inf
    topk = top_idx.shape[-1]
    n_sel = topk * A_BLOCK
    scale = d ** -0.5
    pick = jax.vmap(jax.vmap(lambda blocks, i: blocks[i]))

    def block(q0):
        qs = lax.dynamic_slice_in_dim(q, q0, GATHER_QBLOCK, axis=2)
        ids = lax.dynamic_slice_in_dim(top_idx, q0, GATHER_QBLOCK, axis=2)
        ok = lax.dynamic_slice_in_dim(top_ok, q0, GATHER_QBLOCK, axis=2)
        k_sel = pick(kb, ids).reshape(b, h, GATHER_QBLOCK, n_sel, d)
        v_sel = pick(vb, ids).reshape(b, h, GATHER_QBLOCK, n_sel, d)
        own0 = (q0 // A_BLOCK) * A_BLOCK
        k_own = lax.dynamic_slice_in_dim(k, own0, A_BLOCK, axis=2)
        v_own = lax.dynamic_slice_in_dim(v, own0, A_BLOCK, axis=2)
        tq = q0 + jnp.arange(GATHER_QBLOCK)
        tk = own0 + jnp.arange(A_BLOCK)
        s_sel = jnp.einsum('bhqd,bhqkd->bhqk', qs, k_sel, preferred_element_type=jnp.float32) * scale
        s_own = jnp.einsum('bhqd,bhkd->bhqk', qs, k_own, preferred_element_type=jnp.float32) * scale
        s = jnp.concatenate([s_sel, s_own], axis=-1)
        mask = jnp.concatenate([
            jnp.repeat(ok, A_BLOCK, axis=-1),
            jnp.broadcast_to(tk[None, :] <= tq[:, None], s_own.shape)], axis=-1)
        p, _ = _masked_softmax(s, mask)
        p = p.astype(v.dtype)
        return (jnp.einsum('bhqk,bhqkd->bhqd', p[..., :n_sel], v_sel)
                + jnp.einsum('bhqk,bhkd->bhqd', p[..., n_sel:], v_own))

    return _unblock(lax.map(block, jnp.arange(S // GATHER_QBLOCK) * GATHER_QBLOCK))


def _nsa_attention(q, kv, gates, cmp_pos, cmp_w1, cmp_w2, pos):
    b, h, S, d = q.shape
    scale = d ** -0.5
    k_c, v_c, k_s, v_s, k_w, v_w = [kv[:, :, i] for i in range(6)]
    q_rot = _rope(q, pos)
    k_s = _rope(k_s, pos)
    k_w = _rope(k_w, pos)

    nc = (S - B_CMP_LEN) // B_CMP_STRIDE + 1
    starts = np.arange(nc) * B_CMP_STRIDE
    gidx = starts[:, None] + np.arange(B_CMP_LEN)[None, :]

    def compress(x, pe, w1, w2):
        blocks = (x[:, gidx] + pe).reshape(b, nc, B_CMP_LEN * d)
        return jax.nn.gelu(blocks @ w1) @ w2

    k_cmp = compress(k_c, cmp_pos[0], cmp_w1[0], cmp_w2[0])
    v_cmp = compress(v_c, cmp_pos[1], cmp_w1[1], cmp_w2[1])
    s_cmp = jnp.einsum('bhsd,bnd->bhsn', q, k_cmp, preferred_element_type=jnp.float32) * scale
    vis = jnp.asarray(starts + B_CMP_LEN - 1)[None, :] <= pos[:, None]
    p_cmp, _ = _masked_softmax(s_cmp, vis)
    o_cmp = jnp.einsum('bhsn,bnd->bhsd', p_cmp.astype(v_cmp.dtype), v_cmp)

    nsel = S // B_SLC_LEN
    j = np.arange(nsel)
    overlap = ((starts[:, None] < (j[None, :] + 1) * B_SLC_LEN)
               & (starts[:, None] + B_CMP_LEN > j[None, :] * B_SLC_LEN)).astype(np.float32)
    imp = jnp.einsum('bhsn,nj->bsj', p_cmp, jnp.asarray(overlap))
    cur = (pos // B_SLC_LEN)[:, None]
    jj = jnp.arange(nsel)[None, :]
    forced = (jj == 0) | (jj == cur) | (jj == cur - 1)
    imp = jnp.where(jj <= cur, jnp.where(forced, jnp.inf, imp), -jnp.inf)
    top_score, top_idx = lax.top_k(imp, min(B_SLC_TOPN, nsel))
    top_ok = top_score > -jnp.inf
    topn = top_idx.shape[-1]
    n_key = topn * B_SLC_LEN
    ksb = k_s.reshape(b, nsel, B_SLC_LEN, d)
    vsb = v_s.reshape(b, nsel, B_SLC_LEN, d)
    pick = jax.vmap(lambda blocks, i: blocks[i])

    def block(q0):
        qs = lax.dynamic_slice_in_dim(q_rot, q0, GATHER_QBLOCK, axis=2)
        ids = lax.dynamic_slice_in_dim(top_idx, q0, GATHER_QBLOCK, axis=1)
        ok = lax.dynamic_slice_in_dim(top_ok, q0, GATHER_QBLOCK, axis=1)
        kg = pick(ksb, ids).reshape(b, GATHER_QBLOCK, n_key, d)
        vg = pick(vsb, ids).reshape(b, GATHER_QBLOCK, n_key, d)
        tk = (ids[..., None] * B_SLC_LEN + jnp.arange(B_SLC_LEN)).reshape(b, GATHER_QBLOCK, n_key)
        tq = q0 + jnp.arange(GATHER_QBLOCK)
        mask = jnp.repeat(ok, B_SLC_LEN, axis=-1) & (tk <= tq[None, :, None])
        s = jnp.einsum('bhqd,bqkd->bhqk', qs, kg, preferred_element_type=jnp.float32) * scale
        p, _ = _masked_softmax(s, mask[:, None])
        return jnp.einsum('bhqk,bqkd->bhqd', p.astype(vg.dtype), vg)

    o_slc = _unblock(lax.map(block, jnp.arange(S // GATHER_QBLOCK) * GATHER_QBLOCK))

    o_win, _ = _banded_attention(q_rot, k_w[:, None], v_w[:, None], B_WINDOW - 1)
    return gates[0] * o_cmp + gates[1] * o_slc + gates[2] * o_win


def _stick_breaking_attention(q, k, v):
    b, h, S, d = q.shape
    scale = d ** -0.5
    outs = []
    for i in range(S // DENSE_QBLOCK):
        q0, end = i * DENSE_QBLOCK, (i + 1) * DENSE_QBLOCK
        z = jnp.einsum('bhqd,bhkd->bhqk', q[:, :, q0:end], k[:, :, :end],
                       preferred_element_type=jnp.float32) * scale
        tq = q0 + jnp.arange(DENSE_QBLOCK)
        causal = jnp.arange(end)[None, :] < tq[:, None]
        log_1m = jnp.where(causal, jax.nn.log_sigmoid(-z), 0.0)
        tail = lax.cumsum(log_1m, axis=3, reverse=True) - log_1m
        a = jnp.where(causal, jnp.exp(jax.nn.log_sigmoid(z) + tail), 0.0)
        outs.append(jnp.einsum('bhqk,bhkd->bhqd', a.astype(v.dtype), v[:, :, :end]))
    return jnp.concatenate(outs, axis=2)


def _to_sub(x, dil):
    b, h, S, d = x.shape
    return x.reshape(b, h, S // dil, dil, d).transpose(0, 1, 3, 2, 4).reshape(b, h * dil, S // dil, d)


def _dilated_attention(q, k, v):
    b, _, S, d = q.shape
    outs, lses = [], []
    for g, (window, dil) in enumerate(D_PATTERNS):
        sl = slice(g * D_HEADS, (g + 1) * D_HEADS)
        L = S // dil
        o, lse = _banded_attention(_to_sub(q[:, sl], dil), _to_sub(k[:, sl], dil),
                                   _to_sub(v[:, sl], dil), window // dil)
        outs.append(o.reshape(b, D_HEADS, dil, L, d).transpose(0, 1, 3, 2, 4).reshape(b, D_HEADS, S, d))
        lses.append(lse.reshape(b, D_HEADS, dil, L).transpose(0, 1, 3, 2).reshape(b, D_HEADS, S))
    w = jax.nn.softmax(jnp.stack(lses), axis=0)
    return jnp.einsum('gbhs,gbhsd->bhsd', w.astype(q.dtype), jnp.stack(outs))


def _hybrid_layer(x, norm_w, w_in, cmp_pos, cmp_w1, cmp_w2, w_up, w_out):
    b, S, _ = x.shape
    pos = jnp.arange(S)
    h = _rmsnorm(x, norm_w)
    proj = jnp.einsum('bsd,dc->bsc', h, w_in)
    (qa, ka, va, ga, qb, kvb, gb, nsa_g, qkvc, gc, qkvd, gd, merge) = jnp.split(
        proj, np.cumsum(IN_SIZES)[:-1].tolist(), axis=-1)

    o_a = _moba_attention(_rope(_heads(qa, A_HEADS), pos), _rope(_heads(ka, A_HEADS), pos),
                          _heads(va, A_HEADS))

    nsa_gates = jax.nn.sigmoid(nsa_g.astype(jnp.float32)).reshape(b, S, 3, B_HEADS)
    nsa_gates = nsa_gates.transpose(2, 0, 3, 1)[..., None].astype(x.dtype)
    o_b = _nsa_attention(_heads(qb, B_HEADS), kvb.reshape(b, S, 6, HEAD_DIM), nsa_gates,
                         cmp_pos, cmp_w1, cmp_w2, pos)

    qc, kc, vc = jnp.split(qkvc, 3, axis=-1)
    o_c = _stick_breaking_attention(_heads(qc, C_HEADS), _heads(kc, C_HEADS), _heads(vc, C_HEADS))

    n_d = len(D_PATTERNS) * D_HEADS
    qd, kd, vd = jnp.split(qkvd, 3, axis=-1)
    o_d = _dilated_attention(_rope(_heads(qd, n_d), pos), _rope(_heads(kd, n_d), pos), _heads(vd, n_d))

    widened = jnp.stack([_merge_heads(o_a) * jax.nn.silu(ga), _merge_heads(o_b) * jax.nn.silu(gb),
                         _merge_heads(o_c) * jax.nn.silu(gc), _merge_heads(o_d) * jax.nn.silu(gd)],
                        axis=2)
    u = jnp.einsum('bsiw,iwd->bsid', widened, w_up)
    merge_g = jax.nn.sigmoid(merge.astype(jnp.float32)).astype(x.dtype).reshape(b, S, N_BRANCH, D_MODEL)
    y = jnp.sum(merge_g * u, axis=2)
    return x + y @ w_out


def setup_inputs(seed: int = 0) -> dict:
    key = jax.random.key(seed)
    ks = jax.random.split(key, 9)
    f32 = jnp.float32
    x = jax.random.normal(ks[0], (BATCH, SEQ, D_MODEL), f32)
    norm_w = 1.0 + 0.02 * jax.random.normal(ks[1], (DEPTH, D_MODEL), f32)
    w_in = jax.random.normal(ks[2], (DEPTH, D_MODEL, IN_WIDTH), f32) * D_MODEL ** -0.5
    nsa_cmp_pos = 0.02 * jax.random.normal(ks[3], (DEPTH, 2, B_CMP_LEN, HEAD_DIM), f32)
    nsa_cmp_w1 = jax.random.normal(ks[4], (DEPTH, 2, B_CMP_LEN * HEAD_DIM, B_CMP_HIDDEN), f32) * (B_CMP_LEN * HEAD_DIM) ** -0.5
    nsa_cmp_w2 = jax.random.normal(ks[5], (DEPTH, 2, B_CMP_HIDDEN, HEAD_DIM), f32) * B_CMP_HIDDEN ** -0.5
    w_up = jax.random.normal(ks[6], (DEPTH, N_BRANCH, BRANCH_W, D_MODEL), f32) * BRANCH_W ** -0.5
    w_out = jax.random.normal(ks[7], (DEPTH, D_MODEL, D_MODEL), f32) * D_MODEL ** -0.5
    final_norm_w = 1.0 + 0.02 * jax.random.normal(ks[8], (D_MODEL,), f32)
    return {'x': x, 'norm_w': norm_w, 'w_in': w_in, 'nsa_cmp_pos': nsa_cmp_pos,
            'nsa_cmp_w1': nsa_cmp_w1, 'nsa_cmp_w2': nsa_cmp_w2, 'w_up': w_up,
            'w_out': w_out, 'final_norm_w': final_norm_w}


def reference(x, norm_w, w_in, nsa_cmp_pos, nsa_cmp_w1, nsa_cmp_w2, w_up, w_out, final_norm_w):
    for layer in range(DEPTH):
        x = _hybrid_layer(x, norm_w[layer], w_in[layer], nsa_cmp_pos[layer], nsa_cmp_w1[layer],
                          nsa_cmp_w2[layer], w_up[layer], w_out[layer])
    return _rmsnorm(x, final_norm_w)
```

```cpp
#include <hip/hip_runtime.h>
#include <hip/hip_cooperative_groups.h>
#include <cstdio>
#include <cstdint>
namespace cg = cooperative_groups;
namespace pg8 {
#define PG8_LAS __attribute__((address_space(3)))
typedef unsigned short bf16_t;
typedef short bf16x8 __attribute__((ext_vector_type(8)));
typedef float f32x4 __attribute__((ext_vector_type(4)));
typedef unsigned u32x4 __attribute__((ext_vector_type(4)));
constexpr int BM = 256, BK = 64, HALF = 128, HTB = HALF * BK * 2  , STAGE_BYTES = 8 * HTB, NXCD = 8, WGM = 8;

__host__ __device__ __forceinline__ int lds_byte(int r, int c) { const int st = (r >> 4) * 2 + (c >> 5), rr = r & 15, cc = c & 31, ob = rr * 64 + cc * 2; return st * 1024 + (ob ^ (((ob >> 9) & 1) << 5)); }
__host__ __device__ __forceinline__ void stage_rc(int b, int& R, int& C) { const int st = b / 1024, sb = b % 1024, swz = sb ^ (((sb >> 9) & 1) << 5); R = (st >> 1) * 16 + swz / 64; C = (st & 1) * 32 + (swz % 64) / 2; }
__host__ __device__ __forceinline__ int perm32(int rho) { const int n = rho >> 4, i = rho & 15; return 8 * (i >> 2) + 4 * n + (i & 3); }

struct Unit { int pm, pn; };
struct Gemm { const bf16_t* A; const bf16_t* Bt; int M, N, K; };

struct StaticOrder {
    int nM, nN, nwg, G, c;
    __host__ __device__ void init(int M, int N, int G_, int c_) { nM = M / BM; nN = N / BM; nwg = nM * nN; G = G_; c = c_; }
    __host__ __device__ bool next(int i, Unit& u) const {
        const long L = (long)i * G + c; if (L >= nwg) return false;
        int wgid = (int)L; { const int q = nwg / NXCD, r = nwg % NXCD, xcd = wgid % NXCD, off = wgid / NXCD; wgid = (xcd < r ? xcd * (q + 1) : r * (q + 1) + (xcd - r) * q) + off; }
        const int nig = WGM * nN, gid = wgid / nig, fm = gid * WGM, gsz = (nM - fm) < WGM ? (nM - fm) : WGM;
        u.pm = fm + ((wgid % nig) % gsz); u.pn = (wgid % nig) / gsz; return true;
    }
    __device__ __forceinline__ void a_ready(const Unit&) const {}
    __device__ __forceinline__ void done(const Unit&) const {}
};

__device__ __forceinline__ unsigned cvt_pk_bf16(float lo, float hi) { unsigned r; asm volatile("v_cvt_pk_bf16_f32 %0, %1, %2" : "=v"(r) : "v"(lo), "v"(hi)); return r; }
template <class Epi, class Sched, bool ALIGN_EPI = false, bool SP2 = false>
__device__ __forceinline__ void gemm_phase(PG8_LAS unsigned char* lds, const Gemm g, const Sched& S, const Epi& E) {
    const int tid = threadIdx.x, wid = __builtin_amdgcn_readfirstlane(tid >> 6), lane = tid & 63, wr = wid >> 2, wc = wid & 3, fr = lane & 15, fq = lane >> 4;
    const int K = g.K, nt = K / BK;
    unsigned voffA[2], voffB[2];
#pragma unroll
    for (int i = 0; i < 2; ++i) { int R, C; stage_rc(tid * 16 + i * 8192, R, C); const int Rb = Epi::PERM ? ((R & ~31) + perm32(R & 31)) : R;
        voffA[i] = (unsigned)(R * K + C) * 2u; voffB[i] = (unsigned)(Rb * K + C) * 2u; }
    const size_t kstep = (size_t)(BK * 2);
    const size_t hstep = (size_t)HALF * K * 2;
    const size_t tstep = 2 * hstep;
    const unsigned ldsw = (unsigned)wid * 1024u;
    const int aoff = lds_byte(wr * 64 + fr, fq * 8), boff = lds_byte(wc * 32 + fr, fq * 8);
#define PG8_SA(b, h) (((b) * 2 + (h)) * HTB)
#define PG8_SB(b, h) ((4 + (b) * 2 + (h)) * HTB)
#define PG8_STAGE(bufoff, gbase, voff) do { _Pragma("unroll") for (int _i = 0; _i < 2; ++_i) \
        __builtin_amdgcn_global_load_lds((const unsigned*)((const char*)(gbase) + (voff)[_i]), (PG8_LAS unsigned*)(lds + (bufoff) + ldsw + _i * 8192), 16, 0, 0); } while (0)
#define PG8_LDA(dst, b, h) do { _Pragma("unroll") for (int m = 0; m < 4; ++m) _Pragma("unroll") for (int k = 0; k < 2; ++k) dst[m][k] = *(const PG8_LAS bf16x8*)(lds + PG8_SA(b, h) + aoff + m * 2048 + k * 1024); } while (0)
#define PG8_LDB(dst, b, h) do { _Pragma("unroll") for (int n = 0; n < 2; ++n) _Pragma("unroll") for (int k = 0; k < 2; ++k) dst[n][k] = *(const PG8_LAS bf16x8*)(lds + PG8_SB(b, h) + boff + n * 2048 + k * 1024); } while (0)
#define PG8_MMA(ai, bj, At, Bt) do { __builtin_amdgcn_s_setprio(1); _Pragma("unroll") for (int m = 0; m < 4; ++m) _Pragma("unroll") for (int n = 0; n < 2; ++n) _Pragma("unroll") for (int k = 0; k < 2; ++k) \
        acc[ai][bj][m][n] = __builtin_amdgcn_mfma_f32_16x16x32_bf16(Bt[n][k], At[m][k], acc[ai][bj][m][n], 0, 0, 0); __builtin_amdgcn_s_setprio(0); } while (0)
#define PG8_WAIT_V(n) asm volatile("s_waitcnt vmcnt(" #n ")" ::: "memory")
#define PG8_WAIT_L(n) asm volatile("s_waitcnt lgkmcnt(" #n ")" ::: "memory")
#define PG8_BAR __builtin_amdgcn_s_barrier()
#define PG8_SCHED __builtin_amdgcn_sched_barrier(0)
    Unit cur, nxt; int ui = 0;
    if (!S.next(0, cur)) return;
    f32x4 acc[2][2][4][2];
#pragma unroll
    for (int a = 0; a < 2; ++a)
#pragma unroll
        for (int b = 0; b < 2; ++b)
#pragma unroll
            for (int m = 0; m < 4; ++m)
#pragma unroll
                for (int n = 0; n < 2; ++n) acc[a][b][m][n] = (f32x4){0.f, 0.f, 0.f, 0.f};
    bf16x8 At[4][2], B0[2][2], B1[2][2];
    const char* cA = (const char*)g.A + (size_t)cur.pm * tstep; const char* cB = (const char*)g.Bt + (size_t)cur.pn * tstep;
    S.a_ready(cur);
    if constexpr (SP2) {
        PG8_STAGE(PG8_SB(0, 0), cB, voffB); PG8_STAGE(PG8_SB(0, 1), cB + hstep, voffB); PG8_STAGE(PG8_SA(0, 0), cA, voffA); PG8_STAGE(PG8_SA(0, 1), cA + hstep, voffA);
        if (wr == 1) PG8_BAR;
        PG8_WAIT_V(2); PG8_BAR;
        PG8_STAGE(PG8_SB(1, 0), cB + kstep, voffB); PG8_STAGE(PG8_SA(1, 0), cA + kstep, voffA); PG8_STAGE(PG8_SB(1, 1), cB + hstep + kstep, voffB);
        PG8_WAIT_V(6); PG8_BAR;
    } else {
        PG8_STAGE(PG8_SB(0, 0), cB, voffB); PG8_STAGE(PG8_SA(0, 0), cA, voffA); PG8_STAGE(PG8_SB(0, 1), cB + hstep, voffB); PG8_STAGE(PG8_SA(0, 1), cA + hstep, voffA);
        if (wr == 1) PG8_BAR;
        PG8_WAIT_V(4); PG8_BAR;
        PG8_STAGE(PG8_SB(1, 0), cB + kstep, voffB); PG8_STAGE(PG8_SA(1, 0), cA + kstep, voffA); PG8_STAGE(PG8_SB(1, 1), cB + hstep + kstep, voffB);
        PG8_WAIT_V(6); PG8_BAR;
    }
    for (;;) {
        const bool has_next = S.next(ui + 1, nxt);
        const char* nA = has_next ? (const char*)g.A + (size_t)nxt.pm * tstep : cA; const char* nB = has_next ? (const char*)g.Bt + (size_t)nxt.pn * tstep : cB;
        for (int t = 0; t < nt; t += 2) {
            const bool last = (t == nt - 2);
            const char* a1 = cA + (size_t)(t + 1) * kstep;
            const char* a2 = last ? nA : cA + (size_t)(t + 2) * kstep; const char* b2 = last ? nB : cB + (size_t)(t + 2) * kstep;
            const char* a3 = a2 + kstep; const char* b3 = b2 + kstep;
            if (last && has_next) S.a_ready(nxt);
            if constexpr (SP2) {
            PG8_LDB(B0, 0, 0); PG8_LDB(B1, 0, 1); PG8_SCHED; PG8_LDA(At, 0, 0); PG8_STAGE(PG8_SA(1, 1), a1 + hstep, voffA);
            PG8_WAIT_V(8); PG8_WAIT_L(0); PG8_BAR; PG8_MMA(0, 0, At, B0); PG8_MMA(0, 1, At, B1); PG8_BAR; PG8_SCHED;
            PG8_LDA(At, 0, 1); PG8_STAGE(PG8_SB(0, 0), b2, voffB); PG8_STAGE(PG8_SB(0, 1), b2 + hstep, voffB); PG8_STAGE(PG8_SA(0, 0), a2, voffA);
            PG8_WAIT_V(8); PG8_WAIT_L(0); PG8_BAR; PG8_MMA(1, 0, At, B0); PG8_MMA(1, 1, At, B1); PG8_BAR; PG8_SCHED;
            PG8_LDB(B0, 1, 0); PG8_LDB(B1, 1, 1); PG8_SCHED; PG8_LDA(At, 1, 0); PG8_STAGE(PG8_SA(0, 1), a2 + hstep, voffA);
            PG8_WAIT_V(8); PG8_WAIT_L(0); PG8_BAR; PG8_MMA(0, 0, At, B0); PG8_MMA(0, 1, At, B1); PG8_BAR; PG8_SCHED;
            PG8_LDA(At, 1, 1); PG8_STAGE(PG8_SB(1, 0), b3, voffB); PG8_STAGE(PG8_SB(1, 1), b3 + hstep, voffB); PG8_STAGE(PG8_SA(1, 0), a3, voffA);
            PG8_WAIT_V(8); PG8_WAIT_L(0); PG8_BAR; PG8_MMA(1, 0, At, B0); PG8_MMA(1, 1, At, B1); PG8_BAR; PG8_SCHED;
            } else {
            PG8_LDB(B0, 0, 0); PG8_SCHED; PG8_LDA(At, 0, 0); PG8_STAGE(PG8_SA(1, 1), a1 + hstep, voffA);
            PG8_WAIT_L(8); PG8_BAR; PG8_WAIT_L(0); PG8_MMA(0, 0, At, B0); PG8_BAR; PG8_SCHED;
            PG8_LDB(B1, 0, 1); PG8_STAGE(PG8_SB(0, 0), b2, voffB);
            PG8_BAR; PG8_WAIT_L(0); PG8_MMA(0, 1, At, B1); PG8_BAR;
            PG8_LDA(At, 0, 1); PG8_STAGE(PG8_SA(0, 0), a2, voffA);
            PG8_BAR; PG8_WAIT_L(0); PG8_MMA(1, 0, At, B0); PG8_BAR; PG8_SCHED;
            PG8_STAGE(PG8_SB(0, 1), b2 + hstep, voffB);
            PG8_WAIT_V(6); PG8_BAR; PG8_MMA(1, 1, At, B1); PG8_BAR;
            PG8_LDB(B0, 1, 0); PG8_SCHED; PG8_LDA(At, 1, 0); PG8_STAGE(PG8_SA(0, 1), a2 + hstep, voffA);
            PG8_WAIT_L(8); PG8_BAR; PG8_WAIT_L(0); PG8_MMA(0, 0, At, B0); PG8_BAR; PG8_SCHED;
            PG8_LDB(B1, 1, 1); PG8_STAGE(PG8_SB(1, 0), b3, voffB);
            PG8_BAR; PG8_WAIT_L(0); PG8_MMA(0, 1, At, B1); PG8_BAR;
            PG8_LDA(At, 1, 1); PG8_STAGE(PG8_SA(1, 0), a3, voffA);
            PG8_BAR; PG8_WAIT_L(0); PG8_MMA(1, 0, At, B0); PG8_BAR; PG8_SCHED;
            PG8_STAGE(PG8_SB(1, 1), b3 + hstep, voffB);
            PG8_WAIT_V(6); PG8_BAR; PG8_MMA(1, 1, At, B1); PG8_BAR;
            }
        }
        if constexpr (ALIGN_EPI) { if (wr == 0) PG8_BAR; }
        if constexpr (!Epi::AFTER_DRAIN) { E(acc, cur, wr, wc, fr, fq); S.done(cur); }
        if (!has_next) break;
#pragma unroll
        for (int a = 0; a < 2; ++a)
#pragma unroll
            for (int b = 0; b < 2; ++b)
#pragma unroll
                for (int m = 0; m < 4; ++m)
#pragma unroll
                    for (int n = 0; n < 2; ++n) acc[a][b][m][n] = (f32x4){0.f, 0.f, 0.f, 0.f};
        cur = nxt; cA = nA; cB = nB; ++ui;
        if constexpr (ALIGN_EPI) { if (wr == 1) PG8_BAR; }
    }
    PG8_WAIT_V(0);
    if constexpr (!ALIGN_EPI) { if (wr == 0) PG8_BAR; }
    PG8_BAR;
    if constexpr (Epi::AFTER_DRAIN) { E.fused(acc, cur, wr, wc, fr, fq, lds, wid, lane); S.done(cur); }
#undef PG8_SA
#undef PG8_SB
#undef PG8_STAGE
#undef PG8_LDA
#undef PG8_LDB
#undef PG8_MMA
#undef PG8_WAIT_V
#undef PG8_WAIT_L
#undef PG8_BAR
#undef PG8_SCHED
}
}

constexpr int NWAVES = 8;
constexpr int LDS_BYTES = 135168;
constexpr int NB = 8, SEQ = 4096, T = NB * SEQ, D = 1024, INW = 9612, DEPTH = 2;
constexpr int A_Q = 0, A_K = 256, A_V = 512, A_G = 768, B_Q = 1024, B_KC = 1280, B_VC = 1344, B_KS = 1408, B_VS = 1472, B_KW = 1536, B_VW = 1600, B_G = 1664, B_NG = 1920,
              C_Q = 1932, C_K = 2188, C_V = 2444, C_G = 2700, D_Q = 2956, D_K = 3724, D_V = 4492, D_G = 5260, MRG = 5516;
constexpr size_t MiB = 1u << 20, KiB = 1024;
constexpr size_t WS_CTL = 0, WS_COS = 1 * MiB, WS_SIN = 1 * MiB + 512 * KiB, WS_KMEAN = 2 * MiB, WS_BIASP = 2 * MiB + 128 * KiB, WS_BIAS = 2 * MiB + 192 * KiB,
                 WS_KCMP = 2 * MiB + 512 * KiB, WS_VCMPT = 2 * MiB + 768 * KiB, WS_MMASK = 3 * MiB, WS_NMASK = 3 * MiB + 512 * KiB, WS_LSE = 4 * MiB,
                 WS_W1T = 6 * MiB, WS_W2T = 8 * MiB, WS_WQK = 9 * MiB, WS_WV = 15 * MiB, WS_WG = 18 * MiB, WS_WM = 20 * MiB, WS_WUP = 28 * MiB, WS_WOUT = 30 * MiB,
                 WS_H = 32 * MiB, WS_QK = 96 * MiB, WS_VT = 320 * MiB, WS_U = 320 * MiB, WS_Y = 224 * MiB, WS_END = 416 * MiB;
constexpr size_t SLOT_BYTES = 16 * MiB;
constexpr int SL_QA = 0, SL_QB = 1, SL_QC = 2, SL_QD0 = 3, SL_QBR = 4, SL_QD1 = 5, SL_QD2 = 6, SL_OWIN = 7, SL_KA = 8, SL_KB4 = 9, SL_KC = 10, SL_KD0 = 11;
constexpr int NQK = 3072, NV = 1536;
constexpr int CTL_BYTES = 4096;

typedef unsigned short bf16_t;
typedef short bf16x8 __attribute__((ext_vector_type(8)));
typedef float f32x4 __attribute__((ext_vector_type(4)));
typedef float f32x2 __attribute__((ext_vector_type(2)));
typedef float f32x16 __attribute__((ext_vector_type(16)));
typedef unsigned u32x4 __attribute__((ext_vector_type(4)));
typedef unsigned u32x2 __attribute__((ext_vector_type(2)));
typedef __bf16 bf16v2 __attribute__((ext_vector_type(2)));
#define LAS __attribute__((address_space(3)))
#define DI __device__ __forceinline__
#define MFMA32(a, b, c) __builtin_amdgcn_mfma_f32_32x32x16_bf16((a), (b), (c), 0, 0, 0)

constexpr float LOG2E = 1.4426950408889634f, LN2 = 0.6931471805599453f;
constexpr float SM_SCALE = 0.125f, SM_C = 0.125f * LOG2E, NEG = -1e30f, MFLOOR = -30000.f;

DI unsigned pk2(float lo, float hi) { const bf16v2 r = __builtin_convertvector((f32x2){lo, hi}, bf16v2); return __builtin_bit_cast(unsigned, r); }
DI float bf_lo(unsigned w) { return __uint_as_float(w << 16); }
DI float bf_hi(unsigned w) { return __uint_as_float(w & 0xffff0000u); }
DI float bf1(bf16_t x) { return __uint_as_float((unsigned)x << 16); }
DI float fexp2(float x) { return __builtin_amdgcn_exp2f(x); }
DI float flog2(float x) { return __builtin_amdgcn_logf(x); }
DI float frcp(float x) { return __builtin_amdgcn_rcpf(x); }
DI float sigmoidf_(float x) { return frcp(1.f + fexp2(-x * LOG2E)); }
DI float wave_sum(float v) {
#pragma unroll
    for (int o = 1; o < 64; o <<= 1) v += __shfl_xor(v, o);
    return v;
}
DI float xhalf(float v) { return __shfl_xor(v, 32); }
DI bf16_t* slot_ptr(unsigned char* ws, int s) { return (bf16_t*)(ws + WS_QK + (size_t)s * SLOT_BYTES); }
DI void load8(const bf16_t* p, float (&f)[8]) { const u32x4 w = *(const u32x4*)p; f[0] = bf_lo(w.x); f[1] = bf_hi(w.x); f[2] = bf_lo(w.y); f[3] = bf_hi(w.y); f[4] = bf_lo(w.z); f[5] = bf_hi(w.z); f[6] = bf_lo(w.w); f[7] = bf_hi(w.w); }
DI void store8(bf16_t* p, const float (&f)[8]) { u32x4 w; w.x = pk2(f[0], f[1]); w.y = pk2(f[2], f[3]); w.z = pk2(f[4], f[5]); w.w = pk2(f[6], f[7]); *(u32x4*)p = w; }
DI void store4(bf16_t* p, float a, float b, float c, float d) { u32x2 w; w.x = pk2(a, b); w.y = pk2(c, d); *(u32x2*)p = w; }

struct Epi {
    static constexpr bool PERM = true, AFTER_DRAIN = false;
    int kind, first; unsigned char* ws; const float* xin; float* xout;
    typedef pg8::f32x4 a4;
    DI void operator()(const a4 (&acc)[2][2][4][2], const pg8::Unit& u, int wr, int wc, int fr, int fq) const {
        if (kind == 0) {
            const int tile = u.pn;
            const int slot = (int)((0xDCB653A29180ull >> (4 * tile)) & 15ull);
            bf16_t* dst = slot_ptr(ws, slot); bf16_t* dst2 = slot_ptr(ws, SL_QBR);
            const bool ropeall = (tile <= 1) || (tile >= 6);
            const int g = 4 * (wc & 1) + fq, d0 = 4 * g;
            const float* cosT = (const float*)(ws + WS_COS); const float* sinT = (const float*)(ws + WS_SIN);
#pragma unroll
            for (int ai = 0; ai < 2; ++ai)
#pragma unroll
                for (int m = 0; m < 4; ++m) {
                    const int tok = u.pm * 256 + ai * 128 + wr * 64 + m * 16 + fr, pos = tok & (SEQ - 1);
                    const f32x4 cs = *(const f32x4*)(cosT + pos * 32 + d0), sn = *(const f32x4*)(sinT + pos * 32 + d0);
#pragma unroll
                    for (int bj = 0; bj < 2; ++bj) {
                        const int hs = 2 * bj + (wc >> 1);
                        const a4 v0 = acc[ai][bj][m][0], v1 = acc[ai][bj][m][1];
                        const a4 r0 = v0 * cs - v1 * sn, r1 = v0 * sn + v1 * cs;
                        const size_t off = (size_t)tok * 256 + hs * 64 + d0;
                        const bool rope = ropeall || (tile == 3 && hs >= 2);
                        if (tile == 2) { store4(dst + off, v0[0], v0[1], v0[2], v0[3]); store4(dst + off + 32, v1[0], v1[1], v1[2], v1[3]);
                                         store4(dst2 + off, r0[0], r0[1], r0[2], r0[3]); store4(dst2 + off + 32, r1[0], r1[1], r1[2], r1[3]); }
                        else if (rope) { store4(dst + off, r0[0], r0[1], r0[2], r0[3]); store4(dst + off + 32, r1[0], r1[1], r1[2], r1[3]); }
                        else { store4(dst + off, v0[0], v0[1], v0[2], v0[3]); store4(dst + off + 32, v1[0], v1[1], v1[2], v1[3]); }
                    }
                    asm volatile("" ::: "memory");
                }
        } else if (kind == 1) {
            bf16_t* VT = (bf16_t*)(ws + WS_VT);
#pragma unroll
            for (int ai = 0; ai < 2; ++ai)
#pragma unroll
                for (int m = 0; m < 4; ++m) {
                    const int r = u.pm * 256 + ai * 128 + wr * 64 + m * 16 + fr;
                    bf16_t* rowp = VT + (size_t)r * T;
                    const bool gate = (r >= 1408 && r < 1420);
#pragma unroll
                    for (int bj = 0; bj < 2; ++bj) {
                        const int c0 = u.pn * 256 + bj * 128 + wc * 32 + 8 * fq;
                        const a4 v0 = acc[ai][bj][m][0], v1 = acc[ai][bj][m][1];
                        float v[8] = {v0[0], v0[1], v0[2], v0[3], v1[0], v1[1], v1[2], v1[3]};
                        if (gate) {
#pragma unroll
                            for (int j = 0; j < 8; ++j) v[j] = sigmoidf_(v[j]);
                        }
                        if (u.pm == 3) {
                            const int b = c0 >> 12, p0 = c0 & (SEQ - 1), mm0 = p0 >> 2;
                            bf16_t* q = rowp + b * SEQ + mm0;
#pragma unroll
                            for (int c = 0; c < 4; ++c) *(unsigned*)(q + c * 1024) = pk2(v[c], v[c + 4]);
                        } else if (u.pm == 4) {
                            const int b = c0 >> 12, p0 = c0 & (SEQ - 1), mm = p0 >> 4, cc0 = p0 & 15;
                            bf16_t* q = rowp + b * SEQ + cc0 * 256 + mm;
#pragma unroll
                            for (int j = 0; j < 8; ++j) q[j * 256] = (bf16_t)(pk2(v[j], 0.f) & 0xffffu);
                        } else store8(rowp + c0, v);
                    }
                    asm volatile("" ::: "memory");
                }
        } else if (kind == 2) {
            const int br = u.pn;
            const bf16_t* VT = (const bf16_t*)(ws + WS_VT);
            const float* LSE = (const float*)(ws + WS_LSE);
#pragma unroll
            for (int ai = 0; ai < 2; ++ai)
#pragma unroll
                for (int m = 0; m < 4; ++m) {
                    const int tok = u.pm * 256 + ai * 128 + wr * 64 + m * 16 + fr;
#pragma unroll
                    for (int bj = 0; bj < 2; ++bj) {
                        const int cb = bj * 128 + wc * 32 + 8 * fq, head = cb >> 6;
                        const a4 v0 = acc[ai][bj][m][0], v1 = acc[ai][bj][m][1];
                        float gt[8] = {v0[0], v0[1], v0[2], v0[3], v1[0], v1[1], v1[2], v1[3]};
                        const size_t off = (size_t)tok * 256 + cb;
                        float o[8];
                        bf16_t* dst;
                        if (br == 0) { dst = slot_ptr(ws, SL_QA) + off; load8(dst, o); }
                        else if (br == 2) { dst = slot_ptr(ws, SL_QC) + off; load8(dst, o); }
                        else if (br == 1) {
                            dst = slot_ptr(ws, SL_QB) + off;
                            float oc[8], os[8], ow[8]; load8(dst, oc); load8(slot_ptr(ws, SL_QBR) + off, os); load8(slot_ptr(ws, SL_OWIN) + off, ow);
                            const float g0 = bf1(VT[(size_t)(1408 + head) * T + tok]), g1 = bf1(VT[(size_t)(1412 + head) * T + tok]), g2 = bf1(VT[(size_t)(1416 + head) * T + tok]);
#pragma unroll
                            for (int j = 0; j < 8; ++j) o[j] = g0 * oc[j] + g1 * os[j] + g2 * ow[j];
                        } else {
                            dst = slot_ptr(ws, SL_QD0) + off;
                            float o0[8], o1[8], o2[8]; load8(dst, o0); load8(slot_ptr(ws, SL_QD1) + off, o1); load8(slot_ptr(ws, SL_QD2) + off, o2);
                            const float l0 = LSE[((size_t)0 * T + tok) * 4 + head], l1 = LSE[((size_t)1 * T + tok) * 4 + head], l2 = LSE[((size_t)2 * T + tok) * 4 + head];
                            const float mx = fmaxf(l0, fmaxf(l1, l2));
                            const float e0 = fexp2((l0 - mx) * LOG2E), e1 = fexp2((l1 - mx) * LOG2E), e2 = fexp2((l2 - mx) * LOG2E);
                            const float inv = frcp(e0 + e1 + e2);
#pragma unroll
                            for (int j = 0; j < 8; ++j) o[j] = (e0 * o0[j] + e1 * o1[j] + e2 * o2[j]) * inv;
                        }
#pragma unroll
                        for (int j = 0; j < 8; ++j) o[j] *= gt[j] * sigmoidf_(gt[j]);
                        store8(dst, o);
                        asm volatile("" ::: "memory");
                    }
                }
        } else {
            bf16_t* U = (bf16_t*)(ws + WS_U); bf16_t* Y = (bf16_t*)(ws + WS_Y);
#pragma unroll
            for (int ai = 0; ai < 2; ++ai)
#pragma unroll
                for (int m = 0; m < 4; ++m) {
                    const int tok = u.pm * 256 + ai * 128 + wr * 64 + m * 16 + fr;
#pragma unroll
                    for (int bj = 0; bj < 2; ++bj) {
                        const int col = u.pn * 256 + bj * 128 + wc * 32 + 8 * fq;
                        const a4 v0 = acc[ai][bj][m][0], v1 = acc[ai][bj][m][1];
                        float v[8] = {v0[0], v0[1], v0[2], v0[3], v1[0], v1[1], v1[2], v1[3]};
                        const size_t off = (size_t)tok * D + col;
                        if (kind == 3) store8(U + off, v);
                        else if (kind == 4) {
                            float uu[8]; load8(U + off, uu);
                            float y[8];
                            if (first) {
#pragma unroll
                                for (int j = 0; j < 8; ++j) y[j] = sigmoidf_(v[j]) * uu[j];
                            } else {
                                load8(Y + off, y);
#pragma unroll
                                for (int j = 0; j < 8; ++j) y[j] += sigmoidf_(v[j]) * uu[j];
                            }
                            store8(Y + off, y);
                        } else {
                            const f32x4 x0 = *(const f32x4*)(xin + off), x1 = *(const f32x4*)(xin + off + 4);
                            *(f32x4*)(xout + off) = (f32x4){x0[0] + v[0], x0[1] + v[1], x0[2] + v[2], x0[3] + v[3]};
                            *(f32x4*)(xout + off + 4) = (f32x4){x1[0] + v[4], x1[1] + v[5], x1[2] + v[6], x1[3] + v[7]};
                        }
                        asm volatile("" ::: "memory");
                    }
                }
        }
    }
};

DI void transpose_item(const float* W, int K, int N, bf16_t* WT, int k0, int n0, int sc, LAS float* scr, int lane) {
#pragma unroll 8
    for (int i = 0; i < 32; ++i) { const int kk = 2 * i + (lane >> 5); scr[kk * 33 + (lane & 31)] = sc >= 0 ? W[(size_t)(k0 + kk) * N + sc] : 0.f; }
    asm volatile("s_waitcnt lgkmcnt(0)" ::: "memory");
    const int c = lane & 7;
#pragma unroll
    for (int j = 0; j < 4; ++j) { const int n = (lane >> 3) + 8 * j; const LAS float* s = scr + (8 * c) * 33 + n;
        u32x4 o; o.x = pk2(s[0 * 33], s[1 * 33]); o.y = pk2(s[2 * 33], s[3 * 33]); o.z = pk2(s[4 * 33], s[5 * 33]); o.w = pk2(s[6 * 33], s[7 * 33]);
        *(u32x4*)(WT + (size_t)(n0 + n) * K + k0 + 8 * c) = o; }
    asm volatile("s_waitcnt lgkmcnt(0)" ::: "memory");
}
DI int src_qk(int n) {
    const int tile = n >> 8, hs = (n >> 6) & 3, g = (n >> 3) & 7, e = n & 7, d = 4 * g + (e & 3) + 32 * (e >> 2);
    int base;
    switch (tile) {
        case 0: base = A_Q + 64 * hs; break; case 1: base = A_K + 64 * hs; break; case 2: base = B_Q + 64 * hs; break;
        case 3: base = hs == 0 ? B_KC : hs == 1 ? B_VC : hs == 2 ? B_KS : B_KW; break;
        case 4: base = C_Q + 64 * hs; break; case 5: base = C_K + 64 * hs; break;
        case 6: case 7: case 8: base = D_Q + 256 * (tile - 6) + 64 * hs; break;
        default: base = D_K + 256 * (tile - 9) + 64 * hs; break;
    }
    return base + d;
}
DI int src_v(int n) {
    const int slot = n >> 6, d = n & 63;
    if (slot < 4) return A_V + 64 * slot + d;
    if (slot < 8) return C_V + 64 * (slot - 4) + d;
    if (slot < 20) return D_V + 64 * (slot - 8) + d;
    if (slot == 20) return B_VS + d;
    if (slot == 21) return B_VW + d;
    if (slot == 22 && d < 12) return B_NG + d;
    return -1;
}
DI int src_g(int n) { const int br = n >> 8, c = n & 255; return (br == 0 ? A_G : br == 1 ? B_G : br == 2 ? C_G : D_G) + c; }

DI int kappa(int rho) { return (rho & 16) | ((rho & 4) << 1) | ((rho & 8) >> 1) | (rho & 3); }
DI bf16x8 ldfrag(const bf16_t* p) { return *(const bf16x8*)p; }
DI bf16x8 pack8(const float* p) { u32x4 w; w.x = pk2(p[0], p[1]); w.y = pk2(p[2], p[3]); w.z = pk2(p[4], p[5]); w.w = pk2(p[6], p[7]); return __builtin_bit_cast(bf16x8, w); }

struct SmState { f32x16 O[2]; float m, l; };
DI void sm_init(SmState& st) {
#pragma unroll
    for (int i = 0; i < 16; ++i) { st.O[0][i] = 0.f; st.O[1][i] = 0.f; }
    st.m = MFLOOR; st.l = 0.f;
}
template <bool MASK>
DI void sm_tile(SmState& st, const bf16x8 (&qf)[4], const bf16_t* kp, const bf16_t* v0p, const bf16_t* v1p, int key0, bool allow, int klo, int khi) {
    bf16x8 kf[4], vf[2][2];
#pragma unroll
    for (int s = 0; s < 4; ++s) kf[s] = ldfrag(kp + 16 * s);
#pragma unroll
    for (int s = 0; s < 2; ++s) { vf[0][s] = ldfrag(v0p + 16 * s); vf[1][s] = ldfrag(v1p + 16 * s); }
    f32x16 S;
#pragma unroll
    for (int i = 0; i < 16; ++i) S[i] = 0.f;
#pragma unroll
    for (int s = 0; s < 4; ++s) S = MFMA32(kf[s], qf[s], S);
    float p[16]; float mx = MFLOOR;
#pragma unroll
    for (int i = 0; i < 16; ++i) {
        float v = S[i];
        if (MASK) { const int key = key0 + 16 * (i >> 3) + (i & 7); v = (allow && key >= klo && key <= khi) ? v : NEG; }
        p[i] = v; mx = fmaxf(mx, v);
    }
    mx = fmaxf(mx, xhalf(mx));
    const float mn = fmaxf(st.m, mx), alpha = fexp2((st.m - mn) * SM_C), mc = mn * SM_C;
    float rs = 0.f;
#pragma unroll
    for (int i = 0; i < 16; ++i) { p[i] = fexp2(p[i] * SM_C - mc); rs += p[i]; }
    st.l = st.l * alpha + rs; st.m = mn;
#pragma unroll
    for (int i = 0; i < 16; ++i) { st.O[0][i] *= alpha; st.O[1][i] *= alpha; }
    const bf16x8 pf0 = pack8(p), pf1 = pack8(p + 8);
    st.O[0] = MFMA32(vf[0][0], pf0, st.O[0]); st.O[0] = MFMA32(vf[0][1], pf1, st.O[0]);
    st.O[1] = MFMA32(vf[1][0], pf0, st.O[1]); st.O[1] = MFMA32(vf[1][1], pf1, st.O[1]);
}
DI void write_o(bf16_t* orow, const f32x16 (&O)[2], float inv, int h) {
#pragma unroll
    for (int dt = 0; dt < 2; ++dt)
#pragma unroll
        for (int g = 0; g < 4; ++g) store4(orow + 32 * dt + 8 * g + 4 * h, O[dt][4 * g] * inv, O[dt][4 * g + 1] * inv, O[dt][4 * g + 2] * inv, O[dt][4 * g + 3] * inv);
}
DI void load_q(bf16x8 (&qf)[4], const bf16_t* qrow, int h) {
#pragma unroll
    for (int s = 0; s < 4; ++s) qf[s] = ldfrag(qrow + 16 * s + 8 * h);
}

DI void task_moba(unsigned char* ws, int b, int hh, int qt, int lane) {
    const int r = lane & 31, h = lane >> 5, t0 = 32 * qt, t = t0 + r, cb = t0 >> 8;
    bf16_t* qrow = slot_ptr(ws, SL_QA) + (size_t)(b * SEQ + t) * 256 + hh * 64;
    bf16x8 qf[4]; load_q(qf, qrow, h);
    const unsigned mask = ((const unsigned*)(ws + WS_MMASK))[(b * 4 + hh) * SEQ + t];
    const bf16_t* kb = slot_ptr(ws, SL_KA) + (size_t)(b * SEQ + kappa(r)) * 256 + hh * 64 + 8 * h;
    const bf16_t* vb0 = (const bf16_t*)(ws + WS_VT) + (size_t)(hh * 64 + r) * T + b * SEQ + 8 * h;
    const bf16_t* vb1 = vb0 + (size_t)32 * T;
    SmState st; sm_init(st);
    for (int blk = 0; blk < cb; ++blk) {
        const bool allow = (mask >> blk) & 1u;
        const unsigned long long bits = __ballot(allow);
        if (bits == 0ull) continue;
        if (bits == ~0ull) { for (int kt0 = 256 * blk; kt0 < 256 * blk + 256; kt0 += 32) sm_tile<false>(st, qf, kb + (size_t)kt0 * 256, vb0 + kt0, vb1 + kt0, kt0 + 8 * h, true, 0, 0); }
        else { for (int kt0 = 256 * blk; kt0 < 256 * blk + 256; kt0 += 32) sm_tile<true>(st, qf, kb + (size_t)kt0 * 256, vb0 + kt0, vb1 + kt0, kt0 + 8 * h, allow, -1, 1 << 30); }
    }
    for (int kt0 = 256 * cb; kt0 < t0; kt0 += 32) sm_tile<false>(st, qf, kb + (size_t)kt0 * 256, vb0 + kt0, vb1 + kt0, kt0 + 8 * h, true, 0, 0);
    sm_tile<true>(st, qf, kb + (size_t)t0 * 256, vb0 + t0, vb1 + t0, t0 + 8 * h, true, -1, t);
    const float lt = st.l + xhalf(st.l);
    write_o(qrow, st.O, frcp(lt), h);
}

DI void task_nsa_sw(unsigned char* ws, int b, int hh, int qt, int lane) {
    const int r = lane & 31, h = lane >> 5, t0 = 32 * qt, t = t0 + r, cur = t0 >> 6;
    bf16_t* qrow = slot_ptr(ws, SL_QBR) + (size_t)(b * SEQ + t) * 256 + hh * 64;
    bf16x8 qf[4]; load_q(qf, qrow, h);
    const unsigned long long mask = ((const unsigned long long*)(ws + WS_NMASK))[b * SEQ + t];
    const bf16_t* VT = (const bf16_t*)(ws + WS_VT);
    {
        const bf16_t* kb = slot_ptr(ws, SL_KB4) + (size_t)(b * SEQ + kappa(r)) * 256 + 128 + 8 * h;
        const bf16_t* vb0 = VT + (size_t)(1280 + r) * T + b * SEQ + 8 * h; const bf16_t* vb1 = vb0 + (size_t)32 * T;
        SmState st; sm_init(st);
        for (int j = 0; j <= cur; ++j) {
            const bool allow = (mask >> j) & 1ull;
            if (__ballot(allow) == 0ull) continue;
            const int kend = (j == cur) ? t0 + 32 : 64 * j + 64;
            for (int kt0 = 64 * j; kt0 < kend; kt0 += 32) sm_tile<true>(st, qf, kb + (size_t)kt0 * 256, vb0 + kt0, vb1 + kt0, kt0 + 8 * h, allow, -1, t);
        }
        const float lt = st.l + xhalf(st.l);
        write_o(qrow, st.O, frcp(lt), h);
    }
    {
        const bf16_t* kb = slot_ptr(ws, SL_KB4) + (size_t)(b * SEQ + kappa(r)) * 256 + 192 + 8 * h;
        const bf16_t* vb0 = VT + (size_t)(1344 + r) * T + b * SEQ + 8 * h; const bf16_t* vb1 = vb0 + (size_t)32 * T;
        SmState st; sm_init(st);
        const int first = t0 - 512;
        for (int kt0 = first < 0 ? 0 : first; kt0 <= t0; kt0 += 32) {
            if (kt0 == first || kt0 == t0) sm_tile<true>(st, qf, kb + (size_t)kt0 * 256, vb0 + kt0, vb1 + kt0, kt0 + 8 * h, true, t - 511, t);
            else sm_tile<false>(st, qf, kb + (size_t)kt0 * 256, vb0 + kt0, vb1 + kt0, kt0 + 8 * h, true, 0, 0);
        }
        const float lt = st.l + xhalf(st.l);
        write_o(slot_ptr(ws, SL_OWIN) + (size_t)(b * SEQ + t) * 256 + hh * 64, st.O, frcp(lt), h);
    }
}

DI void task_dil(unsigned char* ws, int g, int b, int hd, int c, int sq, int lane) {
    const int r = lane & 31, h = lane >> 5, dil = g == 0 ? 1 : g == 1 ? 4 : 16, L = SEQ / dil;
    const int m0 = 32 * sq, mq = m0 + r, tok = b * SEQ + mq * dil + c;
    bf16_t* qrow = slot_ptr(ws, g == 0 ? SL_QD0 : g == 1 ? SL_QD1 : SL_QD2) + (size_t)tok * 256 + hd * 64;
    bf16x8 qf[4]; load_q(qf, qrow, h);
    const size_t kstride = (size_t)256 * dil;
    const bf16_t* kb = slot_ptr(ws, SL_KD0 + g) + (size_t)(b * SEQ + c) * 256 + (size_t)kappa(r) * kstride + hd * 64 + 8 * h;
    const bf16_t* vb0 = (const bf16_t*)(ws + WS_VT) + (size_t)(512 + 256 * g + hd * 64 + r) * T + b * SEQ + (g == 0 ? 0 : c * L) + 8 * h;
    const bf16_t* vb1 = vb0 + (size_t)32 * T;
    SmState st; sm_init(st);
    const int first = m0 - 128;
    for (int kt0 = first < 0 ? 0 : first; kt0 <= m0; kt0 += 32) {
        if (kt0 == first || kt0 == m0) sm_tile<true>(st, qf, kb + (size_t)kt0 * kstride, vb0 + kt0, vb1 + kt0, kt0 + 8 * h, true, mq - 128, mq);
        else sm_tile<false>(st, qf, kb + (size_t)kt0 * kstride, vb0 + kt0, vb1 + kt0, kt0 + 8 * h, true, 0, 0);
    }
    const float lt = st.l + xhalf(st.l);
    write_o(qrow, st.O, frcp(lt), h);
    if (h == 0) ((float*)(ws + WS_LSE))[((size_t)g * T + tok) * 4 + hd] = st.m * SM_SCALE + flog2(lt) * LN2;
}

DI void task_stick(unsigned char* ws, int b, int hh, int qt, int lane) {
    const int r = lane & 31, h = lane >> 5, t0 = 32 * qt, t = t0 + r;
    bf16_t* qrow = slot_ptr(ws, SL_QC) + (size_t)(b * SEQ + t) * 256 + hh * 64;
    bf16x8 qf[4]; load_q(qf, qrow, h);
    const bf16_t* kb = slot_ptr(ws, SL_KC) + (size_t)(b * SEQ + kappa(r)) * 256 + hh * 64 + 8 * h;
    const bf16_t* vb0 = (const bf16_t*)(ws + WS_VT) + (size_t)(256 + hh * 64 + r) * T + b * SEQ + 8 * h;
    const bf16_t* vb1 = vb0 + (size_t)32 * T;
    f32x16 O[2];
#pragma unroll
    for (int i = 0; i < 16; ++i) { O[0][i] = 0.f; O[1][i] = 0.f; }
    float carry = 0.f;
    for (int kt0 = t0; kt0 >= 0; kt0 -= 32) {
        const bf16_t* kp = kb + (size_t)kt0 * 256;
        bf16x8 kf[4], vf[2][2];
#pragma unroll
        for (int s = 0; s < 4; ++s) kf[s] = ldfrag(kp + 16 * s);
#pragma unroll
        for (int s = 0; s < 2; ++s) { vf[0][s] = ldfrag(vb0 + kt0 + 16 * s); vf[1][s] = ldfrag(vb1 + kt0 + 16 * s); }
        f32x16 S;
#pragma unroll
        for (int i = 0; i < 16; ++i) S[i] = 0.f;
#pragma unroll
        for (int s = 0; s < 4; ++s) S = MFMA32(kf[s], qf[s], S);
        float lsm[16], ls[16]; float sA = 0.f, sB = 0.f;
        const int key0 = kt0 + 8 * h;
#pragma unroll
        for (int i = 0; i < 16; ++i) {
            const int key = key0 + 16 * (i >> 3) + (i & 7);
            const bool valid = key < t;
            const float z = S[i] * SM_SCALE;
            const float sp = fmaxf(z, 0.f) + flog2(1.f + fexp2(-fabsf(z) * LOG2E)) * LN2;
            lsm[i] = valid ? -sp : 0.f;
            ls[i] = valid ? z - sp : NEG;
            if (i < 8) sA += lsm[i]; else sB += lsm[i];
        }
        const float pA = xhalf(sA), pB = xhalf(sB);
        const float baseB = carry + (h == 0 ? pB : 0.f), baseA = carry + sB + pB + (h == 0 ? pA : 0.f);
        float p[16]; float run = baseA;
#pragma unroll
        for (int e = 7; e >= 0; --e) { p[e] = fexp2((ls[e] + run) * LOG2E); run += lsm[e]; }
        run = baseB;
#pragma unroll
        for (int e = 15; e >= 8; --e) { p[e] = fexp2((ls[e] + run) * LOG2E); run += lsm[e]; }
        carry += (sA + sB) + (pA + pB);
        const bf16x8 pf0 = pack8(p), pf1 = pack8(p + 8);
        O[0] = MFMA32(vf[0][0], pf0, O[0]); O[0] = MFMA32(vf[0][1], pf1, O[0]);
        O[1] = MFMA32(vf[1][0], pf0, O[1]); O[1] = MFMA32(vf[1][1], pf1, O[1]);
        if (__ballot(carry > -104.f) == 0ull) break;
    }
    write_o(qrow, O, 1.f, h);
}

DI void task_cmp(unsigned char* ws, int b, int qt, int lane, LAS float* imp) {
    const int r = lane & 31, h = lane >> 5, t0 = 32 * qt, t = t0 + r, cur = t0 >> 6;
    const int nvis = t >= 31 ? ((t - 31) >> 4) + 1 : 0;
    const int nvmax = (t0 >> 4) + 1, ntile = (nvmax + 31) >> 5;
    const bool need_imp = cur >= 16;
    for (int i = lane; i < 32 * 65; i += 64) imp[i] = 0.f;
    const bf16_t* kb = (const bf16_t*)(ws + WS_KCMP) + (size_t)(b * 256 + kappa(r)) * 64 + 8 * h;
    const bf16_t* vb0 = (const bf16_t*)(ws + WS_VCMPT) + (size_t)(b * 64 + r) * 256 + 8 * h; const bf16_t* vb1 = vb0 + 32 * 256;
    for (int hh = 0; hh < 4; ++hh) {
        bf16_t* qrow = slot_ptr(ws, SL_QB) + (size_t)(b * SEQ + t) * 256 + hh * 64;
        bf16x8 qf[4]; load_q(qf, qrow, h);
        float m = MFLOOR, l = 0.f;
        for (int tl = 0; tl < ntile; ++tl) {
            bf16x8 kf[4];
#pragma unroll
            for (int s = 0; s < 4; ++s) kf[s] = ldfrag(kb + (size_t)(32 * tl) * 64 + 16 * s);
            f32x16 S;
#pragma unroll
            for (int i = 0; i < 16; ++i) S[i] = 0.f;
#pragma unroll
            for (int s = 0; s < 4; ++s) S = MFMA32(kf[s], qf[s], S);
            float mx = MFLOOR;
#pragma unroll
            for (int i = 0; i < 16; ++i) { const int key = 32 * tl + 8 * h + 16 * (i >> 3) + (i & 7); const float v = key < nvis ? S[i] : NEG; S[i] = v; mx = fmaxf(mx, v); }
            mx = fmaxf(mx, xhalf(mx));
            const float mn = fmaxf(m, mx), mc = mn * SM_C;
            float rs = 0.f;
#pragma unroll
            for (int i = 0; i < 16; ++i) rs += fexp2(S[i] * SM_C - mc);
            l = l * fexp2((m - mn) * SM_C) + rs; m = mn;
        }
        const float lt = l + xhalf(l);
        const float inv = nvis > 0 ? frcp(lt) : 0.f, mc = m * SM_C;
        f32x16 O[2];
#pragma unroll
        for (int i = 0; i < 16; ++i) { O[0][i] = 0.f; O[1][i] = 0.f; }
        for (int tl = 0; tl < ntile; ++tl) {
            bf16x8 kf[4], vf[2][2];
#pragma unroll
            for (int s = 0; s < 4; ++s) kf[s] = ldfrag(kb + (size_t)(32 * tl) * 64 + 16 * s);
#pragma unroll
            for (int s = 0; s < 2; ++s) { vf[0][s] = ldfrag(vb0 + 32 * tl + 16 * s); vf[1][s] = ldfrag(vb1 + 32 * tl + 16 * s); }
            f32x16 S;
#pragma unroll
            for (int i = 0; i < 16; ++i) S[i] = 0.f;
#pragma unroll
            for (int s = 0; s < 4; ++s) S = MFMA32(kf[s], qf[s], S);
            float p[16];
#pragma unroll
            for (int i = 0; i < 16; ++i) { const int key = 32 * tl + 8 * h + 16 * (i >> 3) + (i & 7); p[i] = key < nvis ? fexp2(S[i] * SM_C - mc) * inv : 0.f; }
            if (need_imp) {
#pragma unroll
                for (int a = 0; a < 2; ++a) {
                    const int u = 4 * tl + 2 * a + h; const float* q = p + 8 * a;
                    LAS float* row = imp + r * 65 + 2 * u;
                    atomicAdd((float*)(row + 0), (q[0] + q[1]) + (q[2] + q[3]));
                    atomicAdd((float*)(row + 1), (q[3] + q[4]) + (q[5] + q[6]) + q[7]);
                    if (2 * u + 2 < 64) atomicAdd((float*)(row + 2), q[7]);
                }
            }
            const bf16x8 pf0 = pack8(p), pf1 = pack8(p + 8);
            O[0] = MFMA32(vf[0][0], pf0, O[0]); O[0] = MFMA32(vf[0][1], pf1, O[0]);
            O[1] = MFMA32(vf[1][0], pf0, O[1]); O[1] = MFMA32(vf[1][1], pf1, O[1]);
        }
        write_o(qrow, O, 1.f, h);
    }
    asm volatile("s_waitcnt lgkmcnt(0)" ::: "memory");
    if (lane < 32) {
        unsigned long long mask;
        if (cur <= 15) mask = (2ull << cur) - 1ull;
        else {
            mask = 1ull | (1ull << cur) | (1ull << (cur - 1));
            for (int k = 0; k < 13; ++k) {
                float best = -1.f; int bj = 1;
                for (int j = 1; j <= cur - 2; ++j) { const float v = imp[r * 65 + j]; if (!((mask >> j) & 1ull) && v > best) { best = v; bj = j; } }
                mask |= 1ull << bj;
            }
        }
        ((unsigned long long*)(ws + WS_NMASK))[b * SEQ + t] = mask;
    }
    asm volatile("s_waitcnt lgkmcnt(0)" ::: "memory");
}

DI void task_moba_gate(unsigned char* ws, int b, int hh, int qt, int lane) {
    const int r = lane & 31, h = lane >> 5, t0 = 32 * qt, t = t0 + r, cb = t0 >> 8;
    unsigned sel = 0u;
    if (cb <= 3) sel = (1u << cb) - 1u;
    else {
        const bf16_t* qrow = slot_ptr(ws, SL_QA) + (size_t)(b * SEQ + t) * 256 + hh * 64 + 32 * h;
        float q[32];
#pragma unroll
        for (int j = 0; j < 4; ++j) { float f[8]; load8(qrow + 8 * j, f);
#pragma unroll
            for (int e = 0; e < 8; ++e) q[8 * j + e] = f[e]; }
        const float* km = (const float*)(ws + WS_KMEAN) + (size_t)((b * 4 + hh) * 16) * 64 + 32 * h;
        float gate[16];
#pragma unroll
        for (int n = 0; n < 16; ++n) {
            float s = 0.f;
            if (n < cb) {
#pragma unroll
                for (int d = 0; d < 32; ++d) s += q[d] * km[n * 64 + d];
            }
            s += xhalf(s);
            gate[n] = n < cb ? s : -INFINITY;
        }
#pragma unroll
        for (int k = 0; k < 3; ++k) {
            float best = -INFINITY; int bi = -1;
#pragma unroll
            for (int n = 0; n < 16; ++n) if (!((sel >> n) & 1u) && gate[n] > best) { best = gate[n]; bi = n; }
            if (bi >= 0) sel |= 1u << bi;
        }
    }
    if (lane < 32) ((unsigned*)(ws + WS_MMASK))[(b * 4 + hh) * SEQ + t] = sel | (1u << cb);
}

DI void task_kmean(unsigned char* ws, int b, int hh, int blk, int lane) {
    const bf16_t* kp = slot_ptr(ws, SL_KA) + (size_t)(b * SEQ + 256 * blk) * 256 + hh * 64 + lane;
    float s = 0.f;
#pragma unroll 8
    for (int i = 0; i < 256; ++i) s += bf1(kp[(size_t)i * 256]);
    ((float*)(ws + WS_KMEAN))[((b * 4 + hh) * 16 + blk) * 64 + lane] = s * (1.f / 256.f);
}

DI void task_mlp(unsigned char* ws, int kv, int b, int rt, int lane) {
    const int r = lane & 31, h = lane >> 5, n = 32 * rt + r, ne = n > 254 ? 254 : n;
    const bf16_t* xp = slot_ptr(ws, SL_KB4) + (size_t)(b * SEQ + 16 * ne) * 256 + kv * 64 + 8 * h;
    const bf16_t* w1 = (const bf16_t*)(ws + WS_W1T) + (size_t)(kv * 256 + kappa(r)) * 2048 + 8 * h;
    f32x16 acc[8];
#pragma unroll
    for (int ht = 0; ht < 8; ++ht)
#pragma unroll
        for (int i = 0; i < 16; ++i) acc[ht][i] = 0.f;
    for (int l = 0; l < 32; ++l) {
#pragma unroll
        for (int s = 0; s < 4; ++s) {
            const bf16x8 xf = ldfrag(xp + (size_t)l * 256 + 16 * s);
#pragma unroll
            for (int ht = 0; ht < 8; ++ht) acc[ht] = MFMA32(ldfrag(w1 + (size_t)(32 * ht) * 2048 + 64 * l + 16 * s), xf, acc[ht]);
        }
    }
    const float* bias = (const float*)(ws + WS_BIAS) + kv * 256;
    const bf16_t* w2 = (const bf16_t*)(ws + WS_W2T) + (size_t)(kv * 64 + r) * 256 + 8 * h;
    f32x16 out[2];
#pragma unroll
    for (int i = 0; i < 16; ++i) { out[0][i] = 0.f; out[1][i] = 0.f; }
#pragma unroll
    for (int ht = 0; ht < 8; ++ht) {
        float g[16];
#pragma unroll
        for (int i = 0; i < 16; ++i) {
            const float x = acc[ht][i] + bias[32 * ht + 16 * (i >> 3) + 8 * h + (i & 7)];
            const float y = 0.7978845608028654f * (x + 0.044715f * x * x * x);
            const float th = 1.f - 2.f * frcp(1.f + fexp2(2.f * LOG2E * y));
            g[i] = 0.5f * x * (1.f + th);
        }
        const bf16x8 pf0 = pack8(g), pf1 = pack8(g + 8);
#pragma unroll
        for (int dt = 0; dt < 2; ++dt) {
            out[dt] = MFMA32(ldfrag(w2 + (size_t)(32 * dt) * 256 + 32 * ht), pf0, out[dt]);
            out[dt] = MFMA32(ldfrag(w2 + (size_t)(32 * dt) * 256 + 32 * ht + 16), pf1, out[dt]);
        }
    }
    const float keep = n <= 254 ? 1.f : 0.f;
    if (kv == 0) write_o((bf16_t*)(ws + WS_KCMP) + (size_t)(b * 256 + n) * 64, out, keep, h);
    else {
        bf16_t* vt = (bf16_t*)(ws + WS_VCMPT) + (size_t)(b * 64) * 256 + n;
#pragma unroll
        for (int dt = 0; dt < 2; ++dt)
#pragma unroll
            for (int i = 0; i < 16; ++i) vt[(size_t)(32 * dt + 8 * (i >> 2) + 4 * h + (i & 3)) * 256] = (bf16_t)(pk2(out[dt][i] * keep, 0.f) & 0xffffu);
    }
}

struct Args { const float* in[9]; float* out; unsigned char* ws; int pad0, pad1; };

DI int launder(int x) { asm volatile("" : "+v"(x)); return x; }
DI unsigned char* launder_p(unsigned char* p) { asm volatile("" : "+s"(p)); return (unsigned char*)(__attribute__((address_space(1))) unsigned char*)p; }
#define FRESH() const int tid = launder(tid0), lane = tid & 63, gw = blockIdx.x * NWAVES + wave; (void)gw; (void)lane; unsigned char* ws = launder_p(ws0); (void)ws;
DI int next_task(unsigned* ctr, int lane) {
    int v = 0;
    if (lane == 0) v = (int)atomicAdd(ctr, 1u);
    return __builtin_amdgcn_readfirstlane(v);
}

enum { ST_P0 = 0, ST_BIAS, ST_G_QK, ST_G_VT, ST_P2, ST_P3, ST_P4, ST_G_GATE, ST_G_U0, ST_G_M0, ST_G_U1, ST_G_M1, ST_G_U2, ST_G_M2, ST_G_U3, ST_G_M3, ST_G_OUT, NSTEP_LAYER };

__global__ void __launch_bounds__(NWAVES * 64, 2) mega_fwd(Args a) {
    extern __shared__ __attribute__((aligned(16))) unsigned char lds_raw[];
    cg::grid_group grid = cg::this_grid();
    LAS unsigned char* lds = (LAS unsigned char*)lds_raw;
    const int tid0 = threadIdx.x, wave = __builtin_amdgcn_readfirstlane(tid0 >> 6);
    const int G = gridDim.x, NGW = G * NWAVES;
    unsigned char* ws0 = a.ws;

    { FRESH();
    for (int e = blockIdx.x * (NWAVES * 64) + tid; e < SEQ * 32; e += G * NWAVES * 64) {
        const int pos = e >> 5, i = e & 31;
        const float inv = (float)exp2(-(double)i * (13.287712379549449 / 32.0));
        const float ang = (float)pos * inv;
        const double x = (double)ang, kq = rint(x * 0.6366197723675814);
        const double rr = (x - kq * 1.5707963267948966) - kq * 6.123233995736766e-17, r2 = rr * rr;
        const double sn = rr * (1.0 + r2 * (-1.0 / 6 + r2 * (1.0 / 120 + r2 * (-1.0 / 5040 + r2 * (1.0 / 362880 + r2 * (-1.0 / 39916800 + r2 * (1.0 / 6227020800.0)))))));
        const double cs = 1.0 + r2 * (-0.5 + r2 * (1.0 / 24 + r2 * (-1.0 / 720 + r2 * (1.0 / 40320 + r2 * (-1.0 / 3628800 + r2 * (1.0 / 479001600 + r2 * (-1.0 / 87178291200.0)))))));
        const int qd = (int)((long long)kq & 3);
        const double s_ = qd == 0 ? sn : qd == 1 ? cs : qd == 2 ? -sn : -cs, c_ = qd == 0 ? cs : qd == 1 ? -sn : qd == 2 ? -cs : sn;
        ((float*)(ws + WS_COS))[e] = (float)c_; ((float*)(ws + WS_SIN))[e] = (float)s_;
    } }

    for (int step = 0; step <= DEPTH * NSTEP_LAYER; ++step) {
        const int layer = step / NSTEP_LAYER, ls = step - layer * NSTEP_LAYER;
        if (layer == DEPTH) {
            FRESH(); const float* fw = a.in[8];
            for (int m = gw; m < T; m += NGW) {
                f32x4* xr = (f32x4*)(a.out + (size_t)m * D) + lane; const f32x4* wr4 = (const f32x4*)fw + lane;
                f32x4 v[4]; float s = 0.f;
#pragma unroll
                for (int j = 0; j < 4; ++j) { v[j] = xr[64 * j]; s += (v[j].x * v[j].x + v[j].y * v[j].y) + (v[j].z * v[j].z + v[j].w * v[j].w); }
                const float rs = rsqrtf(wave_sum(s) * (1.f / D) + 1e-6f);
#pragma unroll
                for (int j = 0; j < 4; ++j) { const f32x4 w = wr4[64 * j]; xr[64 * j] = (f32x4){v[j].x * rs * w.x, v[j].y * rs * w.y, v[j].z * rs * w.z, v[j].w * rs * w.w}; }
            }
            break;
        }
        const float* xin = layer == 0 ? a.in[0] : a.out;
        bool sync = false;
        if (ls == ST_P0) {
            const float* norm_w = a.in[1] + (size_t)layer * D;
            const float* w_in = a.in[2] + (size_t)layer * D * INW;
            const float* cmp_pos = a.in[3] + (size_t)layer * 2 * 2048;
            const float* cmp_w1 = a.in[4] + (size_t)layer * 2 * 2048 * 256;
            const float* cmp_w2 = a.in[5] + (size_t)layer * 2 * 256 * 64;
            const float* w_up = a.in[6] + (size_t)layer * 4 * 256 * D;
            const float* w_out = a.in[7] + (size_t)layer * D * D;
            FRESH(); LAS float* scr = (LAS float*)(lds + wave * 16384); bf16_t* Hb = (bf16_t*)(ws + WS_H);
            constexpr int I_QK = 16 * (NQK / 32), I_V = 16 * (NV / 32), I_G = 16 * 32, I_M = 16 * 128, I_UP = 4 * 4 * 32, I_OUT = 16 * 32, I_W1 = 2 * 32 * 8, I_W2 = 2 * 4 * 2;
            constexpr int NITEMS = I_QK + I_V + I_G + I_M + I_UP + I_OUT + I_W1 + I_W2;
            for (int it = gw; it < NITEMS; it += NGW) {
                int q = it;
                if (q < I_QK) { const int kb = q / (NQK / 32), nb = q % (NQK / 32); transpose_item(w_in, D, INW, (bf16_t*)(ws + WS_WQK), 64 * kb, 32 * nb, src_qk(32 * nb + (lane & 31)), scr, lane); continue; } q -= I_QK;
                if (q < I_V) { const int kb = q / (NV / 32), nb = q % (NV / 32); transpose_item(w_in, D, INW, (bf16_t*)(ws + WS_WV), 64 * kb, 32 * nb, src_v(32 * nb + (lane & 31)), scr, lane); continue; } q -= I_V;
                if (q < I_G) { const int kb = q / 32, nb = q % 32; transpose_item(w_in, D, INW, (bf16_t*)(ws + WS_WG), 64 * kb, 32 * nb, src_g(32 * nb + (lane & 31)), scr, lane); continue; } q -= I_G;
                if (q < I_M) { const int kb = q / 128, nb = q % 128; transpose_item(w_in, D, INW, (bf16_t*)(ws + WS_WM), 64 * kb, 32 * nb, MRG + 32 * nb + (lane & 31), scr, lane); continue; } q -= I_M;
                if (q < I_UP) { const int br = q / 128, q2 = q % 128, kb = q2 / 32, nb = q2 % 32; transpose_item(w_up + (size_t)br * 256 * D, 256, D, (bf16_t*)(ws + WS_WUP) + (size_t)br * D * 256, 64 * kb, 32 * nb, 32 * nb + (lane & 31), scr, lane); continue; } q -= I_UP;
                if (q < I_OUT) { const int kb = q / 32, nb = q % 32; transpose_item(w_out, D, D, (bf16_t*)(ws + WS_WOUT), 64 * kb, 32 * nb, 32 * nb + (lane & 31), scr, lane); continue; } q -= I_OUT;
                if (q < I_W1) { const int kv = q / 256, q2 = q % 256, kb = q2 / 8, nb = q2 % 8; transpose_item(cmp_w1 + (size_t)kv * 2048 * 256, 2048, 256, (bf16_t*)(ws + WS_W1T) + (size_t)kv * 256 * 2048, 64 * kb, 32 * nb, 32 * nb + (lane & 31), scr, lane); continue; } q -= I_W1;
                { const int kv = q / 8, q2 = q % 8, kb = q2 / 2, nb = q2 % 2; transpose_item(cmp_w2 + (size_t)kv * 256 * 64, 256, 64, (bf16_t*)(ws + WS_W2T) + (size_t)kv * 64 * 256, 64 * kb, 32 * nb, 32 * nb + (lane & 31), scr, lane); }
            }
            for (int it = gw; it < 2 * 4 * 32; it += NGW) {
                const int ch = it & 31, hg = (it >> 5) & 3, kv = it >> 7;
                const float* w1 = cmp_w1 + (size_t)kv * 2048 * 256 + (size_t)(64 * ch) * 256 + 64 * hg + lane; const float* pe = cmp_pos + kv * 2048 + 64 * ch;
                float s = 0.f;
#pragma unroll 8
                for (int f = 0; f < 64; ++f) s += pe[f] * w1[(size_t)f * 256];
                ((float*)(ws + WS_BIASP))[(ch * 2 + kv) * 256 + 64 * hg + lane] = s;
            }
            for (int m = gw; m < T; m += NGW) {
                const f32x4* xr = (const f32x4*)(xin + (size_t)m * D) + lane; const f32x4* wr4 = (const f32x4*)norm_w + lane;
                f32x4 v[4]; float s = 0.f;
#pragma unroll
                for (int j = 0; j < 4; ++j) { v[j] = xr[64 * j]; s += (v[j].x * v[j].x + v[j].y * v[j].y) + (v[j].z * v[j].z + v[j].w * v[j].w); }
                const float rs = rsqrtf(wave_sum(s) * (1.f / D) + 1e-6f);
                u32x2* o8 = (u32x2*)(Hb + (size_t)m * D) + lane;
#pragma unroll
                for (int j = 0; j < 4; ++j) { const f32x4 w = wr4[64 * j]; u32x2 o; o.x = pk2(v[j].x * rs * w.x, v[j].y * rs * w.y); o.y = pk2(v[j].z * rs * w.z, v[j].w * rs * w.w); o8[64 * j] = o; }
            }
            sync = true;
        } else if (ls == ST_BIAS) {
            FRESH();
            if (blockIdx.x == 0) { float s = 0.f; for (int c = 0; c < 32; ++c) s += ((const float*)(ws + WS_BIASP))[c * 512 + tid]; ((float*)(ws + WS_BIAS))[tid] = s; }
        } else if (ls == ST_P2) {
            FRESH();
            for (int it = gw; it < 128 + 512; it += NGW) {
                if (it < 128) task_mlp(ws, it >> 6, (it >> 3) & 7, it & 7, lane);
                else { const int q = it - 128; task_kmean(ws, q >> 6, (q >> 4) & 3, q & 15, lane); }
            }
            sync = true;
        } else if (ls == ST_P3) {
            FRESH();
            for (int it = gw; it < 1024 + 4096; it += NGW) {
                if (it < 1024) { const int q = 1023 - it; task_cmp(ws, q & 7, q >> 3, lane, (LAS float*)(lds + wave * 16384)); }
                else { const int q = it - 1024; task_moba_gate(ws, q & 7, (q >> 3) & 3, q >> 5, lane); }
            }
            sync = true;
        } else if (ls == ST_P4) {
            FRESH(); unsigned* ctr = (unsigned*)(ws + WS_CTL) + layer * 64;
            for (;;) {
                const int it = next_task(ctr, lane);
                if (it >= 8192 + 4096 + 12288) break;
                if (it < 8192) { const int qt = 127 - (it >> 6), w = it & 63, b = w & 7, hh = (w >> 3) & 3; if (w < 32) task_nsa_sw(ws, b, hh, qt, lane); else task_moba(ws, b, hh, qt, lane); }
                else if (it < 8192 + 4096) { const int q = it - 8192; task_stick(ws, q & 7, (q >> 3) & 3, 127 - (q >> 5), lane); }
                else {
                    const int q = it - 12288, g = q >> 12, w = q & 4095, b = w & 7, hd = (w >> 3) & 3, ti = w >> 5;
                    const int dil = g == 0 ? 1 : g == 1 ? 4 : 16, nsub = 128 / dil;
                    task_dil(ws, g, b, hd, ti / nsub, ti % nsub, lane);
                }
            }
            sync = true;
        } else {
            unsigned char* ws = launder_p(ws0); bf16_t* Hb = (bf16_t*)(ws + WS_H);
            pg8::Gemm g; Epi E{0, 0, ws, xin, a.out};
            if (ls == ST_G_QK) { g = pg8::Gemm{Hb, (const bf16_t*)(ws + WS_WQK), T, NQK, D}; E.kind = 0; }
            else if (ls == ST_G_VT) { g = pg8::Gemm{(const bf16_t*)(ws + WS_WV), Hb, NV, T, D}; E.kind = 1; sync = true; }
            else if (ls == ST_G_GATE) { g = pg8::Gemm{Hb, (const bf16_t*)(ws + WS_WG), T, D, D}; E.kind = 2; sync = true; }
            else if (ls == ST_G_OUT) { g = pg8::Gemm{(const bf16_t*)(ws + WS_Y), (const bf16_t*)(ws + WS_WOUT), T, D, D}; E.kind = 5; sync = true; }
            else {
                const int k = ls - ST_G_U0, br = k >> 1;
                const int wslot = br == 0 ? SL_QA : br == 1 ? SL_QB : br == 2 ? SL_QC : SL_QD0;
                if ((k & 1) == 0) { g = pg8::Gemm{slot_ptr(ws, wslot), (const bf16_t*)(ws + WS_WUP) + (size_t)br * D * 256, T, D, 256}; E.kind = 3; }
                else { g = pg8::Gemm{Hb, (const bf16_t*)(ws + WS_WM) + (size_t)br * D * D, T, D, D}; E.kind = 4; E.first = (br == 0); sync = (br == 3); }
            }
            pg8::StaticOrder S; S.init(g.M, g.N, G, (int)blockIdx.x);
            pg8::gemm_phase<Epi, pg8::StaticOrder, true, true>(lds, g, S, E);
        }
        if (sync) grid.sync();
    }
}

extern "C" void kernel_launch(void* const* d_in, const int* in_sizes, int n_in, void* d_out, int out_size, void* d_ws, size_t ws_size, hipStream_t stream) {
    static int grid = 0;
    if (grid == 0) {
        int dev = 0, cus = 0, per_cu = 0;
        hipGetDevice(&dev);
        hipDeviceGetAttribute(&cus, hipDeviceAttributeMultiprocessorCount, dev);
        hipFuncSetAttribute((const void*)mega_fwd, hipFuncAttributeMaxDynamicSharedMemorySize, LDS_BYTES);
        hipOccupancyMaxActiveBlocksPerMultiprocessor(&per_cu, (const void*)mega_fwd, NWAVES * 64, LDS_BYTES);
        (void)hipGetLastError();
        grid = cus;
        if (n_in != 9 || out_size != T * D || ws_size < WS_END || per_cu < 1) { fprintf(stderr, "kernel_launch: unexpected problem (n_in %d out %d ws %zu per_cu %d)\n", n_in, out_size, ws_size, per_cu); grid = -1; }
    }
    if (grid < 0) return;
    hipMemsetAsync((char*)d_ws + WS_CTL, 0, CTL_BYTES, stream);
    Args a{};
    for (int i = 0; i < 9; ++i) a.in[i] = (const float*)d_in[i];
    a.out = (float*)d_out; a.ws = (unsigned char*)d_ws;
    void* args[] = {&a};
    hipError_t e = hipLaunchCooperativeKernel((const void*)mega_fwd, dim3(grid), dim3(NWAVES * 64), args, LDS_BYTES, stream);
    if (e != hipSuccess) fprintf(stderr, "cooperative launch failed: %s\n", hipGetErrorString(e));
}
```

```cpp
#include <hip/hip_runtime.h>
#include <hip/hip_cooperative_groups.h>
#include <cstdio>
#include <cstdint>
namespace cg = cooperative_groups;
__device__ __forceinline__ int launder_i(int x) { asm volatile("" : "+v"(x)); return x; }
namespace pg8 {
#define PG8_LAS __attribute__((address_space(3)))
typedef unsigned short bf16_t;
typedef short bf16x8 __attribute__((ext_vector_type(8)));
typedef float f32x4 __attribute__((ext_vector_type(4)));
typedef unsigned u32x4 __attribute__((ext_vector_type(4)));
constexpr int BM = 256, BK = 64, HALF = 128, HTB = HALF * BK * 2  , STAGE_BYTES = 8 * HTB, NXCD = 8, WGM = 8;

__host__ __device__ __forceinline__ int lds_byte(int r, int c) { const int st = (r >> 4) * 2 + (c >> 5), rr = r & 15, cc = c & 31, ob = rr * 64 + cc * 2; return st * 1024 + (ob ^ (((ob >> 9) & 1) << 5)); }
__host__ __device__ __forceinline__ void stage_rc(int b, int& R, int& C) { const int st = b / 1024, sb = b % 1024, swz = sb ^ (((sb >> 9) & 1) << 5); R = (st >> 1) * 16 + swz / 64; C = (st & 1) * 32 + (swz % 64) / 2; }
__host__ __device__ __forceinline__ int perm32(int rho) { const int n = rho >> 4, i = rho & 15; return 8 * (i >> 2) + 4 * n + (i & 3); }

struct Unit { int pm, pn; };
struct Gemm { const bf16_t* A; const bf16_t* Bt; int M, N, K; };

struct StaticOrder {
    int nM, nN, nwg, G, c, split;
    __host__ __device__ void init(int M, int N, int G_, int c_) { nM = M / BM; nN = N / BM; nwg = nM * nN; G = G_; c = c_; split = 0; }
    __host__ __device__ bool next(int i, Unit& u) const {
        if (split) {
            const int per = c < split ? 2 : 4; if (i >= per) return false;
            const int L2 = c < split ? 2 * c + i : 2 * split + 4 * (c - split) + i;
            u.pm = L2 % nM; u.pn = L2 / nM; return true;
        }
        const long L = (long)i * G + c; if (L >= nwg) return false;
        int wgid = (int)L; { const int q = nwg / NXCD, r = nwg % NXCD, xcd = wgid % NXCD, off = wgid / NXCD; wgid = (xcd < r ? xcd * (q + 1) : r * (q + 1) + (xcd - r) * q) + off; }
        const int nig = WGM * nN, gid = wgid / nig, fm = gid * WGM, gsz = (nM - fm) < WGM ? (nM - fm) : WGM;
        u.pm = fm + ((wgid % nig) % gsz); u.pn = (wgid % nig) / gsz; return true;
    }
    __device__ __forceinline__ void a_ready(const Unit&) const {}
    __device__ __forceinline__ void done(const Unit&) const {}
};

__device__ __forceinline__ unsigned cvt_pk_bf16(float lo, float hi) { unsigned r; asm volatile("v_cvt_pk_bf16_f32 %0, %1, %2" : "=v"(r) : "v"(lo), "v"(hi)); return r; }
template <class Epi, class Sched, bool ALIGN_EPI = false, bool SP2 = false>
__device__ __forceinline__ void gemm_phase(PG8_LAS unsigned char* lds, const Gemm g, const Sched& S, const Epi& E) {
    const int tid = launder_i((int)threadIdx.x), wid = __builtin_amdgcn_readfirstlane(tid >> 6), lane = tid & 63, wr = wid >> 2, wc = wid & 3, fr = lane & 15, fq = lane >> 4;
    const int K = g.K, nt = K / BK;
    unsigned voffA[2], voffB[2];
#pragma unroll
    for (int i = 0; i < 2; ++i) { int R, C; stage_rc(tid * 16 + i * 8192, R, C); const int Rb = Epi::PERM ? ((R & ~31) + perm32(R & 31)) : R;
        voffA[i] = (unsigned)(R * K + C) * 2u; voffB[i] = (unsigned)(Rb * K + C) * 2u; }
    const size_t kstep = (size_t)(BK * 2);
    const size_t hstep = (size_t)HALF * K * 2;
    const size_t tstep = 2 * hstep;
    const unsigned ldsw = (unsigned)wid * 1024u;
    const int aoff = lds_byte(wr * 64 + fr, fq * 8), boff = lds_byte(wc * 32 + fr, fq * 8);
#define PG8_SA(b, h) (((b) * 2 + (h)) * HTB)
#define PG8_SB(b, h) ((4 + (b) * 2 + (h)) * HTB)
#define PG8_STAGE(bufoff, gbase, voff) do { _Pragma("unroll") for (int _i = 0; _i < 2; ++_i) \
        __builtin_amdgcn_global_load_lds((const unsigned*)((const char*)(gbase) + (voff)[_i]), (PG8_LAS unsigned*)(lds + (bufoff) + ldsw + _i * 8192), 16, 0, 0); } while (0)
#define PG8_LDA(dst, b, h) do { _Pragma("unroll") for (int m = 0; m < 4; ++m) _Pragma("unroll") for (int k = 0; k < 2; ++k) dst[m][k] = *(const PG8_LAS bf16x8*)(lds + PG8_SA(b, h) + aoff + m * 2048 + k * 1024); } while (0)
#define PG8_LDB(dst, b, h) do { _Pragma("unroll") for (int n = 0; n < 2; ++n) _Pragma("unroll") for (int k = 0; k < 2; ++k) dst[n][k] = *(const PG8_LAS bf16x8*)(lds + PG8_SB(b, h) + boff + n * 2048 + k * 1024); } while (0)
#define PG8_MMA(ai, bj, At, Bt) do { __builtin_amdgcn_s_setprio(1); _Pragma("unroll") for (int m = 0; m < 4; ++m) _Pragma("unroll") for (int n = 0; n < 2; ++n) _Pragma("unroll") for (int k = 0; k < 2; ++k) \
        acc[ai][bj][m][n] = __builtin_amdgcn_mfma_f32_16x16x32_bf16(Bt[n][k], At[m][k], acc[ai][bj][m][n], 0, 0, 0); __builtin_amdgcn_s_setprio(0); } while (0)
#define PG8_WAIT_V(n) asm volatile("s_waitcnt vmcnt(" #n ")" ::: "memory")
#define PG8_WAIT_L(n) asm volatile("s_waitcnt lgkmcnt(" #n ")" ::: "memory")
#define PG8_BAR __builtin_amdgcn_s_barrier()
#define PG8_SCHED __builtin_amdgcn_sched_barrier(0)
    Unit cur, nxt; int ui = 0;
    if (!S.next(0, cur)) return;
    f32x4 acc[2][2][4][2];
#pragma unroll
    for (int a = 0; a < 2; ++a)
#pragma unroll
        for (int b = 0; b < 2; ++b)
#pragma unroll
            for (int m = 0; m < 4; ++m)
#pragma unroll
                for (int n = 0; n < 2; ++n) acc[a][b][m][n] = (f32x4){0.f, 0.f, 0.f, 0.f};
    bf16x8 At[4][2], B0[2][2], B1[2][2];
    const char* cA = (const char*)g.A + (size_t)cur.pm * tstep; const char* cB = (const char*)g.Bt + (size_t)cur.pn * tstep;
    S.a_ready(cur);
    if constexpr (SP2) {
        PG8_STAGE(PG8_SB(0, 0), cB, voffB); PG8_STAGE(PG8_SB(0, 1), cB + hstep, voffB); PG8_STAGE(PG8_SA(0, 0), cA, voffA); PG8_STAGE(PG8_SA(0, 1), cA + hstep, voffA);
        if (wr == 1) PG8_BAR;
        PG8_WAIT_V(2); PG8_BAR;
        PG8_STAGE(PG8_SB(1, 0), cB + kstep, voffB); PG8_STAGE(PG8_SA(1, 0), cA + kstep, voffA); PG8_STAGE(PG8_SB(1, 1), cB + hstep + kstep, voffB);
        PG8_WAIT_V(6); PG8_BAR;
    } else {
        PG8_STAGE(PG8_SB(0, 0), cB, voffB); PG8_STAGE(PG8_SA(0, 0), cA, voffA); PG8_STAGE(PG8_SB(0, 1), cB + hstep, voffB); PG8_STAGE(PG8_SA(0, 1), cA + hstep, voffA);
        if (wr == 1) PG8_BAR;
        PG8_WAIT_V(4); PG8_BAR;
        PG8_STAGE(PG8_SB(1, 0), cB + kstep, voffB); PG8_STAGE(PG8_SA(1, 0), cA + kstep, voffA); PG8_STAGE(PG8_SB(1, 1), cB + hstep + kstep, voffB);
        PG8_WAIT_V(6); PG8_BAR;
    }
    for (;;) {
        const bool has_next = S.next(ui + 1, nxt);
        const char* nA = has_next ? (const char*)g.A + (size_t)nxt.pm * tstep : cA; const char* nB = has_next ? (const char*)g.Bt + (size_t)nxt.pn * tstep : cB;
        for (int t = 0; t < nt; t += 2) {
            const bool last = (t == nt - 2);
            const char* a1 = cA + (size_t)(t + 1) * kstep;
            const char* a2 = last ? nA : cA + (size_t)(t + 2) * kstep; const char* b2 = last ? nB : cB + (size_t)(t + 2) * kstep;
            const char* a3 = a2 + kstep; const char* b3 = b2 + kstep;
            if (last && has_next) S.a_ready(nxt);
            if constexpr (SP2) {
            PG8_LDB(B0, 0, 0); PG8_LDB(B1, 0, 1); PG8_SCHED; PG8_LDA(At, 0, 0); PG8_STAGE(PG8_SA(1, 1), a1 + hstep, voffA);
            PG8_WAIT_V(8); PG8_WAIT_L(0); PG8_BAR; PG8_MMA(0, 0, At, B0); PG8_MMA(0, 1, At, B1); PG8_BAR; PG8_SCHED;
            PG8_LDA(At, 0, 1); PG8_STAGE(PG8_SB(0, 0), b2, voffB); PG8_STAGE(PG8_SB(0, 1), b2 + hstep, voffB); PG8_STAGE(PG8_SA(0, 0), a2, voffA);
            PG8_WAIT_V(8); PG8_WAIT_L(0); PG8_BAR; PG8_MMA(1, 0, At, B0); PG8_MMA(1, 1, At, B1); PG8_BAR; PG8_SCHED;
            PG8_LDB(B0, 1, 0); PG8_LDB(B1, 1, 1); PG8_SCHED; PG8_LDA(At, 1, 0); PG8_STAGE(PG8_SA(0, 1), a2 + hstep, voffA);
            PG8_WAIT_V(8); PG8_WAIT_L(0); PG8_BAR; PG8_MMA(0, 0, At, B0); PG8_MMA(0, 1, At, B1); PG8_BAR; PG8_SCHED;
            PG8_LDA(At, 1, 1); PG8_STAGE(PG8_SB(1, 0), b3, voffB); PG8_STAGE(PG8_SB(1, 1), b3 + hstep, voffB); PG8_STAGE(PG8_SA(1, 0), a3, voffA);
            PG8_WAIT_V(8); PG8_WAIT_L(0); PG8_BAR; PG8_MMA(1, 0, At, B0); PG8_MMA(1, 1, At, B1); PG8_BAR; PG8_SCHED;
            } else {
            PG8_LDB(B0, 0, 0); PG8_SCHED; PG8_LDA(At, 0, 0); PG8_STAGE(PG8_SA(1, 1), a1 + hstep, voffA);
            PG8_WAIT_L(8); PG8_BAR; PG8_WAIT_L(0); PG8_MMA(0, 0, At, B0); PG8_BAR; PG8_SCHED;
            PG8_LDB(B1, 0, 1); PG8_STAGE(PG8_SB(0, 0), b2, voffB);
            PG8_BAR; PG8_WAIT_L(0); PG8_MMA(0, 1, At, B1); PG8_BAR;
            PG8_LDA(At, 0, 1); PG8_STAGE(PG8_SA(0, 0), a2, voffA);
            PG8_BAR; PG8_WAIT_L(0); PG8_MMA(1, 0, At, B0); PG8_BAR; PG8_SCHED;
            PG8_STAGE(PG8_SB(0, 1), b2 + hstep, voffB);
            PG8_WAIT_V(6); PG8_BAR; PG8_MMA(1, 1, At, B1); PG8_BAR;
            PG8_LDB(B0, 1, 0); PG8_SCHED; PG8_LDA(At, 1, 0); PG8_STAGE(PG8_SA(0, 1), a2 + hstep, voffA);
            PG8_WAIT_L(8); PG8_BAR; PG8_WAIT_L(0); PG8_MMA(0, 0, At, B0); PG8_BAR; PG8_SCHED;
            PG8_LDB(B1, 1, 1); PG8_STAGE(PG8_SB(1, 0), b3, voffB);
            PG8_BAR; PG8_WAIT_L(0); PG8_MMA(0, 1, At, B1); PG8_BAR;
            PG8_LDA(At, 1, 1); PG8_STAGE(PG8_SA(1, 0), a3, voffA);
            PG8_BAR; PG8_WAIT_L(0); PG8_MMA(1, 0, At, B0); PG8_BAR; PG8_SCHED;
            PG8_STAGE(PG8_SB(1, 1), b3 + hstep, voffB);
            PG8_WAIT_V(6); PG8_BAR; PG8_MMA(1, 1, At, B1); PG8_BAR;
            }
        }
        if constexpr (ALIGN_EPI) { if (wr == 0) PG8_BAR; }
        if constexpr (!Epi::AFTER_DRAIN) { E(acc, cur, wr, wc, fr, fq); S.done(cur); }
        if (!has_next) break;
#pragma unroll
        for (int a = 0; a < 2; ++a)
#pragma unroll
            for (int b = 0; b < 2; ++b)
#pragma unroll
                for (int m = 0; m < 4; ++m)
#pragma unroll
                    for (int n = 0; n < 2; ++n) acc[a][b][m][n] = (f32x4){0.f, 0.f, 0.f, 0.f};
        cur = nxt; cA = nA; cB = nB; ++ui;
        if constexpr (ALIGN_EPI) { if (wr == 1) PG8_BAR; }
    }
    PG8_WAIT_V(0);
    if constexpr (!ALIGN_EPI) { if (wr == 0) PG8_BAR; }
    PG8_BAR;
    if constexpr (Epi::AFTER_DRAIN) { E.fused(acc, cur, wr, wc, fr, fq, lds, wid, lane); S.done(cur); }
#undef PG8_SA
#undef PG8_SB
#undef PG8_STAGE
#undef PG8_LDA
#undef PG8_LDB
#undef PG8_MMA
#undef PG8_WAIT_V
#undef PG8_WAIT_L
#undef PG8_BAR
#undef PG8_SCHED
}
}

constexpr int NWAVES = 8;
constexpr int LDS_BYTES = 135168;
constexpr int NB = 8, SEQ = 4096, T = NB * SEQ, D = 1024, INW = 9612, DEPTH = 2;
constexpr int A_Q = 0, A_K = 256, A_V = 512, A_G = 768, B_Q = 1024, B_KC = 1280, B_VC = 1344, B_KS = 1408, B_VS = 1472, B_KW = 1536, B_VW = 1600, B_G = 1664, B_NG = 1920,
              C_Q = 1932, C_K = 2188, C_V = 2444, C_G = 2700, D_Q = 2956, D_K = 3724, D_V = 4492, D_G = 5260, MRG = 5516;
constexpr size_t MiB = 1u << 20, KiB = 1024;
constexpr size_t WS_CTL = 0, WS_COS = 1 * MiB, WS_SIN = 1 * MiB + 512 * KiB, WS_KMEAN = 2 * MiB, WS_BIASP = 2 * MiB + 128 * KiB, WS_BIAS = 2 * MiB + 192 * KiB,
                 WS_KCMP = 2 * MiB + 512 * KiB, WS_VCMPT = 2 * MiB + 768 * KiB, WS_MMASK = 3 * MiB, WS_NMASK = 3 * MiB + 512 * KiB, WS_LSE = 4 * MiB,
                 WS_W1T = 6 * MiB, WS_W2T = 8 * MiB, WS_WQK = 9 * MiB, WS_WV = 15 * MiB, WS_WG = 18 * MiB, WS_WM = 20 * MiB, WS_WUP = 28 * MiB, WS_WOUT = 30 * MiB,
                 WS_H = 32 * MiB, WS_QK = 96 * MiB, WS_VT = 320 * MiB, WS_U = 320 * MiB, WS_Y = 224 * MiB, WS_END = 432 * MiB;
constexpr size_t SLOT_BYTES = 16 * MiB;
constexpr int SL_QA = 0, SL_QB = 1, SL_QC = 2, SL_QD0 = 3, SL_QBR = 4, SL_QD1 = 5, SL_QD2 = 6, SL_OWIN = 7, SL_KA = 8, SL_KB4 = 9, SL_KC = 10, SL_KD0 = 11, SL_OSLC = 20;
constexpr int NQK = 3072, NV = 1536;
constexpr int CTL_BYTES = 4096;

typedef unsigned short bf16_t;
typedef short bf16x8 __attribute__((ext_vector_type(8)));
typedef float f32x4 __attribute__((ext_vector_type(4)));
typedef float f32x2 __attribute__((ext_vector_type(2)));
typedef float f32x16 __attribute__((ext_vector_type(16)));
typedef unsigned u32x4 __attribute__((ext_vector_type(4)));
typedef unsigned u32x2 __attribute__((ext_vector_type(2)));
typedef __bf16 bf16v2 __attribute__((ext_vector_type(2)));
#define LAS __attribute__((address_space(3)))
#define GAS __attribute__((address_space(1)))
#define DI __device__ __forceinline__
#define MFMA32(a, b, c) __builtin_amdgcn_mfma_f32_32x32x16_bf16((a), (b), (c), 0, 0, 0)

constexpr float LOG2E = 1.4426950408889634f, LN2 = 0.6931471805599453f;
DI float sconst(float x) { asm volatile("" : "+s"(x)); return x; }
constexpr float SM_SCALE = 0.125f, SM_C = 0.125f * LOG2E, NEG_C = -1e30f, MFLOOR_C = -30000.f;
#define NEG sconst(NEG_C)
#define MFLOOR sconst(MFLOOR_C)

DI unsigned pk2(float lo, float hi) { const bf16v2 r = __builtin_convertvector((f32x2){lo, hi}, bf16v2); return __builtin_bit_cast(unsigned, r); }
DI float bf_lo(unsigned w) { return __uint_as_float(w << 16); }
DI float bf_hi(unsigned w) { return __uint_as_float(w & 0xffff0000u); }
DI float bf1(bf16_t x) { return __uint_as_float((unsigned)x << 16); }
DI float fexp2(float x) { return __builtin_amdgcn_exp2f(x); }
DI float flog2(float x) { return __builtin_amdgcn_logf(x); }
DI float frcp(float x) { return __builtin_amdgcn_rcpf(x); }
DI float sigmoidf_(float x) { return frcp(1.f + fexp2(-x * LOG2E)); }
DI float wave_sum(float v) {
#pragma unroll
    for (int o = 1; o < 64; o <<= 1) v += __shfl_xor(v, o);
    return v;
}
DI float xhalf(float v) { return __shfl_xor(v, 32); }
DI float hmaxf_(float v) { const auto r = __builtin_amdgcn_permlane32_swap(__float_as_uint(v), __float_as_uint(v), false, false); return fmaxf(__uint_as_float(r[0]), __uint_as_float(r[1])); }
DI float hsumf_(float v) { const auto r = __builtin_amdgcn_permlane32_swap(__float_as_uint(v), __float_as_uint(v), false, false); return __uint_as_float(r[0]) + __uint_as_float(r[1]); }
DI bf16_t* slot_ptr(unsigned char* ws, int s) { return (bf16_t*)(ws + WS_QK + (size_t)s * SLOT_BYTES); }
DI void load8(const bf16_t* p, float (&f)[8]) { const u32x4 w = *(const GAS u32x4*)p; f[0] = bf_lo(w.x); f[1] = bf_hi(w.x); f[2] = bf_lo(w.y); f[3] = bf_hi(w.y); f[4] = bf_lo(w.z); f[5] = bf_hi(w.z); f[6] = bf_lo(w.w); f[7] = bf_hi(w.w); }
DI void store8(bf16_t* p, const float (&f)[8]) { u32x4 w; w.x = pk2(f[0], f[1]); w.y = pk2(f[2], f[3]); w.z = pk2(f[4], f[5]); w.w = pk2(f[6], f[7]); *(GAS u32x4*)p = w; }
DI void store4(bf16_t* p, float a, float b, float c, float d) { u32x2 w; w.x = pk2(a, b); w.y = pk2(c, d); *(GAS u32x2*)p = w; }

struct Epi {
    static constexpr bool PERM = true, AFTER_DRAIN = false;
    int kind, first; unsigned char* ws; const float* xin; float* xout;
    typedef pg8::f32x4 a4;
    DI void operator()(const a4 (&acc)[2][2][4][2], const pg8::Unit& u, int wr, int wc, int fr, int fq) const {
        if (kind == 0) {
            const int tile = u.pn;
            const int slot = (int)((0xDCB653A29180ull >> (4 * tile)) & 15ull);
            bf16_t* dst = slot_ptr(ws, slot); bf16_t* dst2 = slot_ptr(ws, SL_QBR);
            const bool ropeall = (tile <= 1) || (tile >= 6);
            const int g = 4 * (wc & 1) + fq, d0 = 4 * g;
            const float* cosT = (const float*)(ws + WS_COS); const float* sinT = (const float*)(ws + WS_SIN);
#pragma unroll
            for (int ai = 0; ai < 2; ++ai)
#pragma unroll
                for (int m = 0; m < 4; ++m) {
                    const int tok = u.pm * 256 + ai * 128 + wr * 64 + m * 16 + fr, pos = tok & (SEQ - 1);
                    const f32x4 cs = *(const GAS f32x4*)(cosT + pos * 32 + d0), sn = *(const GAS f32x4*)(sinT + pos * 32 + d0);
#pragma unroll
                    for (int bj = 0; bj < 2; ++bj) {
                        const int hs = 2 * bj + (wc >> 1);
                        const a4 v0 = acc[ai][bj][m][0], v1 = acc[ai][bj][m][1];
                        const a4 r0 = v0 * cs - v1 * sn, r1 = v0 * sn + v1 * cs;
                        const size_t off = (size_t)tok * 256 + hs * 64 + d0;
                        const bool rope = ropeall || (tile == 3 && hs >= 2);
                        if (tile == 2) { store4(dst + off, v0[0], v0[1], v0[2], v0[3]); store4(dst + off + 32, v1[0], v1[1], v1[2], v1[3]);
                                         store4(dst2 + off, r0[0], r0[1], r0[2], r0[3]); store4(dst2 + off + 32, r1[0], r1[1], r1[2], r1[3]); }
                        else if (rope) { store4(dst + off, r0[0], r0[1], r0[2], r0[3]); store4(dst + off + 32, r1[0], r1[1], r1[2], r1[3]); }
                        else { store4(dst + off, v0[0], v0[1], v0[2], v0[3]); store4(dst + off + 32, v1[0], v1[1], v1[2], v1[3]); }
                    }
                    asm volatile("" ::: "memory");
                }
        } else if (kind == 1) {
            bf16_t* VT = (bf16_t*)(ws + WS_VT);
#pragma unroll
            for (int ai = 0; ai < 2; ++ai)
#pragma unroll
                for (int m = 0; m < 4; ++m) {
                    const int r = u.pm * 256 + ai * 128 + wr * 64 + m * 16 + fr;
                    bf16_t* rowp = VT + (size_t)r * T;
                    const bool gate = (r >= 1408 && r < 1420);
#pragma unroll
                    for (int bj = 0; bj < 2; ++bj) {
                        const int c0 = u.pn * 256 + bj * 128 + wc * 32 + 8 * fq;
                        const a4 v0 = acc[ai][bj][m][0], v1 = acc[ai][bj][m][1];
                        float v[8] = {v0[0], v0[1], v0[2], v0[3], v1[0], v1[1], v1[2], v1[3]};
                        if (gate) {
#pragma unroll
                            for (int j = 0; j < 8; ++j) v[j] = sigmoidf_(v[j]);
                        }
                        if (u.pm == 3) {
                            const int b = c0 >> 12, p0 = c0 & (SEQ - 1), mm0 = p0 >> 2;
                            bf16_t* q = rowp + b * SEQ + mm0;
#pragma unroll
                            for (int c = 0; c < 4; ++c) *(GAS unsigned*)(q + c * 1024) = pk2(v[c], v[c + 4]);
                        } else if (u.pm == 4) {
                            const int b = c0 >> 12, p0 = c0 & (SEQ - 1), mm = p0 >> 4, cc0 = p0 & 15;
                            bf16_t* q = rowp + b * SEQ + cc0 * 256 + mm;
#pragma unroll
                            for (int j = 0; j < 8; ++j) ((GAS bf16_t*)q)[j * 256] = (bf16_t)(pk2(v[j], 0.f) & 0xffffu);
                        } else store8(rowp + c0, v);
                    }
                    asm volatile("" ::: "memory");
                }
        } else if (kind == 2) {
            const int br = u.pn;
            const bf16_t* VT = (const bf16_t*)(ws + WS_VT);
            const float* LSE = (const float*)(ws + WS_LSE);
#pragma unroll
            for (int ai = 0; ai < 2; ++ai)
#pragma unroll
                for (int m = 0; m < 4; ++m) {
                    const int tok = u.pm * 256 + ai * 128 + wr * 64 + m * 16 + fr;
#pragma unroll
                    for (int bj = 0; bj < 2; ++bj) {
                        const int cb = bj * 128 + wc * 32 + 8 * fq, head = cb >> 6;
                        const a4 v0 = acc[ai][bj][m][0], v1 = acc[ai][bj][m][1];
                        float gt[8] = {v0[0], v0[1], v0[2], v0[3], v1[0], v1[1], v1[2], v1[3]};
                        const size_t off = (size_t)tok * 256 + cb;
                        float o[8];
                        bf16_t* dst;
                        if (br == 0) { dst = slot_ptr(ws, SL_QA) + off; load8(dst, o); }
                        else if (br == 2) { dst = slot_ptr(ws, SL_QC) + off; load8(dst, o); }
                        else if (br == 1) {
                            dst = slot_ptr(ws, SL_QB) + off;
                            float oc[8], os[8], ow[8]; load8(dst, oc); load8(slot_ptr(ws, SL_OSLC) + off, os); load8(slot_ptr(ws, SL_OWIN) + off, ow);
                            const GAS bf16_t* VTg = (const GAS bf16_t*)VT; const float g0 = bf1(VTg[(size_t)(1408 + head) * T + tok]), g1 = bf1(VTg[(size_t)(1412 + head) * T + tok]), g2 = bf1(VTg[(size_t)(1416 + head) * T + tok]);
#pragma unroll
                            for (int j = 0; j < 8; ++j) o[j] = g0 * oc[j] + g1 * os[j] + g2 * ow[j];
                        } else {
                            dst = slot_ptr(ws, SL_QD0) + off;
                            float o0[8], o1[8], o2[8]; load8(dst, o0); load8(slot_ptr(ws, SL_QD1) + off, o1); load8(slot_ptr(ws, SL_QD2) + off, o2);
                            const GAS float* LSEg = (const GAS float*)LSE; const float l0 = LSEg[((size_t)0 * T + tok) * 4 + head], l1 = LSEg[((size_t)1 * T + tok) * 4 + head], l2 = LSEg[((size_t)2 * T + tok) * 4 + head];
                            const float mx = fmaxf(l0, fmaxf(l1, l2));
                            const float e0 = fexp2((l0 - mx) * LOG2E), e1 = fexp2((l1 - mx) * LOG2E), e2 = fexp2((l2 - mx) * LOG2E);
                            const float inv = frcp(e0 + e1 + e2);
#pragma unroll
                            for (int j = 0; j < 8; ++j) o[j] = (e0 * o0[j] + e1 * o1[j] + e2 * o2[j]) * inv;
                        }
#pragma unroll
                        for (int j = 0; j < 8; ++j) o[j] *= gt[j] * sigmoidf_(gt[j]);
                        store8(dst, o);
                        asm volatile("" ::: "memory");
                    }
                }
        } else {
            bf16_t* U = (bf16_t*)(ws + WS_U); bf16_t* Y = (bf16_t*)(ws + WS_Y);
#pragma unroll
            for (int ai = 0; ai < 2; ++ai)
#pragma unroll
                for (int m = 0; m < 4; ++m) {
                    const int tok = u.pm * 256 + ai * 128 + wr * 64 + m * 16 + fr;
#pragma unroll
                    for (int bj = 0; bj < 2; ++bj) {
                        const int col = u.pn * 256 + bj * 128 + wc * 32 + 8 * fq;
                        const a4 v0 = acc[ai][bj][m][0], v1 = acc[ai][bj][m][1];
                        float v[8] = {v0[0], v0[1], v0[2], v0[3], v1[0], v1[1], v1[2], v1[3]};
                        const size_t off = (size_t)tok * D + col;
                        if (kind == 3) store8(U + off, v);
                        else if (kind == 4) {
                            float uu[8]; load8(U + off, uu);
                            float y[8];
                            if (first) {
#pragma unroll
                                for (int j = 0; j < 8; ++j) y[j] = sigmoidf_(v[j]) * uu[j];
                            } else {
                                load8(Y + off, y);
#pragma unroll
                                for (int j = 0; j < 8; ++j) y[j] += sigmoidf_(v[j]) * uu[j];
                            }
                            store8(Y + off, y);
                        } else {
                            const f32x4 x0 = *(const GAS f32x4*)(xin + off), x1 = *(const GAS f32x4*)(xin + off + 4);
                            *(GAS f32x4*)(xout + off) = (f32x4){x0[0] + v[0], x0[1] + v[1], x0[2] + v[2], x0[3] + v[3]};
                            *(GAS f32x4*)(xout + off + 4) = (f32x4){x1[0] + v[4], x1[1] + v[5], x1[2] + v[6], x1[3] + v[7]};
                        }
                        asm volatile("" ::: "memory");
                    }
                }
        }
    }
};

DI void transpose_item(const float* W, int K, int N, bf16_t* WT, int k0, int n0, int sc, LAS float* scr, int lane) {
    const int sc4 = __shfl(sc, 4 * (lane & 7));
#pragma unroll
    for (int i = 0; i < 8; ++i) {
        const int kk = 8 * i + (lane >> 3);
        const f32x4 w = sc4 >= 0 ? *(const GAS f32x4*)(W + (size_t)(k0 + kk) * N + sc4) : (f32x4){0.f, 0.f, 0.f, 0.f};
        LAS float* d = scr + kk * 33 + 4 * (lane & 7);
        d[0] = w.x; d[1] = w.y; d[2] = w.z; d[3] = w.w;
    }
    asm volatile("s_waitcnt lgkmcnt(0)" ::: "memory");
    const int c = lane & 7;
#pragma unroll
    for (int j = 0; j < 4; ++j) { const int n = (lane >> 3) + 8 * j; const LAS float* s = scr + (8 * c) * 33 + n;
        u32x4 o; o.x = pk2(s[0 * 33], s[1 * 33]); o.y = pk2(s[2 * 33], s[3 * 33]); o.z = pk2(s[4 * 33], s[5 * 33]); o.w = pk2(s[6 * 33], s[7 * 33]);
        *(GAS u32x4*)(WT + (size_t)(n0 + n) * K + k0 + 8 * c) = o; }
    asm volatile("s_waitcnt lgkmcnt(0)" ::: "memory");
}
DI int src_qk(int n) {
    const int tile = n >> 8, hs = (n >> 6) & 3, g = (n >> 3) & 7, e = n & 7, d = 4 * g + (e & 3) + 32 * (e >> 2);
    int base;
    switch (tile) {
        case 0: base = A_Q + 64 * hs; break; case 1: base = A_K + 64 * hs; break; case 2: base = B_Q + 64 * hs; break;
        case 3: base = hs == 0 ? B_KC : hs == 1 ? B_VC : hs == 2 ? B_KS : B_KW; break;
        case 4: base = C_Q + 64 * hs; break; case 5: base = C_K + 64 * hs; break;
        case 6: case 7: case 8: base = D_Q + 256 * (tile - 6) + 64 * hs; break;
        default: base = D_K + 256 * (tile - 9) + 64 * hs; break;
    }
    return base + d;
}
DI int src_v(int n) {
    const int slot = n >> 6, d = n & 63;
    if (slot < 4) return A_V + 64 * slot + d;
    if (slot < 8) return C_V + 64 * (slot - 4) + d;
    if (slot < 20) return D_V + 64 * (slot - 8) + d;
    if (slot == 20) return B_VS + d;
    if (slot == 21) return B_VW + d;
    if (slot == 22 && d < 12) return B_NG + d;
    return -1;
}
DI int src_g(int n) { const int br = n >> 8, c = n & 255; return (br == 0 ? A_G : br == 1 ? B_G : br == 2 ? C_G : D_G) + c; }

DI const bf16_t* launder_vp(const bf16_t* p) { asm volatile("" : "+v"(p)); return p; }
DI int kappa(int rho) { return (rho & 16) | ((rho & 4) << 1) | ((rho & 8) >> 1) | (rho & 3); }
DI bf16x8 ldfrag(const bf16_t* p) { return *(const GAS bf16x8*)p; }
DI bf16x8 pack8(const float* p) { u32x4 w; w.x = pk2(p[0], p[1]); w.y = pk2(p[2], p[3]); w.z = pk2(p[4], p[5]); w.w = pk2(p[6], p[7]); return __builtin_bit_cast(bf16x8, w); }

#define BLK_BAR() do { asm volatile("s_waitcnt lgkmcnt(0)" ::: "memory"); __builtin_amdgcn_s_barrier(); asm volatile("" ::: "memory"); } while (0)
struct SmState { f32x16 O[2]; float m, l; };
DI void sm_init(SmState& st) {
#pragma unroll
    for (int i = 0; i < 16; ++i) { st.O[0][i] = 0.f; st.O[1][i] = 0.f; }
    st.m = MFLOOR; st.l = 0.f;
}
struct Frag { bf16x8 k[4], v[2][2]; };
DI void ld_frag(Frag& f, const bf16_t* kp, const bf16_t* v0p, const bf16_t* v1p) {
#pragma unroll
    for (int s = 0; s < 4; ++s) f.k[s] = ldfrag(kp + 16 * s);
#pragma unroll
    for (int s = 0; s < 2; ++s) { f.v[0][s] = ldfrag(v0p + 16 * s); f.v[1][s] = ldfrag(v1p + 16 * s); }
}
struct FragG { u32x4 k[4], v[4]; };
constexpr int WLDS_BYTES = 4608 + 5120;
DI void ldg(FragG& g, const bf16_t* kq, size_t kstride, const bf16_t* vq, size_t vstride) {
#pragma unroll
    for (int j = 0; j < 4; ++j) g.k[j] = *(const GAS u32x4*)(kq + (size_t)(8 * j) * kstride);
#pragma unroll
    for (int j = 0; j < 4; ++j) g.v[j] = *(const GAS u32x4*)(vq + (size_t)(16 * j) * vstride);
}
DI void stage(const FragG& g, Frag& f, LAS unsigned char* wl, int lane) {
    const int r = lane & 31, h = lane >> 5;
    LAS u32x4* kw = (LAS u32x4*)(wl + (lane >> 3) * 144 + (lane & 7) * 16);
    LAS u32x4* vw = (LAS u32x4*)(wl + 4608 + (lane >> 2) * 80 + (lane & 3) * 16);
#pragma unroll
    for (int j = 0; j < 4; ++j) kw[j * 72] = g.k[j];
#pragma unroll
    for (int j = 0; j < 4; ++j) vw[j * 80] = g.v[j];
    asm volatile("" ::: "memory");
    const LAS unsigned char* kr = wl + kappa(r) * 144 + 16 * h;
    const LAS unsigned char* vr = wl + 4608 + r * 80 + 16 * h;
#pragma unroll
    for (int s = 0; s < 4; ++s) f.k[s] = *(const LAS bf16x8*)(kr + 32 * s);
#pragma unroll
    for (int s = 0; s < 2; ++s) { f.v[0][s] = *(const LAS bf16x8*)(vr + 32 * s); f.v[1][s] = *(const LAS bf16x8*)(vr + 32 * 80 + 32 * s); }
    asm volatile("" ::: "memory");
}
template <int MASK>
DI void sm_compute(SmState& st, const bf16x8 (&qf)[4], const Frag& f, int key0, bool allow, int klo, int khi) {
    f32x16 S;
#pragma unroll
    for (int i = 0; i < 16; ++i) S[i] = 0.f;
#pragma unroll
    for (int s = 0; s < 4; ++s) S = MFMA32(f.k[s], qf[s], S);
    const float neg = NEG, mfl = MFLOOR;
    float p[16]; float mx = mfl;
#pragma unroll
    for (int i = 0; i < 16; ++i) {
        float v = S[i];
        if (MASK == 2) { const int key = key0 + 16 * (i >> 3) + (i & 7); v = (allow && key >= klo && key <= khi) ? v : neg; }
        p[i] = v; mx = fmaxf(mx, v);
    }
    if (MASK == 1) mx = allow ? mx : mfl;
    mx = hmaxf_(mx);
    const float mn = fmaxf(st.m, mx), mc = mn * SM_C;
    const float mcl = (MASK == 1 && !allow) ? sconst(INFINITY) : mc;
    const f32x2 c2 = {SM_C, SM_C}, m2 = {mcl, mcl};
    f32x2 rs2 = {0.f, 0.f};
#pragma unroll
    for (int k = 0; k < 8; ++k) {
        const f32x2 x = (f32x2){p[2 * k], p[2 * k + 1]} * c2 - m2;
        const f32x2 e = {fexp2(x.x), fexp2(x.y)};
        p[2 * k] = e.x; p[2 * k + 1] = e.y; rs2 += e;
    }
    const float rs = rs2.x + rs2.y;
    if (__ballot(mn != st.m) != 0ull) {
        const float alpha = fexp2((st.m - mn) * SM_C);
        st.l *= alpha;
#pragma unroll
        for (int i = 0; i < 16; ++i) { st.O[0][i] *= alpha; st.O[1][i] *= alpha; }
    }
    st.l += rs; st.m = mn;
    const bf16x8 pf0 = pack8(p), pf1 = pack8(p + 8);
    st.O[0] = MFMA32(f.v[0][0], pf0, st.O[0]); st.O[0] = MFMA32(f.v[0][1], pf1, st.O[0]);
    st.O[1] = MFMA32(f.v[1][0], pf0, st.O[1]); st.O[1] = MFMA32(f.v[1][1], pf1, st.O[1]);
}
DI void write_o(bf16_t* orow, const f32x16 (&O)[2], float inv, int h) {
#pragma unroll
    for (int dt = 0; dt < 2; ++dt)
#pragma unroll
        for (int g = 0; g < 4; ++g) store4(orow + 32 * dt + 8 * g + 4 * h, O[dt][4 * g] * inv, O[dt][4 * g + 1] * inv, O[dt][4 * g + 2] * inv, O[dt][4 * g + 3] * inv);
}
DI void load_q(bf16x8 (&qf)[4], const bf16_t* qrow, int h) {
#pragma unroll
    for (int s = 0; s < 4; ++s) qf[s] = ldfrag(qrow + 16 * s + 8 * h);
}

struct SmTask { const bf16_t* qrow; const bf16_t* kb; const bf16_t* vb0; bf16_t* orow; float* lse; size_t kstride; int ti_lo, ti_hi, ti_edge, bshift, klo, khi; unsigned long long need, full, allow; };
DI int sm_next(int ti, int ti_hi, int bshift, unsigned long long need) {
    int nt = ti + 1;
    while (nt <= ti_hi) { if ((need >> (nt >> bshift)) & 1ull) return nt; nt = ((nt >> bshift) + 1) << bshift; }
    return -1;
}
DI void sm_step(SmState& st, const bf16x8 (&qf)[4], const Frag& f, const SmTask& tk, int ti, int h) {
    const int blk = ti >> tk.bshift;
    const bool allow = (tk.allow >> blk) & 1ull;
    if ((ti == tk.ti_hi) || (ti == tk.ti_edge)) sm_compute<2>(st, qf, f, 32 * ti + 8 * h, allow, tk.klo, tk.khi);
    else if (!((tk.full >> blk) & 1ull)) sm_compute<1>(st, qf, f, 32 * ti + 8 * h, allow, 0, 0);
    else sm_compute<0>(st, qf, f, 32 * ti + 8 * h, true, 0, 0);
}
DI void run_sm(const SmTask& tk, int lane, LAS unsigned char* wl) {
    const int h = lane >> 5;
    bf16x8 qf[4]; load_q(qf, tk.qrow, h);
    SmState st; sm_init(st);
    int ti = sm_next(tk.ti_lo - 1, tk.ti_hi, tk.bshift, tk.need);
    FragG GA, GB; Frag F;
    ldg(GA, tk.kb + (size_t)(32 * ti) * tk.kstride, tk.kstride, tk.vb0 + 32 * ti, T);
    for (;;) {
        int nt = sm_next(ti, tk.ti_hi, tk.bshift, tk.need); int lt = nt >= 0 ? nt : ti;
        ldg(GB, tk.kb + (size_t)(32 * lt) * tk.kstride, tk.kstride, tk.vb0 + 32 * lt, T);
        __builtin_amdgcn_sched_barrier(0);
        stage(GA, F, wl, lane);
        sm_step(st, qf, F, tk, ti, h);
        if (nt < 0) break;
        ti = nt;
        nt = sm_next(ti, tk.ti_hi, tk.bshift, tk.need); lt = nt >= 0 ? nt : ti;
        ldg(GA, tk.kb + (size_t)(32 * lt) * tk.kstride, tk.kstride, tk.vb0 + 32 * lt, T);
        __builtin_amdgcn_sched_barrier(0);
        stage(GB, F, wl, lane);
        sm_step(st, qf, F, tk, ti, h);
        if (nt < 0) break;
        ti = nt;
    }
    const float lt_ = hsumf_(st.l);
    write_o(tk.orow, st.O, frcp(lt_), h);
    if (tk.lse != nullptr && h == 0) *(GAS float*)tk.lse = st.m * SM_SCALE + flog2(lt_) * LN2;
}
DI unsigned long long bits_any(unsigned long long m, int n) {
    unsigned long long r = 0ull;
    for (int j = 0; j < n; ++j) if (__ballot((m >> j) & 1ull) != 0ull) r |= 1ull << j;
    return r;
}
DI unsigned long long bits_all(unsigned long long m, int n) {
    unsigned long long r = 0ull;
    for (int j = 0; j < n; ++j) if (__ballot((m >> j) & 1ull) == ~0ull) r |= 1ull << j;
    return r;
}
DI void task_sm(unsigned char* ws, int kind, int b, int hh, int qt, int lane, LAS unsigned char* wl) {
    const int r = lane & 31, kr = lane >> 3, kc = 8 * (lane & 7), vd = lane >> 2, vc = 8 * (lane & 3);
    const bf16_t* VT = (const bf16_t*)(ws + WS_VT);
    SmTask tk;
    tk.lse = nullptr; tk.kstride = 256; tk.ti_edge = -1; tk.klo = -1; tk.ti_lo = 0;
    if (kind <= 2) {
        const int t0 = 32 * qt, t = t0 + r; const size_t row = (size_t)(b * SEQ + t) * 256 + hh * 64;
        tk.ti_hi = qt; tk.khi = t;
        if (kind == 0) {
            const int cb = t0 >> 8;
            const unsigned long long mask = ((const GAS unsigned*)(ws + WS_MMASK))[(b * 4 + hh) * SEQ + t];
            tk.qrow = slot_ptr(ws, SL_QA) + row; tk.orow = slot_ptr(ws, SL_QA) + row;
            tk.kb = slot_ptr(ws, SL_KA) + (size_t)(b * SEQ + kr) * 256 + hh * 64 + kc;
            tk.vb0 = VT + (size_t)(hh * 64 + vd) * T + b * SEQ + vc;
            tk.bshift = 3; tk.allow = mask; tk.need = bits_any(mask, cb + 1); tk.full = bits_all(mask, cb + 1);
        } else if (kind == 1) {
            const int cur = t0 >> 6;
            const unsigned long long mask = ((const GAS unsigned long long*)(ws + WS_NMASK))[b * SEQ + t];
            tk.qrow = slot_ptr(ws, SL_QBR) + row; tk.orow = slot_ptr(ws, SL_OSLC) + row;
            tk.kb = slot_ptr(ws, SL_KB4) + (size_t)(b * SEQ + kr) * 256 + 128 + kc;
            tk.vb0 = VT + (size_t)(1280 + vd) * T + b * SEQ + vc;
            tk.bshift = 1; tk.allow = mask; tk.need = bits_any(mask, cur + 1); tk.full = bits_all(mask, cur + 1);
        } else {
            tk.qrow = slot_ptr(ws, SL_QBR) + row; tk.orow = slot_ptr(ws, SL_OWIN) + row;
            tk.kb = slot_ptr(ws, SL_KB4) + (size_t)(b * SEQ + kr) * 256 + 192 + kc;
            tk.vb0 = VT + (size_t)(1344 + vd) * T + b * SEQ + vc;
            tk.bshift = 8; tk.allow = 1ull; tk.need = 1ull; tk.full = 1ull;
            tk.ti_lo = qt - 16 < 0 ? 0 : qt - 16; tk.ti_edge = qt - 16; tk.klo = t - 511;
        }
    } else {
        const int g = kind - 3, dil = g == 0 ? 1 : g == 1 ? 4 : 16, L = SEQ / dil, nsub = 128 / dil, c = qt / nsub, sq = qt - c * nsub;
        const int mq = 32 * sq + r, tok = b * SEQ + mq * dil + c;
        bf16_t* qr = slot_ptr(ws, g == 0 ? SL_QD0 : g == 1 ? SL_QD1 : SL_QD2) + (size_t)tok * 256 + hh * 64;
        tk.qrow = qr; tk.orow = qr; tk.kstride = (size_t)256 * dil;
        tk.kb = slot_ptr(ws, SL_KD0 + g) + (size_t)(b * SEQ + c) * 256 + (size_t)kr * tk.kstride + hh * 64 + kc;
        tk.vb0 = VT + (size_t)(512 + 256 * g + hh * 64 + vd) * T + b * SEQ + (g == 0 ? 0 : c * L) + vc;
        tk.lse = (float*)(ws + WS_LSE) + ((size_t)g * T + tok) * 4 + hh;
        tk.bshift = 8; tk.allow = 1ull; tk.need = 1ull; tk.full = 1ull;
        tk.ti_hi = sq; tk.ti_lo = sq - 4 < 0 ? 0 : sq - 4; tk.ti_edge = sq - 4; tk.klo = mq - 128; tk.khi = mq;
    }
    run_sm(tk, lane, wl);
}

DI void frag_from_image(Frag& f, const LAS unsigned char* img, int lane) {
    const int r = lane & 31, h = lane >> 5;
    const LAS unsigned char* kr = img + kappa(r) * 144 + 16 * h;
    const LAS unsigned char* vr = img + 4608 + r * 80 + 16 * h;
#pragma unroll
    for (int s = 0; s < 4; ++s) f.k[s] = *(const LAS bf16x8*)(kr + 32 * s);
#pragma unroll
    for (int s = 0; s < 2; ++s) { f.v[0][s] = *(const LAS bf16x8*)(vr + 32 * s); f.v[1][s] = *(const LAS bf16x8*)(vr + 32 * 80 + 32 * s); }
}
DI void run_heavy_group(unsigned char* ws, int kind, int b, int hh, int qg, int wave, int lane, int tid, LAS unsigned char* img) {
    const int r = lane & 31, h = lane >> 5, qt = 8 * qg + wave, t0 = 32 * qt, t = t0 + r, tmax = 8 * qg + 7;
    const size_t row = (size_t)(b * SEQ + t) * 256 + hh * 64;
    SmTask tk; tk.lse = nullptr; tk.kstride = 256; tk.ti_edge = -1; tk.klo = -1; tk.ti_lo = 0; tk.ti_hi = qt; tk.khi = t; tk.kb = nullptr; tk.vb0 = nullptr;
    const bf16_t* gp; size_t gstep; int woff;
    if (kind == 0) {
        const int cb = t0 >> 8;
        const unsigned long long mask = ((const GAS unsigned*)(ws + WS_MMASK))[(b * 4 + hh) * SEQ + t];
        tk.qrow = slot_ptr(ws, SL_QA) + row; tk.orow = slot_ptr(ws, SL_QA) + row;
        tk.bshift = 3; tk.allow = mask; tk.need = bits_any(mask, cb + 1); tk.full = bits_all(mask, cb + 1);
        if (tid < 256) { gp = slot_ptr(ws, SL_KA) + (size_t)(b * SEQ + (tid >> 3)) * 256 + hh * 64 + 8 * (tid & 7); gstep = (size_t)32 * 256; woff = (tid >> 3) * 144 + (tid & 7) * 16; }
        else { const int t2 = tid - 256; gp = (const bf16_t*)(ws + WS_VT) + (size_t)(hh * 64 + (t2 >> 2)) * T + b * SEQ + 8 * (t2 & 3); gstep = 32; woff = 4608 + (t2 >> 2) * 80 + (t2 & 3) * 16; }
    } else {
        const int cur = t0 >> 6;
        const unsigned long long mask = ((const GAS unsigned long long*)(ws + WS_NMASK))[b * SEQ + t];
        tk.qrow = slot_ptr(ws, SL_QBR) + row; tk.orow = slot_ptr(ws, SL_OSLC) + row;
        tk.bshift = 1; tk.allow = mask; tk.need = bits_any(mask, cur + 1); tk.full = bits_all(mask, cur + 1);
        if (tid < 256) { gp = slot_ptr(ws, SL_KB4) + (size_t)(b * SEQ + (tid >> 3)) * 256 + 128 + 8 * (tid & 7); gstep = (size_t)32 * 256; woff = (tid >> 3) * 144 + (tid & 7) * 16; }
        else { const int t2 = tid - 256; gp = (const bf16_t*)(ws + WS_VT) + (size_t)(1280 + (t2 >> 2)) * T + b * SEQ + 8 * (t2 & 3); gstep = 32; woff = 4608 + (t2 >> 2) * 80 + (t2 & 3) * 16; }
    }
    bf16x8 qf[4]; load_q(qf, tk.qrow, h);
    SmState st; sm_init(st);
    LAS unsigned char* img0 = img; LAS unsigned char* img1 = img + WLDS_BYTES;
    u32x4 r0 = *(const GAS u32x4*)gp;
    u32x4 r1 = *(const GAS u32x4*)(gp + gstep * (size_t)(tmax < 1 ? tmax : 1));
    *(LAS u32x4*)(img0 + woff) = r0;
    r0 = *(const GAS u32x4*)(gp + gstep * (size_t)(tmax < 2 ? tmax : 2));
    BLK_BAR();
    Frag F;
    int ti = 0;
    for (;;) {
        if (ti <= qt && ((tk.need >> (ti >> tk.bshift)) & 1ull)) { frag_from_image(F, img0, lane); sm_step(st, qf, F, tk, ti, h); }
        if (ti == tmax) break;
        *(LAS u32x4*)(img1 + woff) = r1;
        r1 = *(const GAS u32x4*)(gp + gstep * (size_t)(ti + 3 > tmax ? tmax : ti + 3));
        BLK_BAR(); ++ti;
        if (ti <= qt && ((tk.need >> (ti >> tk.bshift)) & 1ull)) { frag_from_image(F, img1, lane); sm_step(st, qf, F, tk, ti, h); }
        if (ti == tmax) break;
        *(LAS u32x4*)(img0 + woff) = r0;
        r0 = *(const GAS u32x4*)(gp + gstep * (size_t)(ti + 3 > tmax ? tmax : ti + 3));
        BLK_BAR(); ++ti;
    }
    const float lt_ = hsumf_(st.l);
    write_o(tk.orow, st.O, frcp(lt_), h);
}

DI void stick_compute(f32x16 (&O)[2], float& carry, const bf16x8 (&qf)[4], const Frag& f, int kt0, int t, int h) {
    f32x16 S;
#pragma unroll
    for (int i = 0; i < 16; ++i) S[i] = 0.f;
#pragma unroll
    for (int s = 0; s < 4; ++s) S = MFMA32(f.k[s], qf[s], S);
    float lsm[16], ls[16]; float sA = 0.f, sB = 0.f;
    const int key0 = kt0 + 8 * h; const float neg = NEG;
#pragma unroll
    for (int i = 0; i < 16; ++i) {
        const int key = key0 + 16 * (i >> 3) + (i & 7);
        const bool valid = key < t;
        const float z = S[i] * SM_SCALE;
        const float sp = fmaxf(z, 0.f) + flog2(1.f + fexp2(-fabsf(z) * LOG2E)) * LN2;
        lsm[i] = valid ? -sp : 0.f;
        ls[i] = valid ? z - sp : neg;
        if (i < 8) sA += lsm[i]; else sB += lsm[i];
    }
    const float pA = xhalf(sA), pB = xhalf(sB);
    const float baseB = carry + (h == 0 ? pB : 0.f), baseA = carry + sB + pB + (h == 0 ? pA : 0.f);
    float p[16]; float run = baseA;
#pragma unroll
    for (int e = 7; e >= 0; --e) { p[e] = fexp2((ls[e] + run) * LOG2E); run += lsm[e]; }
    run = baseB;
#pragma unroll
    for (int e = 15; e >= 8; --e) { p[e] = fexp2((ls[e] + run) * LOG2E); run += lsm[e]; }
    carry += (sA + sB) + (pA + pB);
    const bf16x8 pf0 = pack8(p), pf1 = pack8(p + 8);
    O[0] = MFMA32(f.v[0][0], pf0, O[0]); O[0] = MFMA32(f.v[0][1], pf1, O[0]);
    O[1] = MFMA32(f.v[1][0], pf0, O[1]); O[1] = MFMA32(f.v[1][1], pf1, O[1]);
}
DI void task_stick(unsigned char* ws, int b, int hh, int qt, int lane, LAS unsigned char* wl) {
    const int r = lane & 31, h = lane >> 5, t0 = 32 * qt, t = t0 + r;
    bf16_t* qrow = slot_ptr(ws, SL_QC) + (size_t)(b * SEQ + t) * 256 + hh * 64;
    bf16x8 qf[4]; load_q(qf, qrow, h);
    const bf16_t* kb = slot_ptr(ws, SL_KC) + (size_t)(b * SEQ + (lane >> 3)) * 256 + hh * 64 + 8 * (lane & 7);
    const bf16_t* vb0 = (const bf16_t*)(ws + WS_VT) + (size_t)(256 + hh * 64 + (lane >> 2)) * T + b * SEQ + 8 * (lane & 3);
    f32x16 O[2];
#pragma unroll
    for (int i = 0; i < 16; ++i) { O[0][i] = 0.f; O[1][i] = 0.f; }
    float carry = 0.f;
    int kt0 = t0;
    FragG GA, GB; Frag F;
    ldg(GA, kb + (size_t)kt0 * 256, 256, vb0 + kt0, T);
    for (;;) {
        int nk = kt0 - 32, lk = nk >= 0 ? nk : kt0;
        ldg(GB, kb + (size_t)lk * 256, 256, vb0 + lk, T);
        __builtin_amdgcn_sched_barrier(0);
        stage(GA, F, wl, lane);
        stick_compute(O, carry, qf, F, kt0, t, h);
        if (nk < 0 || __ballot(carry > -104.f) == 0ull) break;
        kt0 = nk; nk = kt0 - 32; lk = nk >= 0 ? nk : kt0;
        ldg(GA, kb + (size_t)lk * 256, 256, vb0 + lk, T);
        __builtin_amdgcn_sched_barrier(0);
        stage(GB, F, wl, lane);
        stick_compute(O, carry, qf, F, kt0, t, h);
        if (nk < 0 || __ballot(carry > -104.f) == 0ull) break;
        kt0 = nk;
    }
    write_o(qrow, O, 1.f, h);
}

DI void task_cmp(unsigned char* ws, int b, int qt, int lane, LAS float* imp, int hh0, int nh, bool leader) {
    const int r = lane & 31, h = lane >> 5, t0 = 32 * qt, t = t0 + r, cur = t0 >> 6;
    const int nvis = t >= 31 ? ((t - 31) >> 4) + 1 : 0;
    const int nvmax = (t0 >> 4) + 1, ntile = (nvmax + 31) >> 5;
    const bool need_imp = cur >= 16;
    if (leader) { for (int i = lane; i < 32 * 65; i += 64) imp[i] = 0.f; }
    BLK_BAR();
    const bf16_t* kb_ = (const bf16_t*)(ws + WS_KCMP) + (size_t)(b * 256 + kappa(r)) * 64 + 8 * h;
    const bf16_t* vb0_ = (const bf16_t*)(ws + WS_VCMPT) + (size_t)(b * 64 + r) * 256 + 8 * h;
    for (int hh = hh0; hh < hh0 + nh; ++hh) {
        const bf16_t* kb = launder_vp(kb_); const bf16_t* vb0 = launder_vp(vb0_); const bf16_t* vb1 = vb0 + 32 * 256;
        bf16_t* qrow = slot_ptr(ws, SL_QB) + (size_t)(b * SEQ + t) * 256 + hh * 64;
        bf16x8 qf[4]; load_q(qf, qrow, h);
        float m = MFLOOR, l = 0.f;
        bf16x8 kn[4];
#pragma unroll
        for (int s = 0; s < 4; ++s) kn[s] = ldfrag(kb + 16 * s);
        for (int tl = 0; tl < ntile; ++tl) {
            bf16x8 kf[4];
#pragma unroll
            for (int s = 0; s < 4; ++s) kf[s] = kn[s];
            const int nl = tl + 1 < ntile ? tl + 1 : tl;
#pragma unroll
            for (int s = 0; s < 4; ++s) kn[s] = ldfrag(kb + (size_t)(32 * nl) * 64 + 16 * s);
            f32x16 S;
#pragma unroll
            for (int i = 0; i < 16; ++i) S[i] = 0.f;
#pragma unroll
            for (int s = 0; s < 4; ++s) S = MFMA32(kf[s], qf[s], S);
            const float neg = NEG; float mx = MFLOOR;
#pragma unroll
            for (int i = 0; i < 16; ++i) { const int key = 32 * tl + 8 * h + 16 * (i >> 3) + (i & 7); const float v = key < nvis ? S[i] : neg; S[i] = v; mx = fmaxf(mx, v); }
            mx = hmaxf_(mx);
            const float mn = fmaxf(m, mx), mc = mn * SM_C;
            float rs = 0.f;
#pragma unroll
            for (int i = 0; i < 16; ++i) rs += fexp2(S[i] * SM_C - mc);
            l = l * fexp2((m - mn) * SM_C) + rs; m = mn;
        }
        const float lt = hsumf_(l);
        const float inv = nvis > 0 ? frcp(lt) : 0.f, mc = m * SM_C;
        f32x16 O[2];
#pragma unroll
        for (int i = 0; i < 16; ++i) { O[0][i] = 0.f; O[1][i] = 0.f; }
        Frag fn; ld_frag(fn, kb, vb0, vb1);
        for (int tl = 0; tl < ntile; ++tl) {
            bf16x8 kf[4], vf[2][2];
#pragma unroll
            for (int s = 0; s < 4; ++s) kf[s] = fn.k[s];
#pragma unroll
            for (int s = 0; s < 2; ++s) { vf[0][s] = fn.v[0][s]; vf[1][s] = fn.v[1][s]; }
            const int nl = tl + 1 < ntile ? tl + 1 : tl;
            ld_frag(fn, kb + (size_t)(32 * nl) * 64, vb0 + 32 * nl, vb1 + 32 * nl);
            f32x16 S;
#pragma unroll
            for (int i = 0; i < 16; ++i) S[i] = 0.f;
#pragma unroll
            for (int s = 0; s < 4; ++s) S = MFMA32(kf[s], qf[s], S);
            float p[16];
#pragma unroll
            for (int i = 0; i < 16; ++i) { const int key = 32 * tl + 8 * h + 16 * (i >> 3) + (i & 7); p[i] = key < nvis ? fexp2(S[i] * SM_C - mc) * inv : 0.f; }
            if (need_imp) {
#pragma unroll
                for (int a = 0; a < 2; ++a) {
                    const int u = 4 * tl + 2 * a + h; const float* q = p + 8 * a;
                    LAS float* row = imp + r * 65 + 2 * u;
                    atomicAdd((float*)(row + 0), (q[0] + q[1]) + (q[2] + q[3]));
                    atomicAdd((float*)(row + 1), (q[3] + q[4]) + (q[5] + q[6]) + q[7]);
                    if (2 * u + 2 < 64) atomicAdd((float*)(row + 2), q[7]);
                }
            }
            const bf16x8 pf0 = pack8(p), pf1 = pack8(p + 8);
            O[0] = MFMA32(vf[0][0], pf0, O[0]); O[0] = MFMA32(vf[0][1], pf1, O[0]);
            O[1] = MFMA32(vf[1][0], pf0, O[1]); O[1] = MFMA32(vf[1][1], pf1, O[1]);
        }
        write_o(qrow, O, 1.f, h);
    }
    asm volatile("s_waitcnt lgkmcnt(0)" ::: "memory");
    BLK_BAR();
    if (leader) {
        unsigned long long mask;
        if (cur <= 15) mask = (2ull << cur) - 1ull;
        else {
            float v[32];
#pragma unroll
            for (int i = 0; i < 32; ++i) v[i] = imp[r * 65 + 2 * i + h];
            mask = 1ull | (1ull << cur) | (1ull << (cur - 1));
            for (int k = 0; k < 13; ++k) {
                float best = -1.f; int bj = 64;
#pragma unroll
                for (int i = 0; i < 32; ++i) { const int j = 2 * i + h; const bool ok = j >= 1 && j <= cur - 2 && !((mask >> j) & 1ull); if (ok && v[i] > best) { best = v[i]; bj = j; } }
                const float ob = xhalf(best); const int oj = __shfl_xor(bj, 32);
                if (ob > best || (ob == best && oj < bj)) { best = ob; bj = oj; }
                if (bj < 64) mask |= 1ull << bj;
            }
        }
        if (lane < 32) ((GAS unsigned long long*)(ws + WS_NMASK))[b * SEQ + t] = mask;
    }
    asm volatile("s_waitcnt lgkmcnt(0)" ::: "memory");
}

DI void task_moba_gate(unsigned char* ws, int b, int hh, int qt, int lane) {
    const int r = lane & 31, h = lane >> 5, t0 = 32 * qt, t = t0 + r, cb = t0 >> 8;
    unsigned sel = 0u;
    if (cb <= 3) sel = (1u << cb) - 1u;
    else {
        const bf16_t* qrow = slot_ptr(ws, SL_QA) + (size_t)(b * SEQ + t) * 256 + hh * 64 + 32 * h;
        float q[32];
#pragma unroll
        for (int j = 0; j < 4; ++j) { float f[8]; load8(qrow + 8 * j, f);
#pragma unroll
            for (int e = 0; e < 8; ++e) q[8 * j + e] = f[e]; }
        const GAS float* km = (const GAS float*)(ws + WS_KMEAN) + (size_t)((b * 4 + hh) * 16) * 64 + 32 * h;
        float gate[16];
#pragma unroll
        for (int n = 0; n < 16; ++n) {
            float s = 0.f;
            if (n < cb) {
#pragma unroll
                for (int d = 0; d < 32; ++d) s += q[d] * km[n * 64 + d];
            }
            s += xhalf(s);
            gate[n] = n < cb ? s : sconst(-INFINITY);
        }
#pragma unroll
        for (int k = 0; k < 3; ++k) {
            float best = sconst(-INFINITY); int bi = -1;
#pragma unroll
            for (int n = 0; n < 16; ++n) if (!((sel >> n) & 1u) && gate[n] > best) { best = gate[n]; bi = n; }
            if (bi >= 0) sel |= 1u << bi;
        }
    }
    if (lane < 32) ((GAS unsigned*)(ws + WS_MMASK))[(b * 4 + hh) * SEQ + t] = sel | (1u << cb);
}

DI void task_kmean(unsigned char* ws, int b, int hh, int blk, int lane) {
    const bf16_t* kp = slot_ptr(ws, SL_KA) + (size_t)(b * SEQ + 256 * blk + (lane >> 3)) * 256 + hh * 64 + 8 * (lane & 7);
    float s[8];
#pragma unroll
    for (int e = 0; e < 8; ++e) s[e] = 0.f;
#pragma unroll 8
    for (int i = 0; i < 32; ++i) { float f[8]; load8(kp + (size_t)(8 * i) * 256, f);
#pragma unroll
        for (int e = 0; e < 8; ++e) s[e] += f[e]; }
#pragma unroll
    for (int e = 0; e < 8; ++e) { s[e] += __shfl_xor(s[e], 8); s[e] += __shfl_xor(s[e], 16); s[e] += __shfl_xor(s[e], 32); }
    if (lane < 8) {
        GAS float* o = (GAS float*)(ws + WS_KMEAN) + ((b * 4 + hh) * 16 + blk) * 64 + 8 * lane;
#pragma unroll
        for (int e = 0; e < 8; ++e) o[e] = s[e] * (1.f / 256.f);
    }
}

DI void task_mlp_block(unsigned char* ws, int kv, int b, int rt, int wave, int lane, LAS float* part) {
    const int r = lane & 31, h = lane >> 5, n = 32 * rt + r, ne = n > 254 ? 254 : n;
    const bf16_t* xp = slot_ptr(ws, SL_KB4) + (size_t)(b * SEQ + 16 * ne) * 256 + kv * 64 + 8 * h;
    const bf16_t* w1 = (const bf16_t*)(ws + WS_W1T) + (size_t)(kv * 256 + 32 * wave + kappa(r)) * 2048 + 8 * h;
    f32x16 acc;
#pragma unroll
    for (int i = 0; i < 16; ++i) acc[i] = 0.f;
    bf16x8 xa[4], wa[4], xb[4], wb[4];
#pragma unroll
    for (int s = 0; s < 4; ++s) { xa[s] = ldfrag(xp + 16 * s); wa[s] = ldfrag(w1 + 16 * s); }
    for (int l = 0; l < 32; l += 2) {
#pragma unroll
        for (int s = 0; s < 4; ++s) { xb[s] = ldfrag(xp + (size_t)(l + 1) * 256 + 16 * s); wb[s] = ldfrag(w1 + 64 * (l + 1) + 16 * s); }
#pragma unroll
        for (int s = 0; s < 4; ++s) acc = MFMA32(wa[s], xa[s], acc);
        const int l2 = l + 2 < 32 ? l + 2 : l;
#pragma unroll
        for (int s = 0; s < 4; ++s) { xa[s] = ldfrag(xp + (size_t)l2 * 256 + 16 * s); wa[s] = ldfrag(w1 + 64 * l2 + 16 * s); }
#pragma unroll
        for (int s = 0; s < 4; ++s) acc = MFMA32(wb[s], xb[s], acc);
    }
    const GAS float* bias = (const GAS float*)(ws + WS_BIAS) + kv * 256 + 32 * wave;
    const bf16_t* w2 = (const bf16_t*)(ws + WS_W2T) + (size_t)(kv * 64 + r) * 256 + 32 * wave + 8 * h;
    float g[16];
#pragma unroll
    for (int i = 0; i < 16; ++i) {
        const float x = acc[i] + bias[16 * (i >> 3) + 8 * h + (i & 7)];
        const float y = 0.7978845608028654f * (x + 0.044715f * x * x * x);
        const float th = 1.f - 2.f * frcp(1.f + fexp2(2.f * LOG2E * y));
        g[i] = 0.5f * x * (1.f + th);
    }
    const bf16x8 pf0 = pack8(g), pf1 = pack8(g + 8);
    f32x16 out[2];
#pragma unroll
    for (int i = 0; i < 16; ++i) { out[0][i] = 0.f; out[1][i] = 0.f; }
#pragma unroll
    for (int dt = 0; dt < 2; ++dt) {
        out[dt] = MFMA32(ldfrag(w2 + (size_t)(32 * dt) * 256), pf0, out[dt]);
        out[dt] = MFMA32(ldfrag(w2 + (size_t)(32 * dt) * 256 + 16), pf1, out[dt]);
    }
#pragma unroll
    for (int dt = 0; dt < 2; ++dt)
#pragma unroll
        for (int i = 0; i < 16; ++i) part[((wave * 2 + dt) * 16 + i) * 64 + lane] = out[dt][i];
    __syncthreads();
    const int dt = wave >> 2, gq = wave & 3;
    float sum[4];
#pragma unroll
    for (int e = 0; e < 4; ++e) { float a = 0.f;
#pragma unroll
        for (int w = 0; w < 8; ++w) a += part[((w * 2 + dt) * 16 + 4 * gq + e) * 64 + lane];
        sum[e] = n <= 254 ? a : 0.f; }
    const int d0 = 32 * dt + 8 * gq + 4 * h;
    if (kv == 0) store4((bf16_t*)(ws + WS_KCMP) + (size_t)(b * 256 + n) * 64 + d0, sum[0], sum[1], sum[2], sum[3]);
    else {
        bf16_t* vt = (bf16_t*)(ws + WS_VCMPT) + (size_t)(b * 64 + d0) * 256 + n;
#pragma unroll
        for (int e = 0; e < 4; ++e) ((GAS bf16_t*)vt)[e * 256] = (bf16_t)(pk2(sum[e], 0.f) & 0xffffu);
    }
    __syncthreads();
}

struct Args { const float* in[9]; float* out; unsigned char* ws; int pad0, pad1; };

DI int launder(int x) { asm volatile("" : "+v"(x)); return x; }
DI unsigned char* launder_p(unsigned char* p) { asm volatile("" : "+s"(p)); return (unsigned char*)(__attribute__((address_space(1))) unsigned char*)p; }
#define FRESH() const int tid = launder(tid0), lane = tid & 63, gw = blockIdx.x * NWAVES + wave; (void)gw; (void)lane; unsigned char* ws = launder_p(ws0); (void)ws;
DI int next_task(unsigned* ctr, int lane) {
    int v = 0;
    if (lane == 0) v = (int)atomicAdd(ctr, 1u);
    return __builtin_amdgcn_readfirstlane(v);
}

#ifndef PROBE_A
#define PROBE_A 0
#define PROBE_B 0
#endif
enum { ST_P0 = 0, ST_BIAS, ST_G_QK, ST_G_VT, ST_P2, ST_P3, ST_P4, ST_G_GATE, ST_G_U0, ST_G_M0, ST_G_U1, ST_G_M1, ST_G_U2, ST_G_M2, ST_G_U3, ST_G_M3, ST_G_OUT, NSTEP_LAYER };

__global__ void __launch_bounds__(NWAVES * 64, 2) mega_fwd(Args a) {
    extern __shared__ __attribute__((aligned(16))) unsigned char lds_raw[];
    cg::grid_group grid = cg::this_grid();
    LAS unsigned char* lds = (LAS unsigned char*)lds_raw;
    const int tid0 = threadIdx.x, wave = __builtin_amdgcn_readfirstlane(tid0 >> 6);
    const int G = gridDim.x, NGW = G * NWAVES;
    unsigned char* ws0 = a.ws;

    { FRESH();
    for (int e = blockIdx.x * (NWAVES * 64) + tid; e < SEQ * 32; e += G * NWAVES * 64) {
        const int pos = e >> 5, i = e & 31;
        const float inv = (float)exp2(-(double)i * (13.287712379549449 / 32.0));
        const float ang = (float)pos * inv;
        const double x = (double)ang, kq = rint(x * 0.6366197723675814);
        const double rr = (x - kq * 1.5707963267948966) - kq * 6.123233995736766e-17, r2 = rr * rr;
        const double sn = rr * (1.0 + r2 * (-1.0 / 6 + r2 * (1.0 / 120 + r2 * (-1.0 / 5040 + r2 * (1.0 / 362880 + r2 * (-1.0 / 39916800 + r2 * (1.0 / 6227020800.0)))))));
        const double cs = 1.0 + r2 * (-0.5 + r2 * (1.0 / 24 + r2 * (-1.0 / 720 + r2 * (1.0 / 40320 + r2 * (-1.0 / 3628800 + r2 * (1.0 / 479001600 + r2 * (-1.0 / 87178291200.0)))))));
        const int qd = (int)((long long)kq & 3);
        const double s_ = qd == 0 ? sn : qd == 1 ? cs : qd == 2 ? -sn : -cs, c_ = qd == 0 ? cs : qd == 1 ? -sn : qd == 2 ? -cs : sn;
        ((float*)(ws + WS_COS))[e] = (float)c_; ((float*)(ws + WS_SIN))[e] = (float)s_;
    } }

    for (int step = 0; step <= DEPTH * NSTEP_LAYER; ++step) {
        const int layer = step / NSTEP_LAYER, ls = step - layer * NSTEP_LAYER;
#if PROBE_A || PROBE_B
        if (blockIdx.x == 0 && tid0 == 0) ((unsigned long long*)(ws0 + WS_CTL + 2048))[32] = wall_clock64();
#endif
        if (layer == DEPTH) {
            FRESH(); const float* fw = a.in[8];
#if PROBE_A || PROBE_B
            float pa = 0.f, pb = 0.f;
            { const unsigned long long* tacc = (const unsigned long long*)(ws + WS_CTL + 2048);
              for (int k = 0; k < NSTEP_LAYER; ++k) { const float ms = (float)tacc[k] * 1e-5f; if ((PROBE_B >> k) & 1) pb += 0.002f * ms; } }
#endif
            for (int m = gw; m < T; m += NGW) {
                GAS f32x4* xr = (GAS f32x4*)(a.out + (size_t)m * D) + lane; const GAS f32x4* wr4 = (const GAS f32x4*)fw + lane;
                f32x4 v[4]; float s = 0.f;
#pragma unroll
                for (int j = 0; j < 4; ++j) { v[j] = xr[64 * j]; s += (v[j].x * v[j].x + v[j].y * v[j].y) + (v[j].z * v[j].z + v[j].w * v[j].w); }
                const float rs = rsqrtf(wave_sum(s) * (1.f / D) + sconst(1e-6f));
#pragma unroll
                for (int j = 0; j < 4; ++j) { const f32x4 w = wr4[64 * j]; f32x4 o = (f32x4){v[j].x * rs * w.x, v[j].y * rs * w.y, v[j].z * rs * w.z, v[j].w * rs * w.w};
#if PROBE_A || PROBE_B
                    o = o + ((lane & 1) ? pb : -pb); (void)pa;
#endif
                    xr[64 * j] = o; }
            }
            break;
        }
        const float* xin = layer == 0 ? a.in[0] : a.out;
        bool sync = false;
        if (ls == ST_P0) {
            const float* norm_w = a.in[1] + (size_t)layer * D;
            const float* w_in = a.in[2] + (size_t)layer * D * INW;
            const float* cmp_pos = a.in[3] + (size_t)layer * 2 * 2048;
            const float* cmp_w1 = a.in[4] + (size_t)layer * 2 * 2048 * 256;
            const float* cmp_w2 = a.in[5] + (size_t)layer * 2 * 256 * 64;
            const float* w_up = a.in[6] + (size_t)layer * 4 * 256 * D;
            const float* w_out = a.in[7] + (size_t)layer * D * D;
            FRESH(); LAS float* scr = (LAS float*)(lds + wave * 16384); bf16_t* Hb = (bf16_t*)(ws + WS_H);
            constexpr int I_QK = 16 * (NQK / 32), I_V = 16 * (NV / 32), I_G = 16 * 32, I_M = 16 * 128, I_UP = 4 * 4 * 32, I_OUT = 16 * 32, I_W1 = 2 * 32 * 8, I_W2 = 2 * 4 * 2;
            constexpr int NITEMS = I_QK + I_V + I_G + I_M + I_UP + I_OUT + I_W1 + I_W2;
            for (int it = gw; it < NITEMS; it += NGW) {
                int q = it;
                if (q < I_QK) { const int kb = q / (NQK / 32), nb = q % (NQK / 32); transpose_item(w_in, D, INW, (bf16_t*)(ws + WS_WQK), 64 * kb, 32 * nb, src_qk(32 * nb + (lane & 31)), scr, lane); continue; } q -= I_QK;
                if (q < I_V) { const int kb = q / (NV / 32), nb = q % (NV / 32); transpose_item(w_in, D, INW, (bf16_t*)(ws + WS_WV), 64 * kb, 32 * nb, src_v(32 * nb + (lane & 31)), scr, lane); continue; } q -= I_V;
                if (q < I_G) { const int kb = q / 32, nb = q % 32; transpose_item(w_in, D, INW, (bf16_t*)(ws + WS_WG), 64 * kb, 32 * nb, src_g(32 * nb + (lane & 31)), scr, lane); continue; } q -= I_G;
                if (q < I_M) { const int kb = q / 128, nb = q % 128; transpose_item(w_in, D, INW, (bf16_t*)(ws + WS_WM), 64 * kb, 32 * nb, MRG + 32 * nb + (lane & 31), scr, lane); continue; } q -= I_M;
                if (q < I_UP) { const int br = q / 128, q2 = q % 128, kb = q2 / 32, nb = q2 % 32; transpose_item(w_up + (size_t)br * 256 * D, 256, D, (bf16_t*)(ws + WS_WUP) + (size_t)br * D * 256, 64 * kb, 32 * nb, 32 * nb + (lane & 31), scr, lane); continue; } q -= I_UP;
                if (q < I_OUT) { const int kb = q / 32, nb = q % 32; transpose_item(w_out, D, D, (bf16_t*)(ws + WS_WOUT), 64 * kb, 32 * nb, 32 * nb + (lane & 31), scr, lane); continue; } q -= I_OUT;
                if (q < I_W1) { const int kv = q / 256, q2 = q % 256, kb = q2 / 8, nb = q2 % 8; transpose_item(cmp_w1 + (size_t)kv * 2048 * 256, 2048, 256, (bf16_t*)(ws + WS_W1T) + (size_t)kv * 256 * 2048, 64 * kb, 32 * nb, 32 * nb + (lane & 31), scr, lane); continue; } q -= I_W1;
                { const int kv = q / 8, q2 = q % 8, kb = q2 / 2, nb = q2 % 2; transpose_item(cmp_w2 + (size_t)kv * 256 * 64, 256, 64, (bf16_t*)(ws + WS_W2T) + (size_t)kv * 64 * 256, 64 * kb, 32 * nb, 32 * nb + (lane & 31), scr, lane); }
            }
            for (int it = gw; it < 2 * 4 * 32; it += NGW) {
                const int ch = it & 31, hg = (it >> 5) & 3, kv = it >> 7;
                const float* w1 = cmp_w1 + (size_t)kv * 2048 * 256 + (size_t)(64 * ch) * 256 + 64 * hg + lane; const float* pe = cmp_pos + kv * 2048 + 64 * ch;
                float s = 0.f;
#pragma unroll 8
                for (int f = 0; f < 64; ++f) s += pe[f] * w1[(size_t)f * 256];
                ((float*)(ws + WS_BIASP))[(ch * 2 + kv) * 256 + 64 * hg + lane] = s;
            }
            for (int m = gw; m < T; m += NGW) {
                const GAS f32x4* xr = (const GAS f32x4*)(xin + (size_t)m * D) + lane; const GAS f32x4* wr4 = (const GAS f32x4*)norm_w + lane;
                f32x4 v[4]; float s = 0.f;
#pragma unroll
                for (int j = 0; j < 4; ++j) { v[j] = xr[64 * j]; s += (v[j].x * v[j].x + v[j].y * v[j].y) + (v[j].z * v[j].z + v[j].w * v[j].w); }
                const float rs = rsqrtf(wave_sum(s) * (1.f / D) + sconst(1e-6f));
                GAS u32x2* o8 = (GAS u32x2*)(Hb + (size_t)m * D) + lane;
#pragma unroll
                for (int j = 0; j < 4; ++j) { const f32x4 w = wr4[64 * j]; u32x2 o; o.x = pk2(v[j].x * rs * w.x, v[j].y * rs * w.y); o.y = pk2(v[j].z * rs * w.z, v[j].w * rs * w.w); o8[64 * j] = o; }
            }
            sync = true;
        } else if (ls == ST_BIAS) {
            FRESH();
            if (blockIdx.x == 0) { float s = 0.f; for (int c = 0; c < 32; ++c) s += ((const float*)(ws + WS_BIASP))[c * 512 + tid]; ((float*)(ws + WS_BIAS))[tid] = s; }
        } else if (ls == ST_P2) {
        } else if (ls == ST_P3 || ls == ST_P4) {
            if (ls == ST_P3) {
                { FRESH();
                  for (int base = 0; base < 1024; base += 4 * G) {
                      const int it = base + blockIdx.x + G * (wave & 3); const int q = it < 1024 ? 1023 - it : 0;
                      task_cmp(ws, q & 7, q >> 3, lane, (LAS float*)(lds + (wave & 3) * 16384), 2 * (wave >> 2), it < 1024 ? 2 : 0, wave < 4 && it < 1024);
                  } }
                { FRESH();
                  for (int q = blockIdx.x + G * (NWAVES - 1 - wave); q < 4096; q += NGW) task_moba_gate(ws, q & 7, (q >> 3) & 3, q >> 5, lane); }
            }
            for (int pool = (ls == ST_P3 ? 0 : 2); pool < (ls == ST_P3 ? 2 : 3); ++pool) {
                FRESH();
                unsigned* ctr = (unsigned*)(ws + WS_CTL) + layer * 64 + 16 * pool;
                const int ngroups = pool == 0 ? 1024 : pool == 1 ? 1536 : 1024;
                volatile LAS int* gslot = (volatile LAS int*)(lds + 131072);
                for (;;) {
                    __syncthreads();
                    if (tid == 0) *gslot = (int)atomicAdd(ctr, 1u);
                    __syncthreads();
                    const int g = __builtin_amdgcn_readfirstlane(*gslot);
                    if (g >= ngroups) break;
                    if (pool == 2) { const int qg = 15 - (g >> 6), w = g & 63; run_heavy_group(ws, w >> 5, w & 7, (w >> 3) & 3, qg, wave, lane, tid, lds); }
                    else if (pool == 0 && g < 512) { task_stick(ws, g & 7, (g >> 3) & 3, 8 * (15 - (g >> 5)) + wave, lane, lds + wave * 16384); }
                    else {
                        const int kd = pool == 0 ? 3 : (g < 512 ? 2 : 4 + ((g - 512) >> 9)), w = g & 511;
                        task_sm(ws, kd, w & 7, (w >> 3) & 3, 8 * (w >> 5) + wave, lane, lds + wave * 16384);
                    }
                }
            }
            sync = true;
        } else {
            unsigned char* ws = launder_p(ws0); bf16_t* Hb = (bf16_t*)(ws + WS_H);
            pg8::Gemm g; Epi E{0, 0, ws, xin, a.out};
            if (ls == ST_G_QK) { g = pg8::Gemm{Hb, (const bf16_t*)(ws + WS_WQK), T, NQK, D}; E.kind = 0; sync = true; }
            else if (ls == ST_G_VT) { g = pg8::Gemm{(const bf16_t*)(ws + WS_WV), Hb, NV, T, D}; E.kind = 1; sync = true; }
            else if (ls == ST_G_GATE) { g = pg8::Gemm{Hb, (const bf16_t*)(ws + WS_WG), T, D, D}; E.kind = 2; sync = true; }
            else if (ls == ST_G_OUT) { g = pg8::Gemm{(const bf16_t*)(ws + WS_Y), (const bf16_t*)(ws + WS_WOUT), T, D, D}; E.kind = 5; sync = true; }
            else {
                const int k = ls - ST_G_U0, br = k >> 1;
                const int wslot = br == 0 ? SL_QA : br == 1 ? SL_QB : br == 2 ? SL_QC : SL_QD0;
                if ((k & 1) == 0) { g = pg8::Gemm{slot_ptr(ws, wslot), (const bf16_t*)(ws + WS_WUP) + (size_t)br * D * 256, T, D, 256}; E.kind = 3; }
                else { g = pg8::Gemm{Hb, (const bf16_t*)(ws + WS_WM) + (size_t)br * D * D, T, D, D}; E.kind = 4; E.first = (br == 0); sync = (br == 3); }
            }
            pg8::StaticOrder S; S.init(g.M, g.N, G, (int)blockIdx.x);
            if (ls == ST_G_VT) {
                FRESH();
                if (G == 256) {
                    if (blockIdx.x < 128) task_mlp_block(ws, blockIdx.x >> 6, (blockIdx.x >> 3) & 7, blockIdx.x & 7, wave, lane, (LAS float*)lds);
                    else if (blockIdx.x < 192) { const int q = (blockIdx.x - 128) * NWAVES + wave; task_kmean(ws, q >> 6, (q >> 4) & 3, q & 15, lane); }
                    S.split = 128;
                } else {
                    for (int q = gw; q < 512; q += NGW) task_kmean(ws, q >> 6, (q >> 4) & 3, q & 15, lane);
                    for (int it = blockIdx.x; it < 128; it += G) task_mlp_block(ws, it >> 6, (it >> 3) & 7, it & 7, wave, lane, (LAS float*)lds);
                }
                __syncthreads();
            }
            pg8::gemm_phase<Epi, pg8::StaticOrder, true, true>(lds, g, S, E);
        }
        if (sync) grid.sync();
#if PROBE_A || PROBE_B
        if (blockIdx.x == 0 && tid0 == 0) { unsigned long long* tp = (unsigned long long*)(ws0 + WS_CTL + 2048); tp[ls] += wall_clock64() - tp[32]; }
#endif
    }
}

extern "C" void kernel_launch(void* const* d_in, const int* in_sizes, int n_in, void* d_out, int out_size, void* d_ws, size_t ws_size, hipStream_t stream) {
    static int grid = 0;
    if (grid == 0) {
        int dev = 0, cus = 0, per_cu = 0;
        hipGetDevice(&dev);
        hipDeviceGetAttribute(&cus, hipDeviceAttributeMultiprocessorCount, dev);
        hipFuncSetAttribute((const void*)mega_fwd, hipFuncAttributeMaxDynamicSharedMemorySize, LDS_BYTES);
        hipOccupancyMaxActiveBlocksPerMultiprocessor(&per_cu, (const void*)mega_fwd, NWAVES * 64, LDS_BYTES);
        (void)hipGetLastError();
        grid = cus;
        if (n_in != 9 || out_size != T * D || ws_size < WS_END || per_cu < 1) { fprintf(stderr, "kernel_launch: unexpected problem (n_in %d out %d ws %zu per_cu %d)\n", n_in, out_size, ws_size, per_cu); grid = -1; }
    }
    if (grid < 0) return;
    hipMemsetAsync((char*)d_ws + WS_CTL, 0, CTL_BYTES, stream);
    Args a{};
    for (int i = 0; i < 9; ++i) a.in[i] = (const float*)d_in[i];
    a.out = (float*)d_out; a.ws = (unsigned char*)d_ws;
    void* args[] = {&a};
    hipError_t e = hipLaunchCooperativeKernel((const void*)mega_fwd, dim3(grid), dim3(NWAVES * 64), args, LDS_BYTES, stream);
    if (e != hipSuccess) fprintf(stderr, "cooperative launch failed: %s\n", hipGetErrorString(e));
}
```

```cpp
#include <hip/hip_runtime.h>
#include <hip/hip_cooperative_groups.h>
#include <cstdio>
#include <cstdint>
namespace cg = cooperative_groups;
__device__ __forceinline__ int launder_i(int x) { asm volatile("" : "+v"(x)); return x; }
namespace pg8 {
#define PG8_LAS __attribute__((address_space(3)))
typedef unsigned short bf16_t;
typedef short bf16x8 __attribute__((ext_vector_type(8)));
typedef float f32x4 __attribute__((ext_vector_type(4)));
typedef unsigned u32x4 __attribute__((ext_vector_type(4)));
constexpr int BM = 256, BK = 64, HALF = 128, HTB = HALF * BK * 2  , STAGE_BYTES = 8 * HTB, NXCD = 8, WGM = 8;

__host__ __device__ __forceinline__ int lds_byte(int r, int c) { const int st = (r >> 4) * 2 + (c >> 5), rr = r & 15, cc = c & 31, ob = rr * 64 + cc * 2; return st * 1024 + (ob ^ (((ob >> 9) & 1) << 5)); }
__host__ __device__ __forceinline__ void stage_rc(int b, int& R, int& C) { const int st = b / 1024, sb = b % 1024, swz = sb ^ (((sb >> 9) & 1) << 5); R = (st >> 1) * 16 + swz / 64; C = (st & 1) * 32 + (swz % 64) / 2; }
__host__ __device__ __forceinline__ int perm32(int rho) { const int n = rho >> 4, i = rho & 15; return 8 * (i >> 2) + 4 * n + (i & 3); }

struct Unit { int pm, pn; };
struct Gemm { const bf16_t* A; const bf16_t* Bt; int M, N, K; };

struct StaticOrder {
    int nM, nN, nwg, G, c, split;
    __host__ __device__ void init(int M, int N, int G_, int c_) { nM = M / BM; nN = N / BM; nwg = nM * nN; G = G_; c = c_; split = 0; }
    __host__ __device__ bool next(int i, Unit& u) const {
        if (split) {
            const int per = c < split ? 2 : 4; if (i >= per) return false;
            const int L2 = c < split ? 2 * c + i : 2 * split + 4 * (c - split) + i;
            u.pm = L2 % nM; u.pn = L2 / nM; return true;
        }
        const long L = (long)i * G + c; if (L >= nwg) return false;
        int wgid = (int)L; { const int q = nwg / NXCD, r = nwg % NXCD, xcd = wgid % NXCD, off = wgid / NXCD; wgid = (xcd < r ? xcd * (q + 1) : r * (q + 1) + (xcd - r) * q) + off; }
        const int nig = WGM * nN, gid = wgid / nig, fm = gid * WGM, gsz = (nM - fm) < WGM ? (nM - fm) : WGM;
        u.pm = fm + ((wgid % nig) % gsz); u.pn = (wgid % nig) / gsz; return true;
    }
    __device__ __forceinline__ void a_ready(const Unit&) const {}
    __device__ __forceinline__ void done(const Unit&) const {}
};

__device__ __forceinline__ unsigned cvt_pk_bf16(float lo, float hi) { unsigned r; asm volatile("v_cvt_pk_bf16_f32 %0, %1, %2" : "=v"(r) : "v"(lo), "v"(hi)); return r; }
template <class Epi, class Sched, bool ALIGN_EPI = false, bool SP2 = false>
__device__ __forceinline__ void gemm_phase(PG8_LAS unsigned char* lds, const Gemm g, const Sched& S, const Epi& E) {
    const int tid = launder_i((int)threadIdx.x), wid = __builtin_amdgcn_readfirstlane(tid >> 6), lane = tid & 63, wr = wid >> 2, wc = wid & 3, fr = lane & 15, fq = lane >> 4;
    const int K = g.K, nt = K / BK;
    unsigned voffA[2], voffB[2];
#pragma unroll
    for (int i = 0; i < 2; ++i) { int R, C; stage_rc(tid * 16 + i * 8192, R, C); const int Rb = Epi::PERM ? ((R & ~31) + perm32(R & 31)) : R;
        voffA[i] = (unsigned)(R * K + C) * 2u; voffB[i] = (unsigned)(Rb * K + C) * 2u; }
    const size_t kstep = (size_t)(BK * 2);
    const size_t hstep = (size_t)HALF * K * 2;
    const size_t tstep = 2 * hstep;
    const unsigned ldsw = (unsigned)wid * 1024u;
    const int aoff = lds_byte(wr * 64 + fr, fq * 8), boff = lds_byte(wc * 32 + fr, fq * 8);
#define PG8_SA(b, h) (((b) * 2 + (h)) * HTB)
#define PG8_SB(b, h) ((4 + (b) * 2 + (h)) * HTB)
#define PG8_STAGE(bufoff, gbase, voff) do { _Pragma("unroll") for (int _i = 0; _i < 2; ++_i) \
        __builtin_amdgcn_global_load_lds((const unsigned*)((const char*)(gbase) + (voff)[_i]), (PG8_LAS unsigned*)(lds + (bufoff) + ldsw + _i * 8192), 16, 0, 0); } while (0)
#define PG8_LDA(dst, b, h) do { _Pragma("unroll") for (int m = 0; m < 4; ++m) _Pragma("unroll") for (int k = 0; k < 2; ++k) dst[m][k] = *(const PG8_LAS bf16x8*)(lds + PG8_SA(b, h) + aoff + m * 2048 + k * 1024); } while (0)
#define PG8_LDB(dst, b, h) do { _Pragma("unroll") for (int n = 0; n < 2; ++n) _Pragma("unroll") for (int k = 0; k < 2; ++k) dst[n][k] = *(const PG8_LAS bf16x8*)(lds + PG8_SB(b, h) + boff + n * 2048 + k * 1024); } while (0)
#define PG8_MMA(ai, bj, At, Bt) do { __builtin_amdgcn_s_setprio(1); _Pragma("unroll") for (int m = 0; m < 4; ++m) _Pragma("unroll") for (int n = 0; n < 2; ++n) _Pragma("unroll") for (int k = 0; k < 2; ++k) \
        acc[ai][bj][m][n] = __builtin_amdgcn_mfma_f32_16x16x32_bf16(Bt[n][k], At[m][k], acc[ai][bj][m][n], 0, 0, 0); __builtin_amdgcn_s_setprio(0); } while (0)
#define PG8_WAIT_V(n) asm volatile("s_waitcnt vmcnt(" #n ")" ::: "memory")
#define PG8_WAIT_L(n) asm volatile("s_waitcnt lgkmcnt(" #n ")" ::: "memory")
#define PG8_BAR __builtin_amdgcn_s_barrier()
#define PG8_SCHED __builtin_amdgcn_sched_barrier(0)
    Unit cur, nxt; int ui = 0;
    if (!S.next(0, cur)) return;
    f32x4 acc[2][2][4][2];
#pragma unroll
    for (int a = 0; a < 2; ++a)
#pragma unroll
        for (int b = 0; b < 2; ++b)
#pragma unroll
            for (int m = 0; m < 4; ++m)
#pragma unroll
                for (int n = 0; n < 2; ++n) acc[a][b][m][n] = (f32x4){0.f, 0.f, 0.f, 0.f};
    bf16x8 At[4][2], B0[2][2], B1[2][2];
    const char* cA = (const char*)g.A + (size_t)cur.pm * tstep; const char* cB = (const char*)g.Bt + (size_t)cur.pn * tstep;
    S.a_ready(cur);
    if constexpr (SP2) {
        PG8_STAGE(PG8_SB(0, 0), cB, voffB); PG8_STAGE(PG8_SB(0, 1), cB + hstep, voffB); PG8_STAGE(PG8_SA(0, 0), cA, voffA); PG8_STAGE(PG8_SA(0, 1), cA + hstep, voffA);
        if (wr == 1) PG8_BAR;
        PG8_WAIT_V(2); PG8_BAR;
        PG8_STAGE(PG8_SB(1, 0), cB + kstep, voffB); PG8_STAGE(PG8_SA(1, 0), cA + kstep, voffA); PG8_STAGE(PG8_SB(1, 1), cB + hstep + kstep, voffB);
        PG8_WAIT_V(6); PG8_BAR;
    } else {
        PG8_STAGE(PG8_SB(0, 0), cB, voffB); PG8_STAGE(PG8_SA(0, 0), cA, voffA); PG8_STAGE(PG8_SB(0, 1), cB + hstep, voffB); PG8_STAGE(PG8_SA(0, 1), cA + hstep, voffA);
        if (wr == 1) PG8_BAR;
        PG8_WAIT_V(4); PG8_BAR;
        PG8_STAGE(PG8_SB(1, 0), cB + kstep, voffB); PG8_STAGE(PG8_SA(1, 0), cA + kstep, voffA); PG8_STAGE(PG8_SB(1, 1), cB + hstep + kstep, voffB);
        PG8_WAIT_V(6); PG8_BAR;
    }
    for (;;) {
        const bool has_next = S.next(ui + 1, nxt);
        const char* nA = has_next ? (const char*)g.A + (size_t)nxt.pm * tstep : cA; const char* nB = has_next ? (const char*)g.Bt + (size_t)nxt.pn * tstep : cB;
        for (int t = 0; t < nt; t += 2) {
            const bool last = (t == nt - 2);
            const char* a1 = cA + (size_t)(t + 1) * kstep;
            const char* a2 = last ? nA : cA + (size_t)(t + 2) * kstep; const char* b2 = last ? nB : cB + (size_t)(t + 2) * kstep;
            const char* a3 = a2 + kstep; const char* b3 = b2 + kstep;
            if (last && has_next) S.a_ready(nxt);
            if constexpr (SP2) {
            PG8_LDB(B0, 0, 0); PG8_LDB(B1, 0, 1); PG8_SCHED; PG8_LDA(At, 0, 0); PG8_STAGE(PG8_SA(1, 1), a1 + hstep, voffA);
            PG8_WAIT_V(8); PG8_WAIT_L(0); PG8_BAR; PG8_MMA(0, 0, At, B0); PG8_MMA(0, 1, At, B1); PG8_BAR; PG8_SCHED;
            PG8_LDA(At, 0, 1); PG8_STAGE(PG8_SB(0, 0), b2, voffB); PG8_STAGE(PG8_SB(0, 1), b2 + hstep, voffB); PG8_STAGE(PG8_SA(0, 0), a2, voffA);
            PG8_WAIT_V(8); PG8_WAIT_L(0); PG8_BAR; PG8_MMA(1, 0, At, B0); PG8_MMA(1, 1, At, B1); PG8_BAR; PG8_SCHED;
            PG8_LDB(B0, 1, 0); PG8_LDB(B1, 1, 1); PG8_SCHED; PG8_LDA(At, 1, 0); PG8_STAGE(PG8_SA(0, 1), a2 + hstep, voffA);
            PG8_WAIT_V(8); PG8_WAIT_L(0); PG8_BAR; PG8_MMA(0, 0, At, B0); PG8_MMA(0, 1, At, B1); PG8_BAR; PG8_SCHED;
            PG8_LDA(At, 1, 1); PG8_STAGE(PG8_SB(1, 0), b3, voffB); PG8_STAGE(PG8_SB(1, 1), b3 + hstep, voffB); PG8_STAGE(PG8_SA(1, 0), a3, voffA);
            PG8_WAIT_V(8); PG8_WAIT_L(0); PG8_BAR; PG8_MMA(1, 0, At, B0); PG8_MMA(1, 1, At, B1); PG8_BAR; PG8_SCHED;
            } else {
            PG8_LDB(B0, 0, 0); PG8_SCHED; PG8_LDA(At, 0, 0); PG8_STAGE(PG8_SA(1, 1), a1 + hstep, voffA);
            PG8_WAIT_L(8); PG8_BAR; PG8_WAIT_L(0); PG8_MMA(0, 0, At, B0); PG8_BAR; PG8_SCHED;
            PG8_LDB(B1, 0, 1); PG8_STAGE(PG8_SB(0, 0), b2, voffB);
            PG8_BAR; PG8_WAIT_L(0); PG8_MMA(0, 1, At, B1); PG8_BAR;
            PG8_LDA(At, 0, 1); PG8_STAGE(PG8_SA(0, 0), a2, voffA);
            PG8_BAR; PG8_WAIT_L(0); PG8_MMA(1, 0, At, B0); PG8_BAR; PG8_SCHED;
            PG8_STAGE(PG8_SB(0, 1), b2 + hstep, voffB);
            PG8_WAIT_V(6); PG8_BAR; PG8_MMA(1, 1, At, B1); PG8_BAR;
            PG8_LDB(B0, 1, 0); PG8_SCHED; PG8_LDA(At, 1, 0); PG8_STAGE(PG8_SA(0, 1), a2 + hstep, voffA);
            PG8_WAIT_L(8); PG8_BAR; PG8_WAIT_L(0); PG8_MMA(0, 0, At, B0); PG8_BAR; PG8_SCHED;
            PG8_LDB(B1, 1, 1); PG8_STAGE(PG8_SB(1, 0), b3, voffB);
            PG8_BAR; PG8_WAIT_L(0); PG8_MMA(0, 1, At, B1); PG8_BAR;
            PG8_LDA(At, 1, 1); PG8_STAGE(PG8_SA(1, 0), a3, voffA);
            PG8_BAR; PG8_WAIT_L(0); PG8_MMA(1, 0, At, B0); PG8_BAR; PG8_SCHED;
            PG8_STAGE(PG8_SB(1, 1), b3 + hstep, voffB);
            PG8_WAIT_V(6); PG8_BAR; PG8_MMA(1, 1, At, B1); PG8_BAR;
            }
        }
        if constexpr (ALIGN_EPI) { if (wr == 0) PG8_BAR; }
        if constexpr (!Epi::AFTER_DRAIN) { E(acc, cur, wr, wc, fr, fq); S.done(cur); }
        if (!has_next) break;
#pragma unroll
        for (int a = 0; a < 2; ++a)
#pragma unroll
            for (int b = 0; b < 2; ++b)
#pragma unroll
                for (int m = 0; m < 4; ++m)
#pragma unroll
                    for (int n = 0; n < 2; ++n) acc[a][b][m][n] = (f32x4){0.f, 0.f, 0.f, 0.f};
        cur = nxt; cA = nA; cB = nB; ++ui;
        if constexpr (ALIGN_EPI) { if (wr == 1) PG8_BAR; }
    }
    PG8_WAIT_V(0);
    if constexpr (!ALIGN_EPI) { if (wr == 0) PG8_BAR; }
    PG8_BAR;
    if constexpr (Epi::AFTER_DRAIN) { E.fused(acc, cur, wr, wc, fr, fq, lds, wid, lane); S.done(cur); }
#undef PG8_SA
#undef PG8_SB
#undef PG8_STAGE
#undef PG8_LDA
#undef PG8_LDB
#undef PG8_MMA
#undef PG8_WAIT_V
#undef PG8_WAIT_L
#undef PG8_BAR
#undef PG8_SCHED
}
}

constexpr int NWAVES = 8;
constexpr int LDS_BYTES = 135168;
constexpr int NB = 8, SEQ = 4096, T = NB * SEQ, D = 1024, INW = 9612, DEPTH = 2;
constexpr int A_Q = 0, A_K = 256, A_V = 512, A_G = 768, B_Q = 1024, B_KC = 1280, B_VC = 1344, B_KS = 1408, B_VS = 1472, B_KW = 1536, B_VW = 1600, B_G = 1664, B_NG = 1920,
              C_Q = 1932, C_K = 2188, C_V = 2444, C_G = 2700, D_Q = 2956, D_K = 3724, D_V = 4492, D_G = 5260, MRG = 5516;
constexpr size_t MiB = 1u << 20, KiB = 1024;
constexpr size_t WS_CTL = 0, WS_COS = 1 * MiB, WS_SIN = 1 * MiB + 512 * KiB, WS_KMEAN = 2 * MiB, WS_BIASP = 2 * MiB + 128 * KiB, WS_BIAS = 2 * MiB + 192 * KiB,
                 WS_KCMP = 2 * MiB + 512 * KiB, WS_VCMPT = 2 * MiB + 768 * KiB, WS_MMASK = 3 * MiB, WS_NMASK = 3 * MiB + 512 * KiB, WS_LSE = 4 * MiB,
                 WS_W1T = 6 * MiB, WS_W2T = 8 * MiB, WS_WQK = 9 * MiB, WS_WV = 15 * MiB, WS_WG = 18 * MiB, WS_WM = 20 * MiB, WS_WUP = 28 * MiB, WS_WOUT = 30 * MiB,
                 WS_H = 32 * MiB, WS_QK = 96 * MiB, WS_VT = 320 * MiB, WS_U = 320 * MiB, WS_Y = 224 * MiB, WS_END = 432 * MiB;
constexpr size_t SLOT_BYTES = 16 * MiB;
constexpr int SL_QA = 0, SL_QB = 1, SL_QC = 2, SL_QD0 = 3, SL_QBR = 4, SL_QD1 = 5, SL_QD2 = 6, SL_OWIN = 7, SL_KA = 8, SL_KB4 = 9, SL_KC = 10, SL_KD0 = 11, SL_OSLC = 20;
constexpr int NQK = 3072, NV = 1536;
constexpr int CTL_BYTES = 4096;

typedef unsigned short bf16_t;
typedef short bf16x8 __attribute__((ext_vector_type(8)));
typedef float f32x4 __attribute__((ext_vector_type(4)));
typedef float f32x2 __attribute__((ext_vector_type(2)));
typedef float f32x16 __attribute__((ext_vector_type(16)));
typedef unsigned u32x4 __attribute__((ext_vector_type(4)));
typedef unsigned u32x2 __attribute__((ext_vector_type(2)));
typedef __bf16 bf16v2 __attribute__((ext_vector_type(2)));
#define LAS __attribute__((address_space(3)))
#define GAS __attribute__((address_space(1)))
#define DI __device__ __forceinline__
#define MFMA32(a, b, c) __builtin_amdgcn_mfma_f32_32x32x16_bf16((a), (b), (c), 0, 0, 0)

constexpr float LOG2E = 1.4426950408889634f, LN2 = 0.6931471805599453f;
DI float sconst(float x) { asm volatile("" : "+s"(x)); return x; }
constexpr float SM_SCALE = 0.125f, SM_C = 0.125f * LOG2E, NEG_C = -1e30f, MFLOOR_C = -30000.f;
#define NEG sconst(NEG_C)
#define MFLOOR sconst(MFLOOR_C)

DI unsigned pk2(float lo, float hi) { const bf16v2 r = __builtin_convertvector((f32x2){lo, hi}, bf16v2); return __builtin_bit_cast(unsigned, r); }
DI float bf_lo(unsigned w) { return __uint_as_float(w << 16); }
DI float bf_hi(unsigned w) { return __uint_as_float(w & 0xffff0000u); }
DI float bf1(bf16_t x) { return __uint_as_float((unsigned)x << 16); }
DI float fexp2(float x) { return __builtin_amdgcn_exp2f(x); }
DI float flog2(float x) { return __builtin_amdgcn_logf(x); }
DI float frcp(float x) { return __builtin_amdgcn_rcpf(x); }
DI float sigmoidf_(float x) { return frcp(1.f + fexp2(-x * LOG2E)); }
DI float wave_sum(float v) {
#pragma unroll
    for (int o = 1; o < 64; o <<= 1) v += __shfl_xor(v, o);
    return v;
}
DI float xhalf(float v) { return __shfl_xor(v, 32); }
DI float hmaxf_(float v) { const auto r = __builtin_amdgcn_permlane32_swap(__float_as_uint(v), __float_as_uint(v), false, false); return fmaxf(__uint_as_float(r[0]), __uint_as_float(r[1])); }
DI float hsumf_(float v) { const auto r = __builtin_amdgcn_permlane32_swap(__float_as_uint(v), __float_as_uint(v), false, false); return __uint_as_float(r[0]) + __uint_as_float(r[1]); }
DI bf16_t* slot_ptr(unsigned char* ws, int s) { return (bf16_t*)(ws + WS_QK + (size_t)s * SLOT_BYTES); }
DI void load8(const bf16_t* p, float (&f)[8]) { const u32x4 w = *(const GAS u32x4*)p; f[0] = bf_lo(w.x); f[1] = bf_hi(w.x); f[2] = bf_lo(w.y); f[3] = bf_hi(w.y); f[4] = bf_lo(w.z); f[5] = bf_hi(w.z); f[6] = bf_lo(w.w); f[7] = bf_hi(w.w); }
DI void store8(bf16_t* p, const float (&f)[8]) { u32x4 w; w.x = pk2(f[0], f[1]); w.y = pk2(f[2], f[3]); w.z = pk2(f[4], f[5]); w.w = pk2(f[6], f[7]); *(GAS u32x4*)p = w; }
DI void store4(bf16_t* p, float a, float b, float c, float d) { u32x2 w; w.x = pk2(a, b); w.y = pk2(c, d); *(GAS u32x2*)p = w; }

struct Epi {
    static constexpr bool PERM = true, AFTER_DRAIN = false;
    int kind, first; unsigned char* ws; const float* xin; float* xout;
    typedef pg8::f32x4 a4;
    DI void operator()(const a4 (&acc)[2][2][4][2], const pg8::Unit& u, int wr, int wc, int fr, int fq) const {
        if (kind == 0) {
            const int tile = u.pn;
            const int slot = (int)((0xDCB653A29180ull >> (4 * tile)) & 15ull);
            bf16_t* dst = slot_ptr(ws, slot); bf16_t* dst2 = slot_ptr(ws, SL_QBR);
            const bool ropeall = (tile <= 1) || (tile >= 6);
            const int g = 4 * (wc & 1) + fq, d0 = 4 * g;
            const float* cosT = (const float*)(ws + WS_COS); const float* sinT = (const float*)(ws + WS_SIN);
#pragma unroll
            for (int ai = 0; ai < 2; ++ai)
#pragma unroll
                for (int m = 0; m < 4; ++m) {
                    const int tok = u.pm * 256 + ai * 128 + wr * 64 + m * 16 + fr, pos = tok & (SEQ - 1);
                    const f32x4 cs = *(const GAS f32x4*)(cosT + pos * 32 + d0), sn = *(const GAS f32x4*)(sinT + pos * 32 + d0);
#pragma unroll
                    for (int bj = 0; bj < 2; ++bj) {
                        const int hs = 2 * bj + (wc >> 1);
                        const a4 v0 = acc[ai][bj][m][0], v1 = acc[ai][bj][m][1];
                        const a4 r0 = v0 * cs - v1 * sn, r1 = v0 * sn + v1 * cs;
                        const size_t off = (size_t)tok * 256 + hs * 64 + d0;
                        const bool rope = ropeall || (tile == 3 && hs >= 2);
                        if (tile == 2) { store4(dst + off, v0[0], v0[1], v0[2], v0[3]); store4(dst + off + 32, v1[0], v1[1], v1[2], v1[3]);
                                         store4(dst2 + off, r0[0], r0[1], r0[2], r0[3]); store4(dst2 + off + 32, r1[0], r1[1], r1[2], r1[3]); }
                        else if (rope) { store4(dst + off, r0[0], r0[1], r0[2], r0[3]); store4(dst + off + 32, r1[0], r1[1], r1[2], r1[3]); }
                        else { store4(dst + off, v0[0], v0[1], v0[2], v0[3]); store4(dst + off + 32, v1[0], v1[1], v1[2], v1[3]); }
                    }
                    asm volatile("" ::: "memory");
                }
        } else if (kind == 1) {
            bf16_t* VT = (bf16_t*)(ws + WS_VT);
#pragma unroll
            for (int ai = 0; ai < 2; ++ai)
#pragma unroll
                for (int m = 0; m < 4; ++m) {
                    const int r = u.pm * 256 + ai * 128 + wr * 64 + m * 16 + fr;
                    bf16_t* rowp = VT + (size_t)r * T;
                    const bool gate = (r >= 1408 && r < 1420);
#pragma unroll
                    for (int bj = 0; bj < 2; ++bj) {
                        const int c0 = u.pn * 256 + bj * 128 + wc * 32 + 8 * fq;
                        const a4 v0 = acc[ai][bj][m][0], v1 = acc[ai][bj][m][1];
                        float v[8] = {v0[0], v0[1], v0[2], v0[3], v1[0], v1[1], v1[2], v1[3]};
                        if (gate) {
#pragma unroll
                            for (int j = 0; j < 8; ++j) v[j] = sigmoidf_(v[j]);
                        }
                        if (u.pm == 3) {
                            const int b = c0 >> 12, p0 = c0 & (SEQ - 1), mm0 = p0 >> 2;
                            bf16_t* q = rowp + b * SEQ + mm0;
#pragma unroll
                            for (int c = 0; c < 4; ++c) *(GAS unsigned*)(q + c * 1024) = pk2(v[c], v[c + 4]);
                        } else if (u.pm == 4) {
                            const int b = c0 >> 12, p0 = c0 & (SEQ - 1), mm = p0 >> 4, cc0 = p0 & 15;
                            bf16_t* q = rowp + b * SEQ + cc0 * 256 + mm;
#pragma unroll
                            for (int j = 0; j < 8; ++j) ((GAS bf16_t*)q)[j * 256] = (bf16_t)(pk2(v[j], 0.f) & 0xffffu);
                        } else store8(rowp + c0, v);
                    }
                    asm volatile("" ::: "memory");
                }
        } else if (kind == 2) {
            const int br = u.pn;
            const bf16_t* VT = (const bf16_t*)(ws + WS_VT);
            const float* LSE = (const float*)(ws + WS_LSE);
#pragma unroll
            for (int ai = 0; ai < 2; ++ai)
#pragma unroll
                for (int m = 0; m < 4; ++m) {
                    const int tok = u.pm * 256 + ai * 128 + wr * 64 + m * 16 + fr;
#pragma unroll
                    for (int bj = 0; bj < 2; ++bj) {
                        const int cb = bj * 128 + wc * 32 + 8 * fq, head = cb >> 6;
                        const a4 v0 = acc[ai][bj][m][0], v1 = acc[ai][bj][m][1];
                        float gt[8] = {v0[0], v0[1], v0[2], v0[3], v1[0], v1[1], v1[2], v1[3]};
                        const size_t off = (size_t)tok * 256 + cb;
                        float o[8];
                        bf16_t* dst;
                        if (br == 0) { dst = slot_ptr(ws, SL_QA) + off; load8(dst, o); }
                        else if (br == 2) { dst = slot_ptr(ws, SL_QC) + off; load8(dst, o); }
                        else if (br == 1) {
                            dst = slot_ptr(ws, SL_QB) + off;
                            float oc[8], os[8], ow[8]; load8(dst, oc); load8(slot_ptr(ws, SL_OSLC) + off, os); load8(slot_ptr(ws, SL_OWIN) + off, ow);
                            const GAS bf16_t* VTg = (const GAS bf16_t*)VT; const float g0 = bf1(VTg[(size_t)(1408 + head) * T + tok]), g1 = bf1(VTg[(size_t)(1412 + head) * T + tok]), g2 = bf1(VTg[(size_t)(1416 + head) * T + tok]);
#pragma unroll
                            for (int j = 0; j < 8; ++j) o[j] = g0 * oc[j] + g1 * os[j] + g2 * ow[j];
                        } else {
                            dst = slot_ptr(ws, SL_QD0) + off;
                            float o0[8], o1[8], o2[8]; load8(dst, o0); load8(slot_ptr(ws, SL_QD1) + off, o1); load8(slot_ptr(ws, SL_QD2) + off, o2);
                            const GAS float* LSEg = (const GAS float*)LSE; const float l0 = LSEg[((size_t)0 * T + tok) * 4 + head], l1 = LSEg[((size_t)1 * T + tok) * 4 + head], l2 = LSEg[((size_t)2 * T + tok) * 4 + head];
                            const float mx = fmaxf(l0, fmaxf(l1, l2));
                            const float e0 = fexp2((l0 - mx) * LOG2E), e1 = fexp2((l1 - mx) * LOG2E), e2 = fexp2((l2 - mx) * LOG2E);
                            const float inv = frcp(e0 + e1 + e2);
#pragma unroll
                            for (int j = 0; j < 8; ++j) o[j] = (e0 * o0[j] + e1 * o1[j] + e2 * o2[j]) * inv;
                        }
#pragma unroll
                        for (int j = 0; j < 8; ++j) o[j] *= gt[j] * sigmoidf_(gt[j]);
                        store8(dst, o);
                        asm volatile("" ::: "memory");
                    }
                }
        } else {
            bf16_t* U = (bf16_t*)(ws + WS_U); bf16_t* Y = (bf16_t*)(ws + WS_Y);
#pragma unroll
            for (int ai = 0; ai < 2; ++ai)
#pragma unroll
                for (int m = 0; m < 4; ++m) {
                    const int tok = u.pm * 256 + ai * 128 + wr * 64 + m * 16 + fr;
#pragma unroll
                    for (int bj = 0; bj < 2; ++bj) {
                        const int col = u.pn * 256 + bj * 128 + wc * 32 + 8 * fq;
                        const a4 v0 = acc[ai][bj][m][0], v1 = acc[ai][bj][m][1];
                        float v[8] = {v0[0], v0[1], v0[2], v0[3], v1[0], v1[1], v1[2], v1[3]};
                        const size_t off = (size_t)tok * D + col;
                        if (kind == 3) store8(U + off, v);
                        else if (kind == 4) {
                            float uu[8]; load8(U + off, uu);
                            float y[8];
                            if (first) {
#pragma unroll
                                for (int j = 0; j < 8; ++j) y[j] = sigmoidf_(v[j]) * uu[j];
                            } else {
                                load8(Y + off, y);
#pragma unroll
                                for (int j = 0; j < 8; ++j) y[j] += sigmoidf_(v[j]) * uu[j];
                            }
                            store8(Y + off, y);
                        } else {
                            const f32x4 x0 = *(const GAS f32x4*)(xin + off), x1 = *(const GAS f32x4*)(xin + off + 4);
                            *(GAS f32x4*)(xout + off) = (f32x4){x0[0] + v[0], x0[1] + v[1], x0[2] + v[2], x0[3] + v[3]};
                            *(GAS f32x4*)(xout + off + 4) = (f32x4){x1[0] + v[4], x1[1] + v[5], x1[2] + v[6], x1[3] + v[7]};
                        }
                        asm volatile("" ::: "memory");
                    }
                }
        }
    }
};

DI void transpose_item(const float* W, int K, int N, bf16_t* WT, int k0, int n0, int sc, LAS float* scr, int lane) {
    const int sc4 = __shfl(sc, 4 * (lane & 7));
#pragma unroll
    for (int i = 0; i < 8; ++i) {
        const int kk = 8 * i + (lane >> 3);
        const f32x4 w = sc4 >= 0 ? *(const GAS f32x4*)(W + (size_t)(k0 + kk) * N + sc4) : (f32x4){0.f, 0.f, 0.f, 0.f};
        LAS float* d = scr + kk * 33 + 4 * (lane & 7);
        d[0] = w.x; d[1] = w.y; d[2] = w.z; d[3] = w.w;
    }
    asm volatile("s_waitcnt lgkmcnt(0)" ::: "memory");
    const int c = lane & 7;
#pragma unroll
    for (int j = 0; j < 4; ++j) { const int n = (lane >> 3) + 8 * j; const LAS float* s = scr + (8 * c) * 33 + n;
        u32x4 o; o.x = pk2(s[0 * 33], s[1 * 33]); o.y = pk2(s[2 * 33], s[3 * 33]); o.z = pk2(s[4 * 33], s[5 * 33]); o.w = pk2(s[6 * 33], s[7 * 33]);
        *(GAS u32x4*)(WT + (size_t)(n0 + n) * K + k0 + 8 * c) = o; }
    asm volatile("s_waitcnt lgkmcnt(0)" ::: "memory");
}
DI int src_qk(int n) {
    const int tile = n >> 8, hs = (n >> 6) & 3, g = (n >> 3) & 7, e = n & 7, d = 4 * g + (e & 3) + 32 * (e >> 2);
    int base;
    switch (tile) {
        case 0: base = A_Q + 64 * hs; break; case 1: base = A_K + 64 * hs; break; case 2: base = B_Q + 64 * hs; break;
        case 3: base = hs == 0 ? B_KC : hs == 1 ? B_VC : hs == 2 ? B_KS : B_KW; break;
        case 4: base = C_Q + 64 * hs; break; case 5: base = C_K + 64 * hs; break;
        case 6: case 7: case 8: base = D_Q + 256 * (tile - 6) + 64 * hs; break;
        default: base = D_K + 256 * (tile - 9) + 64 * hs; break;
    }
    return base + d;
}
DI int src_v(int n) {
    const int slot = n >> 6, d = n & 63;
    if (slot < 4) return A_V + 64 * slot + d;
    if (slot < 8) return C_V + 64 * (slot - 4) + d;
    if (slot < 20) return D_V + 64 * (slot - 8) + d;
    if (slot == 20) return B_VS + d;
    if (slot == 21) return B_VW + d;
    if (slot == 22 && d < 12) return B_NG + d;
    return -1;
}
DI int src_g(int n) { const int br = n >> 8, c = n & 255; return (br == 0 ? A_G : br == 1 ? B_G : br == 2 ? C_G : D_G) + c; }

DI const bf16_t* launder_vp(const bf16_t* p) { asm volatile("" : "+v"(p)); return p; }
DI int kappa(int rho) { return (rho & 16) | ((rho & 4) << 1) | ((rho & 8) >> 1) | (rho & 3); }
DI bf16x8 ldfrag(const bf16_t* p) { return *(const GAS bf16x8*)p; }
DI bf16x8 pack8(const float* p) { u32x4 w; w.x = pk2(p[0], p[1]); w.y = pk2(p[2], p[3]); w.z = pk2(p[4], p[5]); w.w = pk2(p[6], p[7]); return __builtin_bit_cast(bf16x8, w); }

#define BLK_BAR() do { asm volatile("s_waitcnt lgkmcnt(0)" ::: "memory"); __builtin_amdgcn_s_barrier(); asm volatile("" ::: "memory"); } while (0)
struct SmState { f32x16 O[2]; float m, l; };
DI void sm_init(SmState& st) {
#pragma unroll
    for (int i = 0; i < 16; ++i) { st.O[0][i] = 0.f; st.O[1][i] = 0.f; }
    st.m = MFLOOR; st.l = 0.f;
}
struct Frag { bf16x8 k[4], v[2][2]; };
DI void ld_frag(Frag& f, const bf16_t* kp, const bf16_t* v0p, const bf16_t* v1p) {
#pragma unroll
    for (int s = 0; s < 4; ++s) f.k[s] = ldfrag(kp + 16 * s);
#pragma unroll
    for (int s = 0; s < 2; ++s) { f.v[0][s] = ldfrag(v0p + 16 * s); f.v[1][s] = ldfrag(v1p + 16 * s); }
}
struct FragG { u32x4 k[4], v[4]; };
constexpr int WLDS_BYTES = 4608 + 5120;
DI void ldg(FragG& g, const bf16_t* kq, size_t kstride, const bf16_t* vq, size_t vstride) {
#pragma unroll
    for (int j = 0; j < 4; ++j) g.k[j] = *(const GAS u32x4*)(kq + (size_t)(8 * j) * kstride);
#pragma unroll
    for (int j = 0; j < 4; ++j) g.v[j] = *(const GAS u32x4*)(vq + (size_t)(16 * j) * vstride);
}
DI void stage(const FragG& g, Frag& f, LAS unsigned char* wl, int lane) {
    const int r = lane & 31, h = lane >> 5;
    LAS u32x4* kw = (LAS u32x4*)(wl + (lane >> 3) * 144 + (lane & 7) * 16);
    LAS u32x4* vw = (LAS u32x4*)(wl + 4608 + (lane >> 2) * 80 + (lane & 3) * 16);
#pragma unroll
    for (int j = 0; j < 4; ++j) kw[j * 72] = g.k[j];
#pragma unroll
    for (int j = 0; j < 4; ++j) vw[j * 80] = g.v[j];
    asm volatile("" ::: "memory");
    const LAS unsigned char* kr = wl + kappa(r) * 144 + 16 * h;
    const LAS unsigned char* vr = wl + 4608 + r * 80 + 16 * h;
#pragma unroll
    for (int s = 0; s < 4; ++s) f.k[s] = *(const LAS bf16x8*)(kr + 32 * s);
#pragma unroll
    for (int s = 0; s < 2; ++s) { f.v[0][s] = *(const LAS bf16x8*)(vr + 32 * s); f.v[1][s] = *(const LAS bf16x8*)(vr + 32 * 80 + 32 * s); }
    asm volatile("" ::: "memory");
}
template <int MASK>
DI void sm_compute(SmState& st, const bf16x8 (&qf)[4], const Frag& f, int key0, bool allow, int klo, int khi) {
    f32x16 S;
#pragma unroll
    for (int i = 0; i < 16; ++i) S[i] = 0.f;
#pragma unroll
    for (int s = 0; s < 4; ++s) S = MFMA32(f.k[s], qf[s], S);
    const float neg = NEG, mfl = MFLOOR;
    float p[16]; float mx = mfl;
#pragma unroll
    for (int i = 0; i < 16; ++i) {
        float v = S[i];
        if (MASK == 2) { const int key = key0 + 16 * (i >> 3) + (i & 7); v = (allow && key >= klo && key <= khi) ? v : neg; }
        p[i] = v; mx = fmaxf(mx, v);
    }
    if (MASK == 1) mx = allow ? mx : mfl;
    mx = hmaxf_(mx);
    const float mn = fmaxf(st.m, mx), mc = mn * SM_C;
    const float mcl = (MASK == 1 && !allow) ? sconst(INFINITY) : mc;
    const f32x2 c2 = {SM_C, SM_C}, m2 = {mcl, mcl};
    f32x2 rs2 = {0.f, 0.f};
#pragma unroll
    for (int k = 0; k < 8; ++k) {
        const f32x2 x = (f32x2){p[2 * k], p[2 * k + 1]} * c2 - m2;
        const f32x2 e = {fexp2(x.x), fexp2(x.y)};
        p[2 * k] = e.x; p[2 * k + 1] = e.y; rs2 += e;
    }
    const float rs = rs2.x + rs2.y;
    if (__ballot(mn != st.m) != 0ull) {
        const float alpha = fexp2((st.m - mn) * SM_C);
        st.l *= alpha;
#pragma unroll
        for (int i = 0; i < 16; ++i) { st.O[0][i] *= alpha; st.O[1][i] *= alpha; }
    }
    st.l += rs; st.m = mn;
    const bf16x8 pf0 = pack8(p), pf1 = pack8(p + 8);
    st.O[0] = MFMA32(f.v[0][0], pf0, st.O[0]); st.O[0] = MFMA32(f.v[0][1], pf1, st.O[0]);
    st.O[1] = MFMA32(f.v[1][0], pf0, st.O[1]); st.O[1] = MFMA32(f.v[1][1], pf1, st.O[1]);
}
DI void write_o(bf16_t* orow, const f32x16 (&O)[2], float inv, int h) {
#pragma unroll
    for (int dt = 0; dt < 2; ++dt)
#pragma unroll
        for (int g = 0; g < 4; ++g) store4(orow + 32 * dt + 8 * g + 4 * h, O[dt][4 * g] * inv, O[dt][4 * g + 1] * inv, O[dt][4 * g + 2] * inv, O[dt][4 * g + 3] * inv);
}
DI void load_q(bf16x8 (&qf)[4], const bf16_t* qrow, int h) {
#pragma unroll
    for (int s = 0; s < 4; ++s) qf[s] = ldfrag(qrow + 16 * s + 8 * h);
}

struct SmTask { const bf16_t* qrow; const bf16_t* kb; const bf16_t* vb0; bf16_t* orow; float* lse; size_t kstride; int ti_lo, ti_hi, ti_edge, bshift, klo, khi; unsigned long long need, full, allow; };
DI int sm_next(int ti, int ti_hi, int bshift, unsigned long long need) {
    int nt = ti + 1;
    while (nt <= ti_hi) { if ((need >> (nt >> bshift)) & 1ull) return nt; nt = ((nt >> bshift) + 1) << bshift; }
    return -1;
}
DI void sm_step(SmState& st, const bf16x8 (&qf)[4], const Frag& f, const SmTask& tk, int ti, int h) {
    const int blk = ti >> tk.bshift;
    const bool allow = (tk.allow >> blk) & 1ull;
    if ((ti == tk.ti_hi) || (ti == tk.ti_edge)) sm_compute<2>(st, qf, f, 32 * ti + 8 * h, allow, tk.klo, tk.khi);
    else if (!((tk.full >> blk) & 1ull)) sm_compute<1>(st, qf, f, 32 * ti + 8 * h, allow, 0, 0);
    else sm_compute<0>(st, qf, f, 32 * ti + 8 * h, true, 0, 0);
}
DI void run_sm(const SmTask& tk, int lane, LAS unsigned char* wl) {
    const int h = lane >> 5;
    bf16x8 qf[4]; load_q(qf, tk.qrow, h);
    SmState st; sm_init(st);
    int ti = sm_next(tk.ti_lo - 1, tk.ti_hi, tk.bshift, tk.need);
    FragG GA, GB; Frag F;
    ldg(GA, tk.kb + (size_t)(32 * ti) * tk.kstride, tk.kstride, tk.vb0 + 32 * ti, T);
    for (;;) {
        int nt = sm_next(ti, tk.ti_hi, tk.bshift, tk.need); int lt = nt >= 0 ? nt : ti;
        ldg(GB, tk.kb + (size_t)(32 * lt) * tk.kstride, tk.kstride, tk.vb0 + 32 * lt, T);
        __builtin_amdgcn_sched_barrier(0);
        stage(GA, F, wl, lane);
        sm_step(st, qf, F, tk, ti, h);
        if (nt < 0) break;
        ti = nt;
        nt = sm_next(ti, tk.ti_hi, tk.bshift, tk.need); lt = nt >= 0 ? nt : ti;
        ldg(GA, tk.kb + (size_t)(32 * lt) * tk.kstride, tk.kstride, tk.vb0 + 32 * lt, T);
        __builtin_amdgcn_sched_barrier(0);
        stage(GB, F, wl, lane);
        sm_step(st, qf, F, tk, ti, h);
        if (nt < 0) break;
        ti = nt;
    }
    const float lt_ = hsumf_(st.l);
    write_o(tk.orow, st.O, frcp(lt_), h);
    if (tk.lse != nullptr && h == 0) *(GAS float*)tk.lse = st.m * SM_SCALE + flog2(lt_) * LN2;
}
DI unsigned long long bits_any(unsigned long long m, int n) {
    unsigned long long r = 0ull;
    for (int j = 0; j < n; ++j) if (__ballot((m >> j) & 1ull) != 0ull) r |= 1ull << j;
    return r;
}
DI unsigned long long bits_all(unsigned long long m, int n) {
    unsigned long long r = 0ull;
    for (int j = 0; j < n; ++j) if (__ballot((m >> j) & 1ull) == ~0ull) r |= 1ull << j;
    return r;
}
DI void task_sm(unsigned char* ws, int kind, int b, int hh, int qt, int lane, LAS unsigned char* wl) {
    const int r = lane & 31, kr = lane >> 3, kc = 8 * (lane & 7), vd = lane >> 2, vc = 8 * (lane & 3);
    const bf16_t* VT = (const bf16_t*)(ws + WS_VT);
    SmTask tk;
    tk.lse = nullptr; tk.kstride = 256; tk.ti_edge = -1; tk.klo = -1; tk.ti_lo = 0;
    if (kind <= 2) {
        const int t0 = 32 * qt, t = t0 + r; const size_t row = (size_t)(b * SEQ + t) * 256 + hh * 64;
        tk.ti_hi = qt; tk.khi = t;
        if (kind == 0) {
            const int cb = t0 >> 8;
            const unsigned long long mask = ((const GAS unsigned*)(ws + WS_MMASK))[(b * 4 + hh) * SEQ + t];
            tk.qrow = slot_ptr(ws, SL_QA) + row; tk.orow = slot_ptr(ws, SL_QA) + row;
            tk.kb = slot_ptr(ws, SL_KA) + (size_t)(b * SEQ + kr) * 256 + hh * 64 + kc;
            tk.vb0 = VT + (size_t)(hh * 64 + vd) * T + b * SEQ + vc;
            tk.bshift = 3; tk.allow = mask; tk.need = bits_any(mask, cb + 1); tk.full = bits_all(mask, cb + 1);
        } else if (kind == 1) {
            const int cur = t0 >> 6;
            const unsigned long long mask = ((const GAS unsigned long long*)(ws + WS_NMASK))[b * SEQ + t];
            tk.qrow = slot_ptr(ws, SL_QBR) + row; tk.orow = slot_ptr(ws, SL_OSLC) + row;
            tk.kb = slot_ptr(ws, SL_KB4) + (size_t)(b * SEQ + kr) * 256 + 128 + kc;
            tk.vb0 = VT + (size_t)(1280 + vd) * T + b * SEQ + vc;
            tk.bshift = 1; tk.allow = mask; tk.need = bits_any(mask, cur + 1); tk.full = bits_all(mask, cur + 1);
        } else {
            tk.qrow = slot_ptr(ws, SL_QBR) + row; tk.orow = slot_ptr(ws, SL_OWIN) + row;
            tk.kb = slot_ptr(ws, SL_KB4) + (size_t)(b * SEQ + kr) * 256 + 192 + kc;
            tk.vb0 = VT + (size_t)(1344 + vd) * T + b * SEQ + vc;
            tk.bshift = 8; tk.allow = 1ull; tk.need = 1ull; tk.full = 1ull;
            tk.ti_lo = qt - 16 < 0 ? 0 : qt - 16; tk.ti_edge = qt - 16; tk.klo = t - 511;
        }
    } else {
        const int g = kind - 3, dil = g == 0 ? 1 : g == 1 ? 4 : 16, L = SEQ / dil, nsub = 128 / dil, c = qt / nsub, sq = qt - c * nsub;
        const int mq = 32 * sq + r, tok = b * SEQ + mq * dil + c;
        bf16_t* qr = slot_ptr(ws, g == 0 ? SL_QD0 : g == 1 ? SL_QD1 : SL_QD2) + (size_t)tok * 256 + hh * 64;
        tk.qrow = qr; tk.orow = qr; tk.kstride = (size_t)256 * dil;
        tk.kb = slot_ptr(ws, SL_KD0 + g) + (size_t)(b * SEQ + c) * 256 + (size_t)kr * tk.kstride + hh * 64 + kc;
        tk.vb0 = VT + (size_t)(512 + 256 * g + hh * 64 + vd) * T + b * SEQ + (g == 0 ? 0 : c * L) + vc;
        tk.lse = (float*)(ws + WS_LSE) + ((size_t)g * T + tok) * 4 + hh;
        tk.bshift = 8; tk.allow = 1ull; tk.need = 1ull; tk.full = 1ull;
        tk.ti_hi = sq; tk.ti_lo = sq - 4 < 0 ? 0 : sq - 4; tk.ti_edge = sq - 4; tk.klo = mq - 128; tk.khi = mq;
    }
    run_sm(tk, lane, wl);
}

DI void frag_from_image(Frag& f, const LAS unsigned char* img, int lane) {
    const int r = lane & 31, h = lane >> 5;
    const LAS unsigned char* kr = img + kappa(r) * 144 + 16 * h;
    const LAS unsigned char* vr = img + 4608 + r * 80 + 16 * h;
#pragma unroll
    for (int s = 0; s < 4; ++s) f.k[s] = *(const LAS bf16x8*)(kr + 32 * s);
#pragma unroll
    for (int s = 0; s < 2; ++s) { f.v[0][s] = *(const LAS bf16x8*)(vr + 32 * s); f.v[1][s] = *(const LAS bf16x8*)(vr + 32 * 80 + 32 * s); }
}
DI void run_heavy_group(unsigned char* ws, int kind, int b, int hh, int qg, int wave, int lane, int tid, LAS unsigned char* img) {
    const int r = lane & 31, h = lane >> 5, qt = 8 * qg + wave, t0 = 32 * qt, t = t0 + r, tmax = 8 * qg + 7;
    const size_t row = (size_t)(b * SEQ + t) * 256 + hh * 64;
    SmTask tk; tk.lse = nullptr; tk.kstride = 256; tk.ti_edge = -1; tk.klo = -1; tk.ti_lo = 0; tk.ti_hi = qt; tk.khi = t; tk.kb = nullptr; tk.vb0 = nullptr;
    const bf16_t* gp; size_t gstep; int woff;
    if (kind == 0) {
        const int cb = t0 >> 8;
        const unsigned long long mask = ((const GAS unsigned*)(ws + WS_MMASK))[(b * 4 + hh) * SEQ + t];
        tk.qrow = slot_ptr(ws, SL_QA) + row; tk.orow = slot_ptr(ws, SL_QA) + row;
        tk.bshift = 3; tk.allow = mask; tk.need = bits_any(mask, cb + 1); tk.full = bits_all(mask, cb + 1);
        if (tid < 256) { gp = slot_ptr(ws, SL_KA) + (size_t)(b * SEQ + (tid >> 3)) * 256 + hh * 64 + 8 * (tid & 7); gstep = (size_t)32 * 256; woff = (tid >> 3) * 144 + (tid & 7) * 16; }
        else { const int t2 = tid - 256; gp = (const bf16_t*)(ws + WS_VT) + (size_t)(hh * 64 + (t2 >> 2)) * T + b * SEQ + 8 * (t2 & 3); gstep = 32; woff = 4608 + (t2 >> 2) * 80 + (t2 & 3) * 16; }
    } else {
        const int cur = t0 >> 6;
        const unsigned long long mask = ((const GAS unsigned long long*)(ws + WS_NMASK))[b * SEQ + t];
        tk.qrow = slot_ptr(ws, SL_QBR) + row; tk.orow = slot_ptr(ws, SL_OSLC) + row;
        tk.bshift = 1; tk.allow = mask; tk.need = bits_any(mask, cur + 1); tk.full = bits_all(mask, cur + 1);
        if (tid < 256) { gp = slot_ptr(ws, SL_KB4) + (size_t)(b * SEQ + (tid >> 3)) * 256 + 128 + 8 * (tid & 7); gstep = (size_t)32 * 256; woff = (tid >> 3) * 144 + (tid & 7) * 16; }
        else { const int t2 = tid - 256; gp = (const bf16_t*)(ws + WS_VT) + (size_t)(1280 + (t2 >> 2)) * T + b * SEQ + 8 * (t2 & 3); gstep = 32; woff = 4608 + (t2 >> 2) * 80 + (t2 & 3) * 16; }
    }
    bf16x8 qf[4]; load_q(qf, tk.qrow, h);
    SmState st; sm_init(st);
    LAS unsigned char* img0 = img; LAS unsigned char* img1 = img + WLDS_BYTES;
    u32x4 r0 = *(const GAS u32x4*)gp;
    u32x4 r1 = *(const GAS u32x4*)(gp + gstep * (size_t)(tmax < 1 ? tmax : 1));
    *(LAS u32x4*)(img0 + woff) = r0;
    r0 = *(const GAS u32x4*)(gp + gstep * (size_t)(tmax < 2 ? tmax : 2));
    BLK_BAR();
    Frag F;
    int ti = 0;
    for (;;) {
        if (ti <= qt && ((tk.need >> (ti >> tk.bshift)) & 1ull)) { frag_from_image(F, img0, lane); sm_step(st, qf, F, tk, ti, h); }
        if (ti == tmax) break;
        *(LAS u32x4*)(img1 + woff) = r1;
        r1 = *(const GAS u32x4*)(gp + gstep * (size_t)(ti + 3 > tmax ? tmax : ti + 3));
        BLK_BAR(); ++ti;
        if (ti <= qt && ((tk.need >> (ti >> tk.bshift)) & 1ull)) { frag_from_image(F, img1, lane); sm_step(st, qf, F, tk, ti, h); }
        if (ti == tmax) break;
        *(LAS u32x4*)(img0 + woff) = r0;
        r0 = *(const GAS u32x4*)(gp + gstep * (size_t)(ti + 3 > tmax ? tmax : ti + 3));
        BLK_BAR(); ++ti;
    }
    const float lt_ = hsumf_(st.l);
    write_o(tk.orow, st.O, frcp(lt_), h);
}

DI void stick_compute(f32x16 (&O)[2], float& carry, const bf16x8 (&qf)[4], const Frag& f, int kt0, int t, int h) {
    f32x16 S;
#pragma unroll
    for (int i = 0; i < 16; ++i) S[i] = 0.f;
#pragma unroll
    for (int s = 0; s < 4; ++s) S = MFMA32(f.k[s], qf[s], S);
    float lsm[16], ls[16]; float sA = 0.f, sB = 0.f;
    const int key0 = kt0 + 8 * h; const float neg = NEG;
#pragma unroll
    for (int i = 0; i < 16; ++i) {
        const int key = key0 + 16 * (i >> 3) + (i & 7);
        const bool valid = key < t;
        const float z = S[i] * SM_SCALE;
        const float sp = fmaxf(z, 0.f) + flog2(1.f + fexp2(-fabsf(z) * LOG2E)) * LN2;
        lsm[i] = valid ? -sp : 0.f;
        ls[i] = valid ? z - sp : neg;
        if (i < 8) sA += lsm[i]; else sB += lsm[i];
    }
    const float pA = xhalf(sA), pB = xhalf(sB);
    const float baseB = carry + (h == 0 ? pB : 0.f), baseA = carry + sB + pB + (h == 0 ? pA : 0.f);
    float p[16]; float run = baseA;
#pragma unroll
    for (int e = 7; e >= 0; --e) { p[e] = fexp2((ls[e] + run) * LOG2E); run += lsm[e]; }
    run = baseB;
#pragma unroll
    for (int e = 15; e >= 8; --e) { p[e] = fexp2((ls[e] + run) * LOG2E); run += lsm[e]; }
    carry += (sA + sB) + (pA + pB);
    const bf16x8 pf0 = pack8(p), pf1 = pack8(p + 8);
    O[0] = MFMA32(f.v[0][0], pf0, O[0]); O[0] = MFMA32(f.v[0][1], pf1, O[0]);
    O[1] = MFMA32(f.v[1][0], pf0, O[1]); O[1] = MFMA32(f.v[1][1], pf1, O[1]);
}
DI void task_stick(unsigned char* ws, int b, int hh, int qt, int lane, LAS unsigned char* wl) {
    const int r = lane & 31, h = lane >> 5, t0 = 32 * qt, t = t0 + r;
    bf16_t* qrow = slot_ptr(ws, SL_QC) + (size_t)(b * SEQ + t) * 256 + hh * 64;
    bf16x8 qf[4]; load_q(qf, qrow, h);
    const bf16_t* kb = slot_ptr(ws, SL_KC) + (size_t)(b * SEQ + (lane >> 3)) * 256 + hh * 64 + 8 * (lane & 7);
    const bf16_t* vb0 = (const bf16_t*)(ws + WS_VT) + (size_t)(256 + hh * 64 + (lane >> 2)) * T + b * SEQ + 8 * (lane & 3);
    f32x16 O[2];
#pragma unroll
    for (int i = 0; i < 16; ++i) { O[0][i] = 0.f; O[1][i] = 0.f; }
    float carry = 0.f;
    int kt0 = t0;
    FragG GA, GB; Frag F;
    ldg(GA, kb + (size_t)kt0 * 256, 256, vb0 + kt0, T);
    for (;;) {
        int nk = kt0 - 32, lk = nk >= 0 ? nk : kt0;
        ldg(GB, kb + (size_t)lk * 256, 256, vb0 + lk, T);
        __builtin_amdgcn_sched_barrier(0);
        stage(GA, F, wl, lane);
        stick_compute(O, carry, qf, F, kt0, t, h);
        if (nk < 0 || __ballot(carry > -104.f) == 0ull) break;
        kt0 = nk; nk = kt0 - 32; lk = nk >= 0 ? nk : kt0;
        ldg(GA, kb + (size_t)lk * 256, 256, vb0 + lk, T);
        __builtin_amdgcn_sched_barrier(0);
        stage(GB, F, wl, lane);
        stick_compute(O, carry, qf, F, kt0, t, h);
        if (nk < 0 || __ballot(carry > -104.f) == 0ull) break;
        kt0 = nk;
    }
    write_o(qrow, O, 1.f, h);
}

DI void task_cmp(unsigned char* ws, int b, int qt, int lane, LAS float* imp, int hh0, int nh, bool leader) {
    const int r = lane & 31, h = lane >> 5, t0 = 32 * qt, t = t0 + r, cur = t0 >> 6;
    const int nvis = t >= 31 ? ((t - 31) >> 4) + 1 : 0;
    const int nvmax = (t0 >> 4) + 1, ntile = (nvmax + 31) >> 5;
    const bool need_imp = cur >= 16;
    if (leader) { for (int i = lane; i < 32 * 65; i += 64) imp[i] = 0.f; }
    BLK_BAR();
    const bf16_t* kb_ = (const bf16_t*)(ws + WS_KCMP) + (size_t)(b * 256 + kappa(r)) * 64 + 8 * h;
    const bf16_t* vb0_ = (const bf16_t*)(ws + WS_VCMPT) + (size_t)(b * 64 + r) * 256 + 8 * h;
    for (int hh = hh0; hh < hh0 + nh; ++hh) {
        const bf16_t* kb = launder_vp(kb_); const bf16_t* vb0 = launder_vp(vb0_); const bf16_t* vb1 = vb0 + 32 * 256;
        bf16_t* qrow = slot_ptr(ws, SL_QB) + (size_t)(b * SEQ + t) * 256 + hh * 64;
        bf16x8 qf[4]; load_q(qf, qrow, h);
        float m = MFLOOR, l = 0.f;
        bf16x8 kn[4];
#pragma unroll
        for (int s = 0; s < 4; ++s) kn[s] = ldfrag(kb + 16 * s);
        for (int tl = 0; tl < ntile; ++tl) {
            bf16x8 kf[4];
#pragma unroll
            for (int s = 0; s < 4; ++s) kf[s] = kn[s];
            const int nl = tl + 1 < ntile ? tl + 1 : tl;
#pragma unroll
            for (int s = 0; s < 4; ++s) kn[s] = ldfrag(kb + (size_t)(32 * nl) * 64 + 16 * s);
            f32x16 S;
#pragma unroll
            for (int i = 0; i < 16; ++i) S[i] = 0.f;
#pragma unroll
            for (int s = 0; s < 4; ++s) S = MFMA32(kf[s], qf[s], S);
            const float neg = NEG; float mx = MFLOOR;
#pragma unroll
            for (int i = 0; i < 16; ++i) { const int key = 32 * tl + 8 * h + 16 * (i >> 3) + (i & 7); const float v = key < nvis ? S[i] : neg; S[i] = v; mx = fmaxf(mx, v); }
            mx = hmaxf_(mx);
            const float mn = fmaxf(m, mx), mc = mn * SM_C;
            float rs = 0.f;
#pragma unroll
            for (int i = 0; i < 16; ++i) rs += fexp2(S[i] * SM_C - mc);
            l = l * fexp2((m - mn) * SM_C) + rs; m = mn;
        }
        const float lt = hsumf_(l);
        const float inv = nvis > 0 ? frcp(lt) : 0.f, mc = m * SM_C;
        f32x16 O[2];
#pragma unroll
        for (int i = 0; i < 16; ++i) { O[0][i] = 0.f; O[1][i] = 0.f; }
        Frag fn; ld_frag(fn, kb, vb0, vb1);
        for (int tl = 0; tl < ntile; ++tl) {
            bf16x8 kf[4], vf[2][2];
#pragma unroll
            for (int s = 0; s < 4; ++s) kf[s] = fn.k[s];
#pragma unroll
            for (int s = 0; s < 2; ++s) { vf[0][s] = fn.v[0][s]; vf[1][s] = fn.v[1][s]; }
            const int nl = tl + 1 < ntile ? tl + 1 : tl;
            ld_frag(fn, kb + (size_t)(32 * nl) * 64, vb0 + 32 * nl, vb1 + 32 * nl);
            f32x16 S;
#pragma unroll
            for (int i = 0; i < 16; ++i) S[i] = 0.f;
#pragma unroll
            for (int s = 0; s < 4; ++s) S = MFMA32(kf[s], qf[s], S);
            float p[16];
#pragma unroll
            for (int i = 0; i < 16; ++i) { const int key = 32 * tl + 8 * h + 16 * (i >> 3) + (i & 7); p[i] = key < nvis ? fexp2(S[i] * SM_C - mc) * inv : 0.f; }
            if (need_imp) {
#pragma unroll
                for (int a = 0; a < 2; ++a) {
                    const int u = 4 * tl + 2 * a + h; const float* q = p + 8 * a;
                    LAS float* row = imp + r * 65 + 2 * u;
                    atomicAdd((float*)(row + 0), (q[0] + q[1]) + (q[2] + q[3]));
                    atomicAdd((float*)(row + 1), (q[3] + q[4]) + (q[5] + q[6]) + q[7]);
                    if (2 * u + 2 < 64) atomicAdd((float*)(row + 2), q[7]);
                }
            }
            const bf16x8 pf0 = pack8(p), pf1 = pack8(p + 8);
            O[0] = MFMA32(vf[0][0], pf0, O[0]); O[0] = MFMA32(vf[0][1], pf1, O[0]);
            O[1] = MFMA32(vf[1][0], pf0, O[1]); O[1] = MFMA32(vf[1][1], pf1, O[1]);
        }
        write_o(qrow, O, 1.f, h);
    }
    asm volatile("s_waitcnt lgkmcnt(0)" ::: "memory");
    BLK_BAR();
    if (leader) {
        unsigned long long mask;
        if (cur <= 15) mask = (2ull << cur) - 1ull;
        else {
            float v[32];
#pragma unroll
            for (int i = 0; i < 32; ++i) v[i] = imp[r * 65 + 2 * i + h];
            mask = 1ull | (1ull << cur) | (1ull << (cur - 1));
            for (int k = 0; k < 13; ++k) {
                float best = -1.f; int bj = 64;
#pragma unroll
                for (int i = 0; i < 32; ++i) { const int j = 2 * i + h; const bool ok = j >= 1 && j <= cur - 2 && !((mask >> j) & 1ull); if (ok && v[i] > best) { best = v[i]; bj = j; } }
                const float ob = xhalf(best); const int oj = __shfl_xor(bj, 32);
                if (ob > best || (ob == best && oj < bj)) { best = ob; bj = oj; }
                if (bj < 64) mask |= 1ull << bj;
            }
        }
        if (lane < 32) ((GAS unsigned long long*)(ws + WS_NMASK))[b * SEQ + t] = mask;
    }
    asm volatile("s_waitcnt lgkmcnt(0)" ::: "memory");
}

DI void task_moba_gate(unsigned char* ws, int b, int hh, int qt, int lane) {
    const int r = lane & 31, h = lane >> 5, t0 = 32 * qt, t = t0 + r, cb = t0 >> 8;
    unsigned sel = 0u;
    if (cb <= 3) sel = (1u << cb) - 1u;
    else {
        const bf16_t* qrow = slot_ptr(ws, SL_QA) + (size_t)(b * SEQ + t) * 256 + hh * 64 + 32 * h;
        float q[32];
#pragma unroll
        for (int j = 0; j < 4; ++j) { float f[8]; load8(qrow + 8 * j, f);
#pragma unroll
            for (int e = 0; e < 8; ++e) q[8 * j + e] = f[e]; }
        const GAS float* km = (const GAS float*)(ws + WS_KMEAN) + (size_t)((b * 4 + hh) * 16) * 64 + 32 * h;
        float gate[16];
#pragma unroll
        for (int n = 0; n < 16; ++n) {
            float s = 0.f;
            if (n < cb) {
#pragma unroll
                for (int d = 0; d < 32; ++d) s += q[d] * km[n * 64 + d];
            }
            s += xhalf(s);
            gate[n] = n < cb ? s : sconst(-INFINITY);
        }
#pragma unroll
        for (int k = 0; k < 3; ++k) {
            float best = sconst(-INFINITY); int bi = -1;
#pragma unroll
            for (int n = 0; n < 16; ++n) if (!((sel >> n) & 1u) && gate[n] > best) { best = gate[n]; bi = n; }
            if (bi >= 0) sel |= 1u << bi;
        }
    }
    if (lane < 32) ((GAS unsigned*)(ws + WS_MMASK))[(b * 4 + hh) * SEQ + t] = sel | (1u << cb);
}

DI void task_kmean(unsigned char* ws, int b, int hh, int blk, int lane) {
    const bf16_t* kp = slot_ptr(ws, SL_KA) + (size_t)(b * SEQ + 256 * blk + (lane >> 3)) * 256 + hh * 64 + 8 * (lane & 7);
    float s[8];
#pragma unroll
    for (int e = 0; e < 8; ++e) s[e] = 0.f;
#pragma unroll 8
    for (int i = 0; i < 32; ++i) { float f[8]; load8(kp + (size_t)(8 * i) * 256, f);
#pragma unroll
        for (int e = 0; e < 8; ++e) s[e] += f[e]; }
#pragma unroll
    for (int e = 0; e < 8; ++e) { s[e] += __shfl_xor(s[e], 8); s[e] += __shfl_xor(s[e], 16); s[e] += __shfl_xor(s[e], 32); }
    if (lane < 8) {
        GAS float* o = (GAS float*)(ws + WS_KMEAN) + ((b * 4 + hh) * 16 + blk) * 64 + 8 * lane;
#pragma unroll
        for (int e = 0; e < 8; ++e) o[e] = s[e] * (1.f / 256.f);
    }
}

DI void task_mlp_block(unsigned char* ws, int kv, int b, int rt, int wave, int lane, LAS float* part) {
    const int r = lane & 31, h = lane >> 5, n = 32 * rt + r, ne = n > 254 ? 254 : n;
    const bf16_t* xp = slot_ptr(ws, SL_KB4) + (size_t)(b * SEQ + 16 * ne) * 256 + kv * 64 + 8 * h;
    const bf16_t* w1 = (const bf16_t*)(ws + WS_W1T) + (size_t)(kv * 256 + 32 * wave + kappa(r)) * 2048 + 8 * h;
    f32x16 acc;
#pragma unroll
    for (int i = 0; i < 16; ++i) acc[i] = 0.f;
    bf16x8 xa[4], wa[4], xb[4], wb[4];
#pragma unroll
    for (int s = 0; s < 4; ++s) { xa[s] = ldfrag(xp + 16 * s); wa[s] = ldfrag(w1 + 16 * s); }
    for (int l = 0; l < 32; l += 2) {
#pragma unroll
        for (int s = 0; s < 4; ++s) { xb[s] = ldfrag(xp + (size_t)(l + 1) * 256 + 16 * s); wb[s] = ldfrag(w1 + 64 * (l + 1) + 16 * s); }
#pragma unroll
        for (int s = 0; s < 4; ++s) acc = MFMA32(wa[s], xa[s], acc);
        const int l2 = l + 2 < 32 ? l + 2 : l;
#pragma unroll
        for (int s = 0; s < 4; ++s) { xa[s] = ldfrag(xp + (size_t)l2 * 256 + 16 * s); wa[s] = ldfrag(w1 + 64 * l2 + 16 * s); }
#pragma unroll
        for (int s = 0; s < 4; ++s) acc = MFMA32(wb[s], xb[s], acc);
    }
    const GAS float* bias = (const GAS float*)(ws + WS_BIAS) + kv * 256 + 32 * wave;
    const bf16_t* w2 = (const bf16_t*)(ws + WS_W2T) + (size_t)(kv * 64 + r) * 256 + 32 * wave + 8 * h;
    float g[16];
#pragma unroll
    for (int i = 0; i < 16; ++i) {
        const float x = acc[i] + bias[16 * (i >> 3) + 8 * h + (i & 7)];
        const float y = 0.7978845608028654f * (x + 0.044715f * x * x * x);
        const float th = 1.f - 2.f * frcp(1.f + fexp2(2.f * LOG2E * y));
        g[i] = 0.5f * x * (1.f + th);
    }
    const bf16x8 pf0 = pack8(g), pf1 = pack8(g + 8);
    f32x16 out[2];
#pragma unroll
    for (int i = 0; i < 16; ++i) { out[0][i] = 0.f; out[1][i] = 0.f; }
#pragma unroll
    for (int dt = 0; dt < 2; ++dt) {
        out[dt] = MFMA32(ldfrag(w2 + (size_t)(32 * dt) * 256), pf0, out[dt]);
        out[dt] = MFMA32(ldfrag(w2 + (size_t)(32 * dt) * 256 + 16), pf1, out[dt]);
    }
#pragma unroll
    for (int dt = 0; dt < 2; ++dt)
#pragma unroll
        for (int i = 0; i < 16; ++i) part[((wave * 2 + dt) * 16 + i) * 64 + lane] = out[dt][i];
    __syncthreads();
    const int dt = wave >> 2, gq = wave & 3;
    float sum[4];
#pragma unroll
    for (int e = 0; e < 4; ++e) { float a = 0.f;
#pragma unroll
        for (int w = 0; w < 8; ++w) a += part[((w * 2 + dt) * 16 + 4 * gq + e) * 64 + lane];
        sum[e] = n <= 254 ? a : 0.f; }
    const int d0 = 32 * dt + 8 * gq + 4 * h;
    if (kv == 0) store4((bf16_t*)(ws + WS_KCMP) + (size_t)(b * 256 + n) * 64 + d0, sum[0], sum[1], sum[2], sum[3]);
    else {
        bf16_t* vt = (bf16_t*)(ws + WS_VCMPT) + (size_t)(b * 64 + d0) * 256 + n;
#pragma unroll
        for (int e = 0; e < 4; ++e) ((GAS bf16_t*)vt)[e * 256] = (bf16_t)(pk2(sum[e], 0.f) & 0xffffu);
    }
    __syncthreads();
}

struct Args { const float* in[9]; float* out; unsigned char* ws; int pad0, pad1; };

DI int launder(int x) { asm volatile("" : "+v"(x)); return x; }
DI unsigned char* launder_p(unsigned char* p) { asm volatile("" : "+s"(p)); return (unsigned char*)(__attribute__((address_space(1))) unsigned char*)p; }
#define FRESH() const int tid = launder(tid0), lane = tid & 63, gw = blockIdx.x * NWAVES + wave; (void)gw; (void)lane; unsigned char* ws = launder_p(ws0); (void)ws;
DI int next_task(unsigned* ctr, int lane) {
    int v = 0;
    if (lane == 0) v = (int)atomicAdd(ctr, 1u);
    return __builtin_amdgcn_readfirstlane(v);
}

#ifndef PROBE_A
#define PROBE_A 0
#define PROBE_B 0
#endif
enum { ST_P0 = 0, ST_BIAS, ST_G_QK, ST_G_VT, ST_P2, ST_P3, ST_P4, ST_G_GATE, ST_G_U0, ST_G_M0, ST_G_U1, ST_G_M1, ST_G_U2, ST_G_M2, ST_G_U3, ST_G_M3, ST_G_OUT, NSTEP_LAYER };

__global__ void __launch_bounds__(NWAVES * 64, 2) mega_fwd(Args a) {
    extern __shared__ __attribute__((aligned(16))) unsigned char lds_raw[];
    cg::grid_group grid = cg::this_grid();
    LAS unsigned char* lds = (LAS unsigned char*)lds_raw;
    const int tid0 = threadIdx.x, wave = __builtin_amdgcn_readfirstlane(tid0 >> 6);
    const int G = gridDim.x, NGW = G * NWAVES;
    unsigned char* ws0 = a.ws;

    if (blockIdx.x == 0) { for (int i = tid0; i < CTL_BYTES / 4; i += NWAVES * 64) ((GAS unsigned*)(ws0 + WS_CTL))[i] = 0u; }
    { FRESH();
    for (int e = blockIdx.x * (NWAVES * 64) + tid; e < SEQ * 32; e += G * NWAVES * 64) {
        const int pos = e >> 5, i = e & 31;
        const float inv = (float)exp2(-(double)i * (13.287712379549449 / 32.0));
        const float ang = (float)pos * inv;
        const double x = (double)ang, kq = rint(x * 0.6366197723675814);
        const double rr = (x - kq * 1.5707963267948966) - kq * 6.123233995736766e-17, r2 = rr * rr;
        const double sn = rr * (1.0 + r2 * (-1.0 / 6 + r2 * (1.0 / 120 + r2 * (-1.0 / 5040 + r2 * (1.0 / 362880 + r2 * (-1.0 / 39916800 + r2 * (1.0 / 6227020800.0)))))));
        const double cs = 1.0 + r2 * (-0.5 + r2 * (1.0 / 24 + r2 * (-1.0 / 720 + r2 * (1.0 / 40320 + r2 * (-1.0 / 3628800 + r2 * (1.0 / 479001600 + r2 * (-1.0 / 87178291200.0)))))));
        const int qd = (int)((long long)kq & 3);
        const double s_ = qd == 0 ? sn : qd == 1 ? cs : qd == 2 ? -sn : -cs, c_ = qd == 0 ? cs : qd == 1 ? -sn : qd == 2 ? -cs : sn;
        ((float*)(ws + WS_COS))[e] = (float)c_; ((float*)(ws + WS_SIN))[e] = (float)s_;
    } }

    for (int step = 0; step <= DEPTH * NSTEP_LAYER; ++step) {
        const int layer = step / NSTEP_LAYER, ls = step - layer * NSTEP_LAYER;
#if PROBE_A || PROBE_B
        if (blockIdx.x == 0 && tid0 == 0) ((unsigned long long*)(ws0 + WS_CTL + 2048))[32] = wall_clock64();
#endif
        if (layer == DEPTH) {
            FRESH(); const float* fw = a.in[8];
#if PROBE_A || PROBE_B
            float pa = 0.f, pb = 0.f;
            { const unsigned long long* tacc = (const unsigned long long*)(ws + WS_CTL + 2048);
              for (int k = 0; k < NSTEP_LAYER; ++k) { const float ms = (float)tacc[k] * 1e-5f; if ((PROBE_B >> k) & 1) pb += 0.002f * ms; } }
#endif
            for (int m = gw; m < T; m += NGW) {
                GAS f32x4* xr = (GAS f32x4*)(a.out + (size_t)m * D) + lane; const GAS f32x4* wr4 = (const GAS f32x4*)fw + lane;
                f32x4 v[4]; float s = 0.f;
#pragma unroll
                for (int j = 0; j < 4; ++j) { v[j] = xr[64 * j]; s += (v[j].x * v[j].x + v[j].y * v[j].y) + (v[j].z * v[j].z + v[j].w * v[j].w); }
                const float rs = rsqrtf(wave_sum(s) * (1.f / D) + sconst(1e-6f));
#pragma unroll
                for (int j = 0; j < 4; ++j) { const f32x4 w = wr4[64 * j]; f32x4 o = (f32x4){v[j].x * rs * w.x, v[j].y * rs * w.y, v[j].z * rs * w.z, v[j].w * rs * w.w};
#if PROBE_A || PROBE_B
                    o = o + ((lane & 1) ? pb : -pb); (void)pa;
#endif
                    xr[64 * j] = o; }
            }
            break;
        }
        const float* xin = layer == 0 ? a.in[0] : a.out;
        bool sync = false;
        if (ls == ST_P0) {
            const float* norm_w = a.in[1] + (size_t)layer * D;
            const float* w_in = a.in[2] + (size_t)layer * D * INW;
            const float* cmp_pos = a.in[3] + (size_t)layer * 2 * 2048;
            const float* cmp_w1 = a.in[4] + (size_t)layer * 2 * 2048 * 256;
            const float* cmp_w2 = a.in[5] + (size_t)layer * 2 * 256 * 64;
            const float* w_up = a.in[6] + (size_t)layer * 4 * 256 * D;
            const float* w_out = a.in[7] + (size_t)layer * D * D;
            FRESH(); LAS float* scr = (LAS float*)(lds + wave * 16384); bf16_t* Hb = (bf16_t*)(ws + WS_H);
            constexpr int I_QK = 16 * (NQK / 32), I_V = 16 * (NV / 32), I_G = 16 * 32, I_M = 16 * 128, I_UP = 4 * 4 * 32, I_OUT = 16 * 32, I_W1 = 2 * 32 * 8, I_W2 = 2 * 4 * 2;
            constexpr int NITEMS = I_QK + I_V + I_G + I_M + I_UP + I_OUT + I_W1 + I_W2;
            for (int it = gw; it < NITEMS; it += NGW) {
                int q = it;
                if (q < I_QK) { const int kb = q / (NQK / 32), nb = q % (NQK / 32); transpose_item(w_in, D, INW, (bf16_t*)(ws + WS_WQK), 64 * kb, 32 * nb, src_qk(32 * nb + (lane & 31)), scr, lane); continue; } q -= I_QK;
                if (q < I_V) { const int kb = q / (NV / 32), nb = q % (NV / 32); transpose_item(w_in, D, INW, (bf16_t*)(ws + WS_WV), 64 * kb, 32 * nb, src_v(32 * nb + (lane & 31)), scr, lane); continue; } q -= I_V;
                if (q < I_G) { const int kb = q / 32, nb = q % 32; transpose_item(w_in, D, INW, (bf16_t*)(ws + WS_WG), 64 * kb, 32 * nb, src_g(32 * nb + (lane & 31)), scr, lane); continue; } q -= I_G;
                if (q < I_M) { const int kb = q / 128, nb = q % 128; transpose_item(w_in, D, INW, (bf16_t*)(ws + WS_WM), 64 * kb, 32 * nb, MRG + 32 * nb + (lane & 31), scr, lane); continue; } q -= I_M;
                if (q < I_UP) { const int br = q / 128, q2 = q % 128, kb = q2 / 32, nb = q2 % 32; transpose_item(w_up + (size_t)br * 256 * D, 256, D, (bf16_t*)(ws + WS_WUP) + (size_t)br * D * 256, 64 * kb, 32 * nb, 32 * nb + (lane & 31), scr, lane); continue; } q -= I_UP;
                if (q < I_OUT) { const int kb = q / 32, nb = q % 32; transpose_item(w_out, D, D, (bf16_t*)(ws + WS_WOUT), 64 * kb, 32 * nb, 32 * nb + (lane & 31), scr, lane); continue; } q -= I_OUT;
                if (q < I_W1) { const int kv = q / 256, q2 = q % 256, kb = q2 / 8, nb = q2 % 8; transpose_item(cmp_w1 + (size_t)kv * 2048 * 256, 2048, 256, (bf16_t*)(ws + WS_W1T) + (size_t)kv * 256 * 2048, 64 * kb, 32 * nb, 32 * nb + (lane & 31), scr, lane); continue; } q -= I_W1;
                { const int kv = q / 8, q2 = q % 8, kb = q2 / 2, nb = q2 % 2; transpose_item(cmp_w2 + (size_t)kv * 256 * 64, 256, 64, (bf16_t*)(ws + WS_W2T) + (size_t)kv * 64 * 256, 64 * kb, 32 * nb, 32 * nb + (lane & 31), scr, lane); }
            }
            for (int it = gw; it < 2 * 4 * 32; it += NGW) {
                const int ch = it & 31, hg = (it >> 5) & 3, kv = it >> 7;
                const float* w1 = cmp_w1 + (size_t)kv * 2048 * 256 + (size_t)(64 * ch) * 256 + 64 * hg + lane; const float* pe = cmp_pos + kv * 2048 + 64 * ch;
                float s = 0.f;
#pragma unroll 8
                for (int f = 0; f < 64; ++f) s += pe[f] * w1[(size_t)f * 256];
                ((float*)(ws + WS_BIASP))[(ch * 2 + kv) * 256 + 64 * hg + lane] = s;
            }
            for (int m = gw; m < T; m += NGW) {
                const GAS f32x4* xr = (const GAS f32x4*)(xin + (size_t)m * D) + lane; const GAS f32x4* wr4 = (const GAS f32x4*)norm_w + lane;
                f32x4 v[4]; float s = 0.f;
#pragma unroll
                for (int j = 0; j < 4; ++j) { v[j] = xr[64 * j]; s += (v[j].x * v[j].x + v[j].y * v[j].y) + (v[j].z * v[j].z + v[j].w * v[j].w); }
                const float rs = rsqrtf(wave_sum(s) * (1.f / D) + sconst(1e-6f));
                GAS u32x2* o8 = (GAS u32x2*)(Hb + (size_t)m * D) + lane;
#pragma unroll
                for (int j = 0; j < 4; ++j) { const f32x4 w = wr4[64 * j]; u32x2 o; o.x = pk2(v[j].x * rs * w.x, v[j].y * rs * w.y); o.y = pk2(v[j].z * rs * w.z, v[j].w * rs * w.w); o8[64 * j] = o; }
            }
            sync = true;
        } else if (ls == ST_BIAS) {
            FRESH();
            if (blockIdx.x == 0) { float s = 0.f; for (int c = 0; c < 32; ++c) s += ((const float*)(ws + WS_BIASP))[c * 512 + tid]; ((float*)(ws + WS_BIAS))[tid] = s; }
        } else if (ls == ST_P2) {
        } else if (ls == ST_P3 || ls == ST_P4) {
            if (ls == ST_P3) {
                { FRESH();
                  for (int base = 0; base < 1024; base += 4 * G) {
                      const int it = base + blockIdx.x + G * (wave & 3); const int q = it < 1024 ? 1023 - it : 0;
                      task_cmp(ws, q & 7, q >> 3, lane, (LAS float*)(lds + (wave & 3) * 16384), 2 * (wave >> 2), it < 1024 ? 2 : 0, wave < 4 && it < 1024);
                  } }
                { FRESH();
                  for (int q = blockIdx.x + G * (NWAVES - 1 - wave); q < 4096; q += NGW) task_moba_gate(ws, q & 7, (q >> 3) & 3, q >> 5, lane); }
            }
            for (int pool = (ls == ST_P3 ? 0 : 2); pool < (ls == ST_P3 ? 2 : 3); ++pool) {
                FRESH();
                unsigned* ctr = (unsigned*)(ws + WS_CTL) + layer * 64 + 16 * pool;
                const int ngroups = pool == 0 ? 1024 : pool == 1 ? 1536 : 1024;
                volatile LAS int* gslot = (volatile LAS int*)(lds + 131072);
                for (;;) {
                    __syncthreads();
                    if (tid == 0) *gslot = (int)atomicAdd(ctr, 1u);
                    __syncthreads();
                    const int g = __builtin_amdgcn_readfirstlane(*gslot);
                    if (g >= ngroups) break;
                    if (pool == 2) { const int qg = 15 - (g >> 6), w = g & 63; run_heavy_group(ws, w >> 5, w & 7, (w >> 3) & 3, qg, wave, lane, tid, lds); }
                    else if (pool == 0 && g < 512) { task_stick(ws, g & 7, (g >> 3) & 3, 8 * (15 - (g >> 5)) + wave, lane, lds + wave * 16384); }
                    else {
                        const int kd = pool == 0 ? 3 : (g < 512 ? 2 : 4 + ((g - 512) >> 9)), w = g & 511;
                        task_sm(ws, kd, w & 7, (w >> 3) & 3, 8 * (w >> 5) + wave, lane, lds + wave * 16384);
                    }
                }
            }
            sync = true;
        } else {
            unsigned char* ws = launder_p(ws0); bf16_t* Hb = (bf16_t*)(ws + WS_H);
            pg8::Gemm g; Epi E{0, 0, ws, xin, a.out};
            if (ls == ST_G_QK) { g = pg8::Gemm{Hb, (const bf16_t*)(ws + WS_WQK), T, NQK, D}; E.kind = 0; sync = true; }
            else if (ls == ST_G_VT) { g = pg8::Gemm{(const bf16_t*)(ws + WS_WV), Hb, NV, T, D}; E.kind = 1; sync = true; }
            else if (ls == ST_G_GATE) { g = pg8::Gemm{Hb, (const bf16_t*)(ws + WS_WG), T, D, D}; E.kind = 2; sync = true; }
            else if (ls == ST_G_OUT) { g = pg8::Gemm{(const bf16_t*)(ws + WS_Y), (const bf16_t*)(ws + WS_WOUT), T, D, D}; E.kind = 5; sync = true; }
            else {
                const int k = ls - ST_G_U0, br = k >> 1;
                const int wslot = br == 0 ? SL_QA : br == 1 ? SL_QB : br == 2 ? SL_QC : SL_QD0;
                if ((k & 1) == 0) { g = pg8::Gemm{slot_ptr(ws, wslot), (const bf16_t*)(ws + WS_WUP) + (size_t)br * D * 256, T, D, 256}; E.kind = 3; }
                else { g = pg8::Gemm{Hb, (const bf16_t*)(ws + WS_WM) + (size_t)br * D * D, T, D, D}; E.kind = 4; E.first = (br == 0); sync = (br == 3); }
            }
            pg8::StaticOrder S; S.init(g.M, g.N, G, (int)blockIdx.x);
            if (ls == ST_G_VT) {
                FRESH();
                if (G == 256) {
                    if (blockIdx.x < 128) task_mlp_block(ws, blockIdx.x >> 6, (blockIdx.x >> 3) & 7, blockIdx.x & 7, wave, lane, (LAS float*)lds);
                    else if (blockIdx.x < 192) { const int q = (blockIdx.x - 128) * NWAVES + wave; task_kmean(ws, q >> 6, (q >> 4) & 3, q & 15, lane); }
                    S.split = 128;
                } else {
                    for (int q = gw; q < 512; q += NGW) task_kmean(ws, q >> 6, (q >> 4) & 3, q & 15, lane);
                    for (int it = blockIdx.x; it < 128; it += G) task_mlp_block(ws, it >> 6, (it >> 3) & 7, it & 7, wave, lane, (LAS float*)lds);
                }
                __syncthreads();
            }
            pg8::gemm_phase<Epi, pg8::StaticOrder, true, true>(lds, g, S, E);
        }
        if (sync) grid.sync();
#if PROBE_A || PROBE_B
        if (blockIdx.x == 0 && tid0 == 0) { unsigned long long* tp = (unsigned long long*)(ws0 + WS_CTL + 2048); tp[ls] += wall_clock64() - tp[32]; }
#endif
    }
}

extern "C" void kernel_launch(void* const* d_in, const int* in_sizes, int n_in, void* d_out, int out_size, void* d_ws, size_t ws_size, hipStream_t stream) {
    static int grid = 0;
    if (grid == 0) {
        int dev = 0, cus = 0, per_cu = 0;
        hipGetDevice(&dev);
        hipDeviceGetAttribute(&cus, hipDeviceAttributeMultiprocessorCount, dev);
        hipFuncSetAttribute((const void*)mega_fwd, hipFuncAttributeMaxDynamicSharedMemorySize, LDS_BYTES);
        hipOccupancyMaxActiveBlocksPerMultiprocessor(&per_cu, (const void*)mega_fwd, NWAVES * 64, LDS_BYTES);
        (void)hipGetLastError();
        grid = cus;
        if (n_in != 9 || out_size != T * D || ws_size < WS_END || per_cu < 1) { fprintf(stderr, "kernel_launch: unexpected problem (n_in %d out %d ws %zu per_cu %d)\n", n_in, out_size, ws_size, per_cu); grid = -1; }
    }
    if (grid < 0) return;
    Args a{};
    for (int i = 0; i < 9; ++i) a.in[i] = (const float*)d_in[i];
    a.out = (float*)d_out; a.ws = (unsigned char*)d_ws;
    void* args[] = {&a};
    hipError_t e = hipLaunchCooperativeKernel((const void*)mega_fwd, dim3(grid), dim3(NWAVES * 64), args, LDS_BYTES, stream);
    if (e != hipSuccess) fprintf(stderr, "cooperative launch failed: %s\n", hipGetErrorString(e));
}
```

```cpp
#include <hip/hip_runtime.h>
#include <hip/hip_cooperative_groups.h>
#include <cstdio>
#include <cstdint>
namespace cg = cooperative_groups;
__device__ __forceinline__ int launder_i(int x) { asm volatile("" : "+v"(x)); return x; }
namespace pg8 {
#define PG8_LAS __attribute__((address_space(3)))
typedef unsigned short bf16_t;
typedef short bf16x8 __attribute__((ext_vector_type(8)));
typedef float f32x4 __attribute__((ext_vector_type(4)));
typedef unsigned u32x4 __attribute__((ext_vector_type(4)));
constexpr int BM = 256, BK = 64, HALF = 128, HTB = HALF * BK * 2  , STAGE_BYTES = 8 * HTB, NXCD = 8, WGM = 8;

__host__ __device__ __forceinline__ int lds_byte(int r, int c) { const int st = (r >> 4) * 2 + (c >> 5), rr = r & 15, cc = c & 31, ob = rr * 64 + cc * 2; return st * 1024 + (ob ^ (((ob >> 9) & 1) << 5)); }
__host__ __device__ __forceinline__ void stage_rc(int b, int& R, int& C) { const int st = b / 1024, sb = b % 1024, swz = sb ^ (((sb >> 9) & 1) << 5); R = (st >> 1) * 16 + swz / 64; C = (st & 1) * 32 + (swz % 64) / 2; }
__host__ __device__ __forceinline__ int perm32(int rho) { const int n = rho >> 4, i = rho & 15; return 8 * (i >> 2) + 4 * n + (i & 3); }

struct Unit { int pm, pn; };
struct Gemm { const bf16_t* A; const bf16_t* Bt; int M, N, K; };

struct StaticOrder {
    int nM, nN, nwg, G, c, split;
    __host__ __device__ void init(int M, int N, int G_, int c_) { nM = M / BM; nN = N / BM; nwg = nM * nN; G = G_; c = c_; split = 0; }
    __host__ __device__ bool next(int i, Unit& u) const {
        if (split) {
            const int per = c < split ? 2 : 4; if (i >= per) return false;
            const int L2 = c < split ? 2 * c + i : 2 * split + 4 * (c - split) + i;
            u.pm = L2 % nM; u.pn = L2 / nM; return true;
        }
        const long L = (long)i * G + c; if (L >= nwg) return false;
        int wgid = (int)L; { const int q = nwg / NXCD, r = nwg % NXCD, xcd = wgid % NXCD, off = wgid / NXCD; wgid = (xcd < r ? xcd * (q + 1) : r * (q + 1) + (xcd - r) * q) + off; }
        const int nig = WGM * nN, gid = wgid / nig, fm = gid * WGM, gsz = (nM - fm) < WGM ? (nM - fm) : WGM;
        u.pm = fm + ((wgid % nig) % gsz); u.pn = (wgid % nig) / gsz; return true;
    }
    __device__ __forceinline__ void a_ready(const Unit&) const {}
    __device__ __forceinline__ void done(const Unit&) const {}
};

__device__ __forceinline__ unsigned cvt_pk_bf16(float lo, float hi) { unsigned r; asm volatile("v_cvt_pk_bf16_f32 %0, %1, %2" : "=v"(r) : "v"(lo), "v"(hi)); return r; }
template <class Epi, class Sched, bool ALIGN_EPI = false, bool SP2 = false>
__device__ __forceinline__ void gemm_phase(PG8_LAS unsigned char* lds, const Gemm g, const Sched& S, const Epi& E) {
    const int tid = launder_i((int)threadIdx.x), wid = __builtin_amdgcn_readfirstlane(tid >> 6), lane = tid & 63, wr = wid >> 2, wc = wid & 3, fr = lane & 15, fq = lane >> 4;
    const int K = g.K, nt = K / BK;
    unsigned voffA[2], voffB[2];
#pragma unroll
    for (int i = 0; i < 2; ++i) { int R, C; stage_rc(tid * 16 + i * 8192, R, C); const int Rb = Epi::PERM ? ((R & ~31) + perm32(R & 31)) : R;
        voffA[i] = (unsigned)(R * K + C) * 2u; voffB[i] = (unsigned)(Rb * K + C) * 2u; }
    const size_t kstep = (size_t)(BK * 2);
    const size_t hstep = (size_t)HALF * K * 2;
    const size_t tstep = 2 * hstep;
    const unsigned ldsw = (unsigned)wid * 1024u;
    const int aoff = lds_byte(wr * 64 + fr, fq * 8), boff = lds_byte(wc * 32 + fr, fq * 8);
#define PG8_SA(b, h) (((b) * 2 + (h)) * HTB)
#define PG8_SB(b, h) ((4 + (b) * 2 + (h)) * HTB)
#define PG8_STAGE(bufoff, gbase, voff) do { _Pragma("unroll") for (int _i = 0; _i < 2; ++_i) \
        __builtin_amdgcn_global_load_lds((const unsigned*)((const char*)(gbase) + (voff)[_i]), (PG8_LAS unsigned*)(lds + (bufoff) + ldsw + _i * 8192), 16, 0, 0); } while (0)
#define PG8_LDA(dst, b, h) do { _Pragma("unroll") for (int m = 0; m < 4; ++m) _Pragma("unroll") for (int k = 0; k < 2; ++k) dst[m][k] = *(const PG8_LAS bf16x8*)(lds + PG8_SA(b, h) + aoff + m * 2048 + k * 1024); } while (0)
#define PG8_LDB(dst, b, h) do { _Pragma("unroll") for (int n = 0; n < 2; ++n) _Pragma("unroll") for (int k = 0; k < 2; ++k) dst[n][k] = *(const PG8_LAS bf16x8*)(lds + PG8_SB(b, h) + boff + n * 2048 + k * 1024); } while (0)
#define PG8_MMA(ai, bj, At, Bt) do { __builtin_amdgcn_s_setprio(1); _Pragma("unroll") for (int m = 0; m < 4; ++m) _Pragma("unroll") for (int n = 0; n < 2; ++n) _Pragma("unroll") for (int k = 0; k < 2; ++k) \
        acc[ai][bj][m][n] = __builtin_amdgcn_mfma_f32_16x16x32_bf16(Bt[n][k], At[m][k], acc[ai][bj][m][n], 0, 0, 0); __builtin_amdgcn_s_setprio(0); } while (0)
#define PG8_WAIT_V(n) asm volatile("s_waitcnt vmcnt(" #n ")" ::: "memory")
#define PG8_WAIT_L(n) asm volatile("s_waitcnt lgkmcnt(" #n ")" ::: "memory")
#define PG8_BAR __builtin_amdgcn_s_barrier()
#define PG8_SCHED __builtin_amdgcn_sched_barrier(0)
    Unit cur, nxt; int ui = 0;
    if (!S.next(0, cur)) return;
    f32x4 acc[2][2][4][2];
#pragma unroll
    for (int a = 0; a < 2; ++a)
#pragma unroll
        for (int b = 0; b < 2; ++b)
#pragma unroll
            for (int m = 0; m < 4; ++m)
#pragma unroll
                for (int n = 0; n < 2; ++n) acc[a][b][m][n] = (f32x4){0.f, 0.f, 0.f, 0.f};
    bf16x8 At[4][2], B0[2][2], B1[2][2];
    const char* cA = (const char*)g.A + (size_t)cur.pm * tstep; const char* cB = (const char*)g.Bt + (size_t)cur.pn * tstep;
    S.a_ready(cur);
    if constexpr (SP2) {
        PG8_STAGE(PG8_SB(0, 0), cB, voffB); PG8_STAGE(PG8_SB(0, 1), cB + hstep, voffB); PG8_STAGE(PG8_SA(0, 0), cA, voffA); PG8_STAGE(PG8_SA(0, 1), cA + hstep, voffA);
        if (wr == 1) PG8_BAR;
        PG8_WAIT_V(2); PG8_BAR;
        PG8_STAGE(PG8_SB(1, 0), cB + kstep, voffB); PG8_STAGE(PG8_SA(1, 0), cA + kstep, voffA); PG8_STAGE(PG8_SB(1, 1), cB + hstep + kstep, voffB);
        PG8_WAIT_V(6); PG8_BAR;
    } else {
        PG8_STAGE(PG8_SB(0, 0), cB, voffB); PG8_STAGE(PG8_SA(0, 0), cA, voffA); PG8_STAGE(PG8_SB(0, 1), cB + hstep, voffB); PG8_STAGE(PG8_SA(0, 1), cA + hstep, voffA);
        if (wr == 1) PG8_BAR;
        PG8_WAIT_V(4); PG8_BAR;
        PG8_STAGE(PG8_SB(1, 0), cB + kstep, voffB); PG8_STAGE(PG8_SA(1, 0), cA + kstep, voffA); PG8_STAGE(PG8_SB(1, 1), cB + hstep + kstep, voffB);
        PG8_WAIT_V(6); PG8_BAR;
    }
    for (;;) {
        const bool has_next = S.next(ui + 1, nxt);
        const char* nA = has_next ? (const char*)g.A + (size_t)nxt.pm * tstep : cA; const char* nB = has_next ? (const char*)g.Bt + (size_t)nxt.pn * tstep : cB;
        for (int t = 0; t < nt; t += 2) {
            const bool last = (t == nt - 2);
            const char* a1 = cA + (size_t)(t + 1) * kstep;
            const char* a2 = last ? nA : cA + (size_t)(t + 2) * kstep; const char* b2 = last ? nB : cB + (size_t)(t + 2) * kstep;
            const char* a3 = a2 + kstep; const char* b3 = b2 + kstep;
            if (last && has_next) S.a_ready(nxt);
            if constexpr (SP2) {
            PG8_LDB(B0, 0, 0); PG8_LDB(B1, 0, 1); PG8_SCHED; PG8_LDA(At, 0, 0); PG8_STAGE(PG8_SA(1, 1), a1 + hstep, voffA);
            PG8_WAIT_V(8); PG8_WAIT_L(0); PG8_BAR; PG8_MMA(0, 0, At, B0); PG8_MMA(0, 1, At, B1); PG8_BAR; PG8_SCHED;
            PG8_LDA(At, 0, 1); PG8_STAGE(PG8_SB(0, 0), b2, voffB); PG8_STAGE(PG8_SB(0, 1), b2 + hstep, voffB); PG8_STAGE(PG8_SA(0, 0), a2, voffA);
            PG8_WAIT_V(8); PG8_WAIT_L(0); PG8_BAR; PG8_MMA(1, 0, At, B0); PG8_MMA(1, 1, At, B1); PG8_BAR; PG8_SCHED;
            PG8_LDB(B0, 1, 0); PG8_LDB(B1, 1, 1); PG8_SCHED; PG8_LDA(At, 1, 0); PG8_STAGE(PG8_SA(0, 1), a2 + hstep, voffA);
            PG8_WAIT_V(8); PG8_WAIT_L(0); PG8_BAR; PG8_MMA(0, 0, At, B0); PG8_MMA(0, 1, At, B1); PG8_BAR; PG8_SCHED;
            PG8_LDA(At, 1, 1); PG8_STAGE(PG8_SB(1, 0), b3, voffB); PG8_STAGE(PG8_SB(1, 1), b3 + hstep, voffB); PG8_STAGE(PG8_SA(1, 0), a3, voffA);
            PG8_WAIT_V(8); PG8_WAIT_L(0); PG8_BAR; PG8_MMA(1, 0, At, B0); PG8_MMA(1, 1, At, B1); PG8_BAR; PG8_SCHED;
            } else {
            PG8_LDB(B0, 0, 0); PG8_SCHED; PG8_LDA(At, 0, 0); PG8_STAGE(PG8_SA(1, 1), a1 + hstep, voffA);
            PG8_WAIT_L(8); PG8_BAR; PG8_WAIT_L(0); PG8_MMA(0, 0, At, B0); PG8_BAR; PG8_SCHED;
            PG8_LDB(B1, 0, 1); PG8_STAGE(PG8_SB(0, 0), b2, voffB);
            PG8_BAR; PG8_WAIT_L(0); PG8_MMA(0, 1, At, B1); PG8_BAR;
            PG8_LDA(At, 0, 1); PG8_STAGE(PG8_SA(0, 0), a2, voffA);
            PG8_BAR; PG8_WAIT_L(0); PG8_MMA(1, 0, At, B0); PG8_BAR; PG8_SCHED;
            PG8_STAGE(PG8_SB(0, 1), b2 + hstep, voffB);
            PG8_WAIT_V(6); PG8_BAR; PG8_MMA(1, 1, At, B1); PG8_BAR;
            PG8_LDB(B0, 1, 0); PG8_SCHED; PG8_LDA(At, 1, 0); PG8_STAGE(PG8_SA(0, 1), a2 + hstep, voffA);
            PG8_WAIT_L(8); PG8_BAR; PG8_WAIT_L(0); PG8_MMA(0, 0, At, B0); PG8_BAR; PG8_SCHED;
            PG8_LDB(B1, 1, 1); PG8_STAGE(PG8_SB(1, 0), b3, voffB);
            PG8_BAR; PG8_WAIT_L(0); PG8_MMA(0, 1, At, B1); PG8_BAR;
            PG8_LDA(At, 1, 1); PG8_STAGE(PG8_SA(1, 0), a3, voffA);
            PG8_BAR; PG8_WAIT_L(0); PG8_MMA(1, 0, At, B0); PG8_BAR; PG8_SCHED;
            PG8_STAGE(PG8_SB(1, 1), b3 + hstep, voffB);
            PG8_WAIT_V(6); PG8_BAR; PG8_MMA(1, 1, At, B1); PG8_BAR;
            }
        }
        if constexpr (ALIGN_EPI) { if (wr == 0) PG8_BAR; }
        if constexpr (!Epi::AFTER_DRAIN) { E(acc, cur, wr, wc, fr, fq); S.done(cur); }
        if (!has_next) break;
#pragma unroll
        for (int a = 0; a < 2; ++a)
#pragma unroll
            for (int b = 0; b < 2; ++b)
#pragma unroll
                for (int m = 0; m < 4; ++m)
#pragma unroll
                    for (int n = 0; n < 2; ++n) acc[a][b][m][n] = (f32x4){0.f, 0.f, 0.f, 0.f};
        cur = nxt; cA = nA; cB = nB; ++ui;
        if constexpr (ALIGN_EPI) { if (wr == 1) PG8_BAR; }
    }
    PG8_WAIT_V(0);
    if constexpr (!ALIGN_EPI) { if (wr == 0) PG8_BAR; }
    PG8_BAR;
    if constexpr (Epi::AFTER_DRAIN) { E.fused(acc, cur, wr, wc, fr, fq, lds, wid, lane); S.done(cur); }
#undef PG8_SA
#undef PG8_SB
#undef PG8_STAGE
#undef PG8_LDA
#undef PG8_LDB
#undef PG8_MMA
#undef PG8_WAIT_V
#undef PG8_WAIT_L
#undef PG8_BAR
#undef PG8_SCHED
}
}

constexpr int NWAVES = 8;
constexpr int LDS_BYTES = 135168;
constexpr int NB = 8, SEQ = 4096, T = NB * SEQ, D = 1024, INW = 9612, DEPTH = 2;
constexpr int A_Q = 0, A_K = 256, A_V = 512, A_G = 768, B_Q = 1024, B_KC = 1280, B_VC = 1344, B_KS = 1408, B_VS = 1472, B_KW = 1536, B_VW = 1600, B_G = 1664, B_NG = 1920,
              C_Q = 1932, C_K = 2188, C_V = 2444, C_G = 2700, D_Q = 2956, D_K = 3724, D_V = 4492, D_G = 5260, MRG = 5516;
constexpr size_t MiB = 1u << 20, KiB = 1024;
constexpr size_t WS_CTL = 0, WS_COS = 1 * MiB, WS_SIN = 1 * MiB + 512 * KiB, WS_KMEAN = 2 * MiB, WS_BIASP = 2 * MiB + 128 * KiB, WS_BIAS = 2 * MiB + 192 * KiB,
                 WS_KCMP = 2 * MiB + 512 * KiB, WS_VCMPT = 2 * MiB + 768 * KiB, WS_MMASK = 3 * MiB, WS_NMASK = 3 * MiB + 512 * KiB, WS_LSE = 4 * MiB,
                 WS_W1T = 6 * MiB, WS_W2T = 8 * MiB, WS_WQK = 9 * MiB, WS_WV = 15 * MiB, WS_WG = 18 * MiB, WS_WM = 20 * MiB, WS_WUP = 28 * MiB, WS_WOUT = 30 * MiB,
                 WS_H = 32 * MiB, WS_QK = 96 * MiB, WS_VT = 320 * MiB, WS_U = 320 * MiB, WS_Y = 224 * MiB, WS_END = 432 * MiB;
constexpr size_t SLOT_BYTES = 16 * MiB;
constexpr int SL_QA = 0, SL_QB = 1, SL_QC = 2, SL_QD0 = 3, SL_QBR = 4, SL_QD1 = 5, SL_QD2 = 6, SL_OWIN = 7, SL_KA = 8, SL_KB4 = 9, SL_KC = 10, SL_KD0 = 11, SL_OSLC = 20;
constexpr int NQK = 3072, NV = 1536;
constexpr int CTL_BYTES = 4096;

typedef unsigned short bf16_t;
typedef short bf16x8 __attribute__((ext_vector_type(8)));
typedef float f32x4 __attribute__((ext_vector_type(4)));
typedef float f32x2 __attribute__((ext_vector_type(2)));
typedef float f32x16 __attribute__((ext_vector_type(16)));
typedef unsigned u32x4 __attribute__((ext_vector_type(4)));
typedef unsigned u32x2 __attribute__((ext_vector_type(2)));
typedef __bf16 bf16v2 __attribute__((ext_vector_type(2)));
#define LAS __attribute__((address_space(3)))
#define GAS __attribute__((address_space(1)))
#define DI __device__ __forceinline__
#define MFMA32(a, b, c) __builtin_amdgcn_mfma_f32_32x32x16_bf16((a), (b), (c), 0, 0, 0)

constexpr float LOG2E = 1.4426950408889634f, LN2 = 0.6931471805599453f;
DI float sconst(float x) { asm volatile("" : "+s"(x)); return x; }
constexpr float SM_SCALE = 0.125f, SM_C = 0.125f * LOG2E, NEG_C = -1e30f, MFLOOR_C = -30000.f;
#define NEG sconst(NEG_C)
#define MFLOOR sconst(MFLOOR_C)

DI unsigned pk2(float lo, float hi) { const bf16v2 r = __builtin_convertvector((f32x2){lo, hi}, bf16v2); return __builtin_bit_cast(unsigned, r); }
DI float bf_lo(unsigned w) { return __uint_as_float(w << 16); }
DI float bf_hi(unsigned w) { return __uint_as_float(w & 0xffff0000u); }
DI float bf1(bf16_t x) { return __uint_as_float((unsigned)x << 16); }
DI float fexp2(float x) { return __builtin_amdgcn_exp2f(x); }
DI float flog2(float x) { return __builtin_amdgcn_logf(x); }
DI float frcp(float x) { return __builtin_amdgcn_rcpf(x); }
DI float sigmoidf_(float x) { return frcp(1.f + fexp2(-x * LOG2E)); }
DI float wave_sum(float v) {
#pragma unroll
    for (int o = 1; o < 64; o <<= 1) v += __shfl_xor(v, o);
    return v;
}
DI float xhalf(float v) { return __shfl_xor(v, 32); }
DI float hmaxf_(float v) { const auto r = __builtin_amdgcn_permlane32_swap(__float_as_uint(v), __float_as_uint(v), false, false); return fmaxf(__uint_as_float(r[0]), __uint_as_float(r[1])); }
DI float hsumf_(float v) { const auto r = __builtin_amdgcn_permlane32_swap(__float_as_uint(v), __float_as_uint(v), false, false); return __uint_as_float(r[0]) + __uint_as_float(r[1]); }
DI bf16_t* slot_ptr(unsigned char* ws, int s) { return (bf16_t*)(ws + WS_QK + (size_t)s * SLOT_BYTES); }
DI void load8(const bf16_t* p, float (&f)[8]) { const u32x4 w = *(const GAS u32x4*)p; f[0] = bf_lo(w.x); f[1] = bf_hi(w.x); f[2] = bf_lo(w.y); f[3] = bf_hi(w.y); f[4] = bf_lo(w.z); f[5] = bf_hi(w.z); f[6] = bf_lo(w.w); f[7] = bf_hi(w.w); }
DI void store8(bf16_t* p, const float (&f)[8]) { u32x4 w; w.x = pk2(f[0], f[1]); w.y = pk2(f[2], f[3]); w.z = pk2(f[4], f[5]); w.w = pk2(f[6], f[7]); *(GAS u32x4*)p = w; }
DI void store4(bf16_t* p, float a, float b, float c, float d) { u32x2 w; w.x = pk2(a, b); w.y = pk2(c, d); *(GAS u32x2*)p = w; }

struct Epi {
    static constexpr bool PERM = true, AFTER_DRAIN = false;
    int kind, first; unsigned char* ws; const float* xin; float* xout;
    typedef pg8::f32x4 a4;
    DI void operator()(const a4 (&acc)[2][2][4][2], const pg8::Unit& u, int wr, int wc, int fr, int fq) const {
        if (kind == 0) {
            const int tile = u.pn;
            const int slot = (int)((0xDCB653A29180ull >> (4 * tile)) & 15ull);
            bf16_t* dst = slot_ptr(ws, slot); bf16_t* dst2 = slot_ptr(ws, SL_QBR);
            const bool ropeall = (tile <= 1) || (tile >= 6);
            const int g = 4 * (wc & 1) + fq, d0 = 4 * g;
            const float* cosT = (const float*)(ws + WS_COS); const float* sinT = (const float*)(ws + WS_SIN);
#pragma unroll
            for (int ai = 0; ai < 2; ++ai)
#pragma unroll
                for (int m = 0; m < 4; ++m) {
                    const int tok = u.pm * 256 + ai * 128 + wr * 64 + m * 16 + fr, pos = tok & (SEQ - 1);
                    const f32x4 cs = *(const GAS f32x4*)(cosT + pos * 32 + d0), sn = *(const GAS f32x4*)(sinT + pos * 32 + d0);
#pragma unroll
                    for (int bj = 0; bj < 2; ++bj) {
                        const int hs = 2 * bj + (wc >> 1);
                        const a4 v0 = acc[ai][bj][m][0], v1 = acc[ai][bj][m][1];
                        const a4 r0 = v0 * cs - v1 * sn, r1 = v0 * sn + v1 * cs;
                        const size_t off = (size_t)tok * 256 + hs * 64 + d0;
                        const bool rope = ropeall || (tile == 3 && hs >= 2);
                        if (tile == 2) { store4(dst + off, v0[0], v0[1], v0[2], v0[3]); store4(dst + off + 32, v1[0], v1[1], v1[2], v1[3]);
                                         store4(dst2 + off, r0[0], r0[1], r0[2], r0[3]); store4(dst2 + off + 32, r1[0], r1[1], r1[2], r1[3]); }
                        else if (rope) { store4(dst + off, r0[0], r0[1], r0[2], r0[3]); store4(dst + off + 32, r1[0], r1[1], r1[2], r1[3]); }
                        else { store4(dst + off, v0[0], v0[1], v0[2], v0[3]); store4(dst + off + 32, v1[0], v1[1], v1[2], v1[3]); }
                    }
                    asm volatile("" ::: "memory");
                }
        } else if (kind == 1) {
            bf16_t* VT = (bf16_t*)(ws + WS_VT);
#pragma unroll
            for (int ai = 0; ai < 2; ++ai)
#pragma unroll
                for (int m = 0; m < 4; ++m) {
                    const int r = u.pm * 256 + ai * 128 + wr * 64 + m * 16 + fr;
                    bf16_t* rowp = VT + (size_t)r * T;
                    const bool gate = (r >= 1408 && r < 1420);
#pragma unroll
                    for (int bj = 0; bj < 2; ++bj) {
                        const int c0 = u.pn * 256 + bj * 128 + wc * 32 + 8 * fq;
                        const a4 v0 = acc[ai][bj][m][0], v1 = acc[ai][bj][m][1];
                        float v[8] = {v0[0], v0[1], v0[2], v0[3], v1[0], v1[1], v1[2], v1[3]};
                        if (gate) {
#pragma unroll
                            for (int j = 0; j < 8; ++j) v[j] = sigmoidf_(v[j]);
                        }
                        if (u.pm == 3) {
                            const int b = c0 >> 12, p0 = c0 & (SEQ - 1), mm0 = p0 >> 2;
                            bf16_t* q = rowp + b * SEQ + mm0;
#pragma unroll
                            for (int c = 0; c < 4; ++c) *(GAS unsigned*)(q + c * 1024) = pk2(v[c], v[c + 4]);
                        } else if (u.pm == 4) {
                            const int b = c0 >> 12, p0 = c0 & (SEQ - 1), mm = p0 >> 4, cc0 = p0 & 15;
                            bf16_t* q = rowp + b * SEQ + cc0 * 256 + mm;
#pragma unroll
                            for (int j = 0; j < 8; ++j) ((GAS bf16_t*)q)[j * 256] = (bf16_t)(pk2(v[j], 0.f) & 0xffffu);
                        } else store8(rowp + c0, v);
                    }
                    asm volatile("" ::: "memory");
                }
        } else if (kind == 2) {
            const int br = u.pn;
            const bf16_t* VT = (const bf16_t*)(ws + WS_VT);
            const float* LSE = (const float*)(ws + WS_LSE);
#pragma unroll
            for (int ai = 0; ai < 2; ++ai)
#pragma unroll
                for (int m = 0; m < 4; ++m) {
                    const int tok = u.pm * 256 + ai * 128 + wr * 64 + m * 16 + fr;
#pragma unroll
                    for (int bj = 0; bj < 2; ++bj) {
                        const int cb = bj * 128 + wc * 32 + 8 * fq, head = cb >> 6;
                        const a4 v0 = acc[ai][bj][m][0], v1 = acc[ai][bj][m][1];
                        float gt[8] = {v0[0], v0[1], v0[2], v0[3], v1[0], v1[1], v1[2], v1[3]};
                        const size_t off = (size_t)tok * 256 + cb;
                        float o[8];
                        bf16_t* dst;
                        if (br == 0) { dst = slot_ptr(ws, SL_QA) + off; load8(dst, o); }
                        else if (br == 2) { dst = slot_ptr(ws, SL_QC) + off; load8(dst, o); }
                        else if (br == 1) {
                            dst = slot_ptr(ws, SL_QB) + off;
                            float oc[8], os[8], ow[8]; load8(dst, oc); load8(slot_ptr(ws, SL_OSLC) + off, os); load8(slot_ptr(ws, SL_OWIN) + off, ow);
                            const GAS bf16_t* VTg = (const GAS bf16_t*)VT; const float g0 = bf1(VTg[(size_t)(1408 + head) * T + tok]), g1 = bf1(VTg[(size_t)(1412 + head) * T + tok]), g2 = bf1(VTg[(size_t)(1416 + head) * T + tok]);
#pragma unroll
                            for (int j = 0; j < 8; ++j) o[j] = g0 * oc[j] + g1 * os[j] + g2 * ow[j];
                        } else {
                            dst = slot_ptr(ws, SL_QD0) + off;
                            float o0[8], o1[8], o2[8]; load8(dst, o0); load8(slot_ptr(ws, SL_QD1) + off, o1); load8(slot_ptr(ws, SL_QD2) + off, o2);
                            const GAS float* LSEg = (const GAS float*)LSE; const float l0 = LSEg[((size_t)0 * T + tok) * 4 + head], l1 = LSEg[((size_t)1 * T + tok) * 4 + head], l2 = LSEg[((size_t)2 * T + tok) * 4 + head];
                            const float mx = fmaxf(l0, fmaxf(l1, l2));
                            const float e0 = fexp2((l0 - mx) * LOG2E), e1 = fexp2((l1 - mx) * LOG2E), e2 = fexp2((l2 - mx) * LOG2E);
                            const float inv = frcp(e0 + e1 + e2);
#pragma unroll
                            for (int j = 0; j < 8; ++j) o[j] = (e0 * o0[j] + e1 * o1[j] + e2 * o2[j]) * inv;
                        }
#pragma unroll
                        for (int j = 0; j < 8; ++j) o[j] *= gt[j] * sigmoidf_(gt[j]);
                        store8(dst, o);
                        asm volatile("" ::: "memory");
                    }
                }
        } else {
            bf16_t* U = (bf16_t*)(ws + WS_U); bf16_t* Y = (bf16_t*)(ws + WS_Y);
#pragma unroll
            for (int ai = 0; ai < 2; ++ai)
#pragma unroll
                for (int m = 0; m < 4; ++m) {
                    const int tok = u.pm * 256 + ai * 128 + wr * 64 + m * 16 + fr;
#pragma unroll
                    for (int bj = 0; bj < 2; ++bj) {
                        const int col = u.pn * 256 + bj * 128 + wc * 32 + 8 * fq;
                        const a4 v0 = acc[ai][bj][m][0], v1 = acc[ai][bj][m][1];
                        float v[8] = {v0[0], v0[1], v0[2], v0[3], v1[0], v1[1], v1[2], v1[3]};
                        const size_t off = (size_t)tok * D + col;
                        if (kind == 3) store8(U + off, v);
                        else if (kind == 4) {
                            float uu[8]; load8(U + off, uu);
                            float y[8];
                            if (first) {
#pragma unroll
                                for (int j = 0; j < 8; ++j) y[j] = sigmoidf_(v[j]) * uu[j];
                            } else {
                                load8(Y + off, y);
#pragma unroll
                                for (int j = 0; j < 8; ++j) y[j] += sigmoidf_(v[j]) * uu[j];
                            }
                            store8(Y + off, y);
                        } else {
                            const f32x4 x0 = *(const GAS f32x4*)(xin + off), x1 = *(const GAS f32x4*)(xin + off + 4);
                            *(GAS f32x4*)(xout + off) = (f32x4){x0[0] + v[0], x0[1] + v[1], x0[2] + v[2], x0[3] + v[3]};
                            *(GAS f32x4*)(xout + off + 4) = (f32x4){x1[0] + v[4], x1[1] + v[5], x1[2] + v[6], x1[3] + v[7]};
                        }
                        asm volatile("" ::: "memory");
                    }
                }
        }
    }
};

DI void transpose_item(const float* W, int K, int N, bf16_t* WT, int k0, int n0, int sc, LAS float* scr, int lane) {
    const int sc4 = __shfl(sc, 4 * (lane & 7));
#pragma unroll
    for (int i = 0; i < 8; ++i) {
        const int kk = 8 * i + (lane >> 3);
        const f32x4 w = sc4 >= 0 ? *(const GAS f32x4*)(W + (size_t)(k0 + kk) * N + sc4) : (f32x4){0.f, 0.f, 0.f, 0.f};
        LAS float* d = scr + kk * 33 + 4 * (lane & 7);
        d[0] = w.x; d[1] = w.y; d[2] = w.z; d[3] = w.w;
    }
    asm volatile("s_waitcnt lgkmcnt(0)" ::: "memory");
    const int c = lane & 7;
#pragma unroll
    for (int j = 0; j < 4; ++j) { const int n = (lane >> 3) + 8 * j; const LAS float* s = scr + (8 * c) * 33 + n;
        u32x4 o; o.x = pk2(s[0 * 33], s[1 * 33]); o.y = pk2(s[2 * 33], s[3 * 33]); o.z = pk2(s[4 * 33], s[5 * 33]); o.w = pk2(s[6 * 33], s[7 * 33]);
        *(GAS u32x4*)(WT + (size_t)(n0 + n) * K + k0 + 8 * c) = o; }
    asm volatile("s_waitcnt lgkmcnt(0)" ::: "memory");
}
DI int src_qk(int n) {
    const int tile = n >> 8, hs = (n >> 6) & 3, g = (n >> 3) & 7, e = n & 7, d = 4 * g + (e & 3) + 32 * (e >> 2);
    int base;
    switch (tile) {
        case 0: base = A_Q + 64 * hs; break; case 1: base = A_K + 64 * hs; break; case 2: base = B_Q + 64 * hs; break;
        case 3: base = hs == 0 ? B_KC : hs == 1 ? B_VC : hs == 2 ? B_KS : B_KW; break;
        case 4: base = C_Q + 64 * hs; break; case 5: base = C_K + 64 * hs; break;
        case 6: case 7: case 8: base = D_Q + 256 * (tile - 6) + 64 * hs; break;
        default: base = D_K + 256 * (tile - 9) + 64 * hs; break;
    }
    return base + d;
}
DI int src_v(int n) {
    const int slot = n >> 6, d = n & 63;
    if (slot < 4) return A_V + 64 * slot + d;
    if (slot < 8) return C_V + 64 * (slot - 4) + d;
    if (slot < 20) return D_V + 64 * (slot - 8) + d;
    if (slot == 20) return B_VS + d;
    if (slot == 21) return B_VW + d;
    if (slot == 22 && d < 12) return B_NG + d;
    return -1;
}
DI int src_g(int n) { const int br = n >> 8, c = n & 255; return (br == 0 ? A_G : br == 1 ? B_G : br == 2 ? C_G : D_G) + c; }

DI const bf16_t* launder_vp(const bf16_t* p) { asm volatile("" : "+v"(p)); return p; }
DI int kappa(int rho) { return (rho & 16) | ((rho & 4) << 1) | ((rho & 8) >> 1) | (rho & 3); }
DI bf16x8 ldfrag(const bf16_t* p) { return *(const GAS bf16x8*)p; }
DI bf16x8 pack8(const float* p) { u32x4 w; w.x = pk2(p[0], p[1]); w.y = pk2(p[2], p[3]); w.z = pk2(p[4], p[5]); w.w = pk2(p[6], p[7]); return __builtin_bit_cast(bf16x8, w); }

#define BLK_BAR() do { asm volatile("s_waitcnt lgkmcnt(0)" ::: "memory"); __builtin_amdgcn_s_barrier(); asm volatile("" ::: "memory"); } while (0)
struct SmState { f32x16 O[2]; float m, l; };
DI void sm_init(SmState& st) {
#pragma unroll
    for (int i = 0; i < 16; ++i) { st.O[0][i] = 0.f; st.O[1][i] = 0.f; }
    st.m = MFLOOR; st.l = 0.f;
}
struct Frag { bf16x8 k[4], v[2][2]; };
DI void ld_frag(Frag& f, const bf16_t* kp, const bf16_t* v0p, const bf16_t* v1p) {
#pragma unroll
    for (int s = 0; s < 4; ++s) f.k[s] = ldfrag(kp + 16 * s);
#pragma unroll
    for (int s = 0; s < 2; ++s) { f.v[0][s] = ldfrag(v0p + 16 * s); f.v[1][s] = ldfrag(v1p + 16 * s); }
}
struct FragG { u32x4 k[4], v[4]; };
constexpr int WLDS_BYTES = 4608 + 5120;
DI void ldg(FragG& g, const bf16_t* kq, size_t kstride, const bf16_t* vq, size_t vstride) {
#pragma unroll
    for (int j = 0; j < 4; ++j) g.k[j] = *(const GAS u32x4*)(kq + (size_t)(8 * j) * kstride);
#pragma unroll
    for (int j = 0; j < 4; ++j) g.v[j] = *(const GAS u32x4*)(vq + (size_t)(16 * j) * vstride);
}
DI void stage(const FragG& g, Frag& f, LAS unsigned char* wl, int lane) {
    const int r = lane & 31, h = lane >> 5;
    LAS u32x4* kw = (LAS u32x4*)(wl + (lane >> 3) * 144 + (lane & 7) * 16);
    LAS u32x4* vw = (LAS u32x4*)(wl + 4608 + (lane >> 2) * 80 + (lane & 3) * 16);
#pragma unroll
    for (int j = 0; j < 4; ++j) kw[j * 72] = g.k[j];
#pragma unroll
    for (int j = 0; j < 4; ++j) vw[j * 80] = g.v[j];
    asm volatile("" ::: "memory");
    const LAS unsigned char* kr = wl + kappa(r) * 144 + 16 * h;
    const LAS unsigned char* vr = wl + 4608 + r * 80 + 16 * h;
#pragma unroll
    for (int s = 0; s < 4; ++s) f.k[s] = *(const LAS bf16x8*)(kr + 32 * s);
#pragma unroll
    for (int s = 0; s < 2; ++s) { f.v[0][s] = *(const LAS bf16x8*)(vr + 32 * s); f.v[1][s] = *(const LAS bf16x8*)(vr + 32 * 80 + 32 * s); }
    asm volatile("" ::: "memory");
}
template <int MASK>
DI void sm_compute(SmState& st, const bf16x8 (&qf)[4], const Frag& f, int key0, bool allow, int klo, int khi) {
    f32x16 S;
#pragma unroll
    for (int i = 0; i < 16; ++i) S[i] = 0.f;
#pragma unroll
    for (int s = 0; s < 4; ++s) S = MFMA32(f.k[s], qf[s], S);
    const float neg = NEG, mfl = MFLOOR;
    float p[16]; float mx = mfl;
#pragma unroll
    for (int i = 0; i < 16; ++i) {
        float v = S[i];
        if (MASK == 2) { const int key = key0 + 16 * (i >> 3) + (i & 7); v = (allow && key >= klo && key <= khi) ? v : neg; }
        p[i] = v; mx = fmaxf(mx, v);
    }
    if (MASK == 1) mx = allow ? mx : mfl;
    mx = hmaxf_(mx);
    const float mn = fmaxf(st.m, mx), mc = mn * SM_C;
    const float mcl = (MASK == 1 && !allow) ? sconst(INFINITY) : mc;
    const f32x2 c2 = {SM_C, SM_C}, m2 = {mcl, mcl};
    f32x2 rs2 = {0.f, 0.f};
#pragma unroll
    for (int k = 0; k < 8; ++k) {
        const f32x2 x = (f32x2){p[2 * k], p[2 * k + 1]} * c2 - m2;
        const f32x2 e = {fexp2(x.x), fexp2(x.y)};
        p[2 * k] = e.x; p[2 * k + 1] = e.y; rs2 += e;
    }
    const float rs = rs2.x + rs2.y;
    if (__ballot(mn != st.m) != 0ull) {
        const float alpha = fexp2((st.m - mn) * SM_C);
        st.l *= alpha;
#pragma unroll
        for (int i = 0; i < 16; ++i) { st.O[0][i] *= alpha; st.O[1][i] *= alpha; }
    }
    st.l += rs; st.m = mn;
    const bf16x8 pf0 = pack8(p), pf1 = pack8(p + 8);
    st.O[0] = MFMA32(f.v[0][0], pf0, st.O[0]); st.O[0] = MFMA32(f.v[0][1], pf1, st.O[0]);
    st.O[1] = MFMA32(f.v[1][0], pf0, st.O[1]); st.O[1] = MFMA32(f.v[1][1], pf1, st.O[1]);
}
DI void write_o(bf16_t* orow, const f32x16 (&O)[2], float inv, int h) {
#pragma unroll
    for (int dt = 0; dt < 2; ++dt)
#pragma unroll
        for (int g = 0; g < 4; ++g) store4(orow + 32 * dt + 8 * g + 4 * h, O[dt][4 * g] * inv, O[dt][4 * g + 1] * inv, O[dt][4 * g + 2] * inv, O[dt][4 * g + 3] * inv);
}
DI void load_q(bf16x8 (&qf)[4], const bf16_t* qrow, int h) {
#pragma unroll
    for (int s = 0; s < 4; ++s) qf[s] = ldfrag(qrow + 16 * s + 8 * h);
}

struct SmTask { const bf16_t* qrow; const bf16_t* kb; const bf16_t* vb0; bf16_t* orow; float* lse; size_t kstride; int ti_lo, ti_hi, ti_edge, bshift, klo, khi; unsigned long long need, full, allow; };
DI int sm_next(int ti, int ti_hi, int bshift, unsigned long long need) {
    int nt = ti + 1;
    while (nt <= ti_hi) { if ((need >> (nt >> bshift)) & 1ull) return nt; nt = ((nt >> bshift) + 1) << bshift; }
    return -1;
}
DI void sm_step(SmState& st, const bf16x8 (&qf)[4], const Frag& f, const SmTask& tk, int ti, int h) {
    const int blk = ti >> tk.bshift;
    const bool allow = (tk.allow >> blk) & 1ull;
    if ((ti == tk.ti_hi) || (ti == tk.ti_edge)) sm_compute<2>(st, qf, f, 32 * ti + 8 * h, allow, tk.klo, tk.khi);
    else if (!((tk.full >> blk) & 1ull)) sm_compute<1>(st, qf, f, 32 * ti + 8 * h, allow, 0, 0);
    else sm_compute<0>(st, qf, f, 32 * ti + 8 * h, true, 0, 0);
}
DI void run_sm(const SmTask& tk, int lane, LAS unsigned char* wl) {
    const int h = lane >> 5;
    bf16x8 qf[4]; load_q(qf, tk.qrow, h);
    SmState st; sm_init(st);
    int ti = sm_next(tk.ti_lo - 1, tk.ti_hi, tk.bshift, tk.need);
    FragG GA, GB; Frag F;
    ldg(GA, tk.kb + (size_t)(32 * ti) * tk.kstride, tk.kstride, tk.vb0 + 32 * ti, T);
    for (;;) {
        int nt = sm_next(ti, tk.ti_hi, tk.bshift, tk.need); int lt = nt >= 0 ? nt : ti;
        ldg(GB, tk.kb + (size_t)(32 * lt) * tk.kstride, tk.kstride, tk.vb0 + 32 * lt, T);
        __builtin_amdgcn_sched_barrier(0);
        stage(GA, F, wl, lane);
        sm_step(st, qf, F, tk, ti, h);
        if (nt < 0) break;
        ti = nt;
        nt = sm_next(ti, tk.ti_hi, tk.bshift, tk.need); lt = nt >= 0 ? nt : ti;
        ldg(GA, tk.kb + (size_t)(32 * lt) * tk.kstride, tk.kstride, tk.vb0 + 32 * lt, T);
        __builtin_amdgcn_sched_barrier(0);
        stage(GB, F, wl, lane);
        sm_step(st, qf, F, tk, ti, h);
        if (nt < 0) break;
        ti = nt;
    }
    const float lt_ = hsumf_(st.l);
    write_o(tk.orow, st.O, frcp(lt_), h);
    if (tk.lse != nullptr && h == 0) *(GAS float*)tk.lse = st.m * SM_SCALE + flog2(lt_) * LN2;
}
DI unsigned long long bits_any(unsigned long long m, int n) {
    unsigned long long r = 0ull;
    for (int j = 0; j < n; ++j) if (__ballot((m >> j) & 1ull) != 0ull) r |= 1ull << j;
    return r;
}
DI unsigned long long bits_all(unsigned long long m, int n) {
    unsigned long long r = 0ull;
    for (int j = 0; j < n; ++j) if (__ballot((m >> j) & 1ull) == ~0ull) r |= 1ull << j;
    return r;
}
DI void task_sm(unsigned char* ws, int kind, int b, int hh, int qt, int lane, LAS unsigned char* wl) {
    const int r = lane & 31, kr = lane >> 3, kc = 8 * (lane & 7), vd = lane >> 2, vc = 8 * (lane & 3);
    const bf16_t* VT = (const bf16_t*)(ws + WS_VT);
    SmTask tk;
    tk.lse = nullptr; tk.kstride = 256; tk.ti_edge = -1; tk.klo = -1; tk.ti_lo = 0;
    if (kind <= 2) {
        const int t0 = 32 * qt, t = t0 + r; const size_t row = (size_t)(b * SEQ + t) * 256 + hh * 64;
        tk.ti_hi = qt; tk.khi = t;
        if (kind == 0) {
            const int cb = t0 >> 8;
            const unsigned long long mask = ((const GAS unsigned*)(ws + WS_MMASK))[(b * 4 + hh) * SEQ + t];
            tk.qrow = slot_ptr(ws, SL_QA) + row; tk.orow = slot_ptr(ws, SL_QA) + row;
            tk.kb = slot_ptr(ws, SL_KA) + (size_t)(b * SEQ + kr) * 256 + hh * 64 + kc;
            tk.vb0 = VT + (size_t)(hh * 64 + vd) * T + b * SEQ + vc;
            tk.bshift = 3; tk.allow = mask; tk.need = bits_any(mask, cb + 1); tk.full = bits_all(mask, cb + 1);
        } else if (kind == 1) {
            const int cur = t0 >> 6;
            const unsigned long long mask = ((const GAS unsigned long long*)(ws + WS_NMASK))[b * SEQ + t];
            tk.qrow = slot_ptr(ws, SL_QBR) + row; tk.orow = slot_ptr(ws, SL_OSLC) + row;
            tk.kb = slot_ptr(ws, SL_KB4) + (size_t)(b * SEQ + kr) * 256 + 128 + kc;
            tk.vb0 = VT + (size_t)(1280 + vd) * T + b * SEQ + vc;
            tk.bshift = 1; tk.allow = mask; tk.need = bits_any(mask, cur + 1); tk.full = bits_all(mask, cur + 1);
        } else {
            tk.qrow = slot_ptr(ws, SL_QBR) + row; tk.orow = slot_ptr(ws, SL_OWIN) + row;
            tk.kb = slot_ptr(ws, SL_KB4) + (size_t)(b * SEQ + kr) * 256 + 192 + kc;
            tk.vb0 = VT + (size_t)(1344 + vd) * T + b * SEQ + vc;
            tk.bshift = 8; tk.allow = 1ull; tk.need = 1ull; tk.full = 1ull;
            tk.ti_lo = qt - 16 < 0 ? 0 : qt - 16; tk.ti_edge = qt - 16; tk.klo = t - 511;
        }
    } else {
        const int g = kind - 3, dil = g == 0 ? 1 : g == 1 ? 4 : 16, L = SEQ / dil, nsub = 128 / dil, c = qt / nsub, sq = qt - c * nsub;
        const int mq = 32 * sq + r, tok = b * SEQ + mq * dil + c;
        bf16_t* qr = slot_ptr(ws, g == 0 ? SL_QD0 : g == 1 ? SL_QD1 : SL_QD2) + (size_t)tok * 256 + hh * 64;
        tk.qrow = qr; tk.orow = qr; tk.kstride = (size_t)256 * dil;
        tk.kb = slot_ptr(ws, SL_KD0 + g) + (size_t)(b * SEQ + c) * 256 + (size_t)kr * tk.kstride + hh * 64 + kc;
        tk.vb0 = VT + (size_t)(512 + 256 * g + hh * 64 + vd) * T + b * SEQ + (g == 0 ? 0 : c * L) + vc;
        tk.lse = (float*)(ws + WS_LSE) + ((size_t)g * T + tok) * 4 + hh;
        tk.bshift = 8; tk.allow = 1ull; tk.need = 1ull; tk.full = 1ull;
        tk.ti_hi = sq; tk.ti_lo = sq - 4 < 0 ? 0 : sq - 4; tk.ti_edge = sq - 4; tk.klo = mq - 128; tk.khi = mq;
    }
    run_sm(tk, lane, wl);
}

DI void frag_from_image(Frag& f, const LAS unsigned char* img, int lane) {
    const int r = lane & 31, h = lane >> 5;
    const LAS unsigned char* kr = img + kappa(r) * 144 + 16 * h;
    const LAS unsigned char* vr = img + 4608 + r * 80 + 16 * h;
#pragma unroll
    for (int s = 0; s < 4; ++s) f.k[s] = *(const LAS bf16x8*)(kr + 32 * s);
#pragma unroll
    for (int s = 0; s < 2; ++s) { f.v[0][s] = *(const LAS bf16x8*)(vr + 32 * s); f.v[1][s] = *(const LAS bf16x8*)(vr + 32 * 80 + 32 * s); }
}
DI void run_heavy_group(unsigned char* ws, int kind, int b, int hh, int qg, int wave, int lane, int tid, LAS unsigned char* img) {
    const int r = lane & 31, h = lane >> 5, qt = 8 * qg + wave, t0 = 32 * qt, t = t0 + r, tmax = 8 * qg + 7;
    const size_t row = (size_t)(b * SEQ + t) * 256 + hh * 64;
    SmTask tk; tk.lse = nullptr; tk.kstride = 256; tk.ti_edge = -1; tk.klo = -1; tk.ti_lo = 0; tk.ti_hi = qt; tk.khi = t; tk.kb = nullptr; tk.vb0 = nullptr;
    const bf16_t* gp; size_t gstep; int woff;
    if (kind == 0) {
        const int cb = t0 >> 8;
        const unsigned long long mask = ((const GAS unsigned*)(ws + WS_MMASK))[(b * 4 + hh) * SEQ + t];
        tk.qrow = slot_ptr(ws, SL_QA) + row; tk.orow = slot_ptr(ws, SL_QA) + row;
        tk.bshift = 3; tk.allow = mask; tk.need = bits_any(mask, cb + 1); tk.full = bits_all(mask, cb + 1);
        if (tid < 256) { gp = slot_ptr(ws, SL_KA) + (size_t)(b * SEQ + (tid >> 3)) * 256 + hh * 64 + 8 * (tid & 7); gstep = (size_t)32 * 256; woff = (tid >> 3) * 144 + (tid & 7) * 16; }
        else { const int t2 = tid - 256; gp = (const bf16_t*)(ws + WS_VT) + (size_t)(hh * 64 + (t2 >> 2)) * T + b * SEQ + 8 * (t2 & 3); gstep = 32; woff = 4608 + (t2 >> 2) * 80 + (t2 & 3) * 16; }
    } else {
        const int cur = t0 >> 6;
        const unsigned long long mask = ((const GAS unsigned long long*)(ws + WS_NMASK))[b * SEQ + t];
        tk.qrow = slot_ptr(ws, SL_QBR) + row; tk.orow = slot_ptr(ws, SL_OSLC) + row;
        tk.bshift = 1; tk.allow = mask; tk.need = bits_any(mask, cur + 1); tk.full = bits_all(mask, cur + 1);
        if (tid < 256) { gp = slot_ptr(ws, SL_KB4) + (size_t)(b * SEQ + (tid >> 3)) * 256 + 128 + 8 * (tid & 7); gstep = (size_t)32 * 256; woff = (tid >> 3) * 144 + (tid & 7) * 16; }
        else { const int t2 = tid - 256; gp = (const bf16_t*)(ws + WS_VT) + (size_t)(1280 + (t2 >> 2)) * T + b * SEQ + 8 * (t2 & 3); gstep = 32; woff = 4608 + (t2 >> 2) * 80 + (t2 & 3) * 16; }
    }
    bf16x8 qf[4]; load_q(qf, tk.qrow, h);
    SmState st; sm_init(st);
    LAS unsigned char* img0 = img; LAS unsigned char* img1 = img + WLDS_BYTES;
    u32x4 r0 = *(const GAS u32x4*)gp;
    u32x4 r1 = *(const GAS u32x4*)(gp + gstep * (size_t)(tmax < 1 ? tmax : 1));
    *(LAS u32x4*)(img0 + woff) = r0;
    r0 = *(const GAS u32x4*)(gp + gstep * (size_t)(tmax < 2 ? tmax : 2));
    BLK_BAR();
    Frag F;
    int ti = 0;
    for (;;) {
        if (ti <= qt && ((tk.need >> (ti >> tk.bshift)) & 1ull)) { frag_from_image(F, img0, lane); sm_step(st, qf, F, tk, ti, h); }
        if (ti == tmax) break;
        *(LAS u32x4*)(img1 + woff) = r1;
        r1 = *(const GAS u32x4*)(gp + gstep * (size_t)(ti + 3 > tmax ? tmax : ti + 3));
        BLK_BAR(); ++ti;
        if (ti <= qt && ((tk.need >> (ti >> tk.bshift)) & 1ull)) { frag_from_image(F, img1, lane); sm_step(st, qf, F, tk, ti, h); }
        if (ti == tmax) break;
        *(LAS u32x4*)(img0 + woff) = r0;
        r0 = *(const GAS u32x4*)(gp + gstep * (size_t)(ti + 3 > tmax ? tmax : ti + 3));
        BLK_BAR(); ++ti;
    }
    const float lt_ = hsumf_(st.l);
    write_o(tk.orow, st.O, frcp(lt_), h);
}

DI void stick_compute(f32x16 (&O)[2], float& carry, const bf16x8 (&qf)[4], const Frag& f, int kt0, int t, int h) {
    f32x16 S;
#pragma unroll
    for (int i = 0; i < 16; ++i) S[i] = 0.f;
#pragma unroll
    for (int s = 0; s < 4; ++s) S = MFMA32(f.k[s], qf[s], S);
    float lsm[16], ls[16]; float sA = 0.f, sB = 0.f;
    const int key0 = kt0 + 8 * h; const float neg = NEG;
#pragma unroll
    for (int i = 0; i < 16; ++i) {
        const int key = key0 + 16 * (i >> 3) + (i & 7);
        const bool valid = key < t;
        const float z = S[i] * SM_SCALE;
        const float sp = fmaxf(z, 0.f) + flog2(1.f + fexp2(-fabsf(z) * LOG2E)) * LN2;
        lsm[i] = valid ? -sp : 0.f;
        ls[i] = valid ? z - sp : neg;
        if (i < 8) sA += lsm[i]; else sB += lsm[i];
    }
    const float pA = xhalf(sA), pB = xhalf(sB);
    const float baseB = carry + (h == 0 ? pB : 0.f), baseA = carry + sB + pB + (h == 0 ? pA : 0.f);
    float p[16]; float run = baseA;
#pragma unroll
    for (int e = 7; e >= 0; --e) { p[e] = fexp2((ls[e] + run) * LOG2E); run += lsm[e]; }
    run = baseB;
#pragma unroll
    for (int e = 15; e >= 8; --e) { p[e] = fexp2((ls[e] + run) * LOG2E); run += lsm[e]; }
    carry += (sA + sB) + (pA + pB);
    const bf16x8 pf0 = pack8(p), pf1 = pack8(p + 8);
    O[0] = MFMA32(f.v[0][0], pf0, O[0]); O[0] = MFMA32(f.v[0][1], pf1, O[0]);
    O[1] = MFMA32(f.v[1][0], pf0, O[1]); O[1] = MFMA32(f.v[1][1], pf1, O[1]);
}
DI void task_stick(unsigned char* ws, int b, int hh, int qt, int lane, LAS unsigned char* wl) {
    const int r = lane & 31, h = lane >> 5, t0 = 32 * qt, t = t0 + r;
    bf16_t* qrow = slot_ptr(ws, SL_QC) + (size_t)(b * SEQ + t) * 256 + hh * 64;
    bf16x8 qf[4]; load_q(qf, qrow, h);
    const bf16_t* kb = slot_ptr(ws, SL_KC) + (size_t)(b * SEQ + (lane >> 3)) * 256 + hh * 64 + 8 * (lane & 7);
    const bf16_t* vb0 = (const bf16_t*)(ws + WS_VT) + (size_t)(256 + hh * 64 + (lane >> 2)) * T + b * SEQ + 8 * (lane & 3);
    f32x16 O[2];
#pragma unroll
    for (int i = 0; i < 16; ++i) { O[0][i] = 0.f; O[1][i] = 0.f; }
    float carry = 0.f;
    int kt0 = t0;
    FragG GA, GB; Frag F;
    ldg(GA, kb + (size_t)kt0 * 256, 256, vb0 + kt0, T);
    for (;;) {
        int nk = kt0 - 32, lk = nk >= 0 ? nk : kt0;
        ldg(GB, kb + (size_t)lk * 256, 256, vb0 + lk, T);
        __builtin_amdgcn_sched_barrier(0);
        stage(GA, F, wl, lane);
        stick_compute(O, carry, qf, F, kt0, t, h);
        if (nk < 0 || __ballot(carry > -104.f) == 0ull) break;
        kt0 = nk; nk = kt0 - 32; lk = nk >= 0 ? nk : kt0;
        ldg(GA, kb + (size_t)lk * 256, 256, vb0 + lk, T);
        __builtin_amdgcn_sched_barrier(0);
        stage(GB, F, wl, lane);
        stick_compute(O, carry, qf, F, kt0, t, h);
        if (nk < 0 || __ballot(carry > -104.f) == 0ull) break;
        kt0 = nk;
    }
    write_o(qrow, O, 1.f, h);
}

DI void task_cmp(unsigned char* ws, int b, int qt, int lane, LAS float* imp, int hh0, int nh, bool leader) {
    const int r = lane & 31, h = lane >> 5, t0 = 32 * qt, t = t0 + r, cur = t0 >> 6;
    const int nvis = t >= 31 ? ((t - 31) >> 4) + 1 : 0;
    const int nvmax = (t0 >> 4) + 1, ntile = (nvmax + 31) >> 5;
    const bool need_imp = cur >= 16;
    if (leader) { for (int i = lane; i < 32 * 65; i += 64) imp[i] = 0.f; }
    BLK_BAR();
    const bf16_t* kb_ = (const bf16_t*)(ws + WS_KCMP) + (size_t)(b * 256 + kappa(r)) * 64 + 8 * h;
    const bf16_t* vb0_ = (const bf16_t*)(ws + WS_VCMPT) + (size_t)(b * 64 + r) * 256 + 8 * h;
    for (int hh = hh0; hh < hh0 + nh; ++hh) {
        const bf16_t* kb = launder_vp(kb_); const bf16_t* vb0 = launder_vp(vb0_); const bf16_t* vb1 = vb0 + 32 * 256;
        bf16_t* qrow = slot_ptr(ws, SL_QB) + (size_t)(b * SEQ + t) * 256 + hh * 64;
        bf16x8 qf[4]; load_q(qf, qrow, h);
        float m = MFLOOR, l = 0.f;
        bf16x8 kn[4];
#pragma unroll
        for (int s = 0; s < 4; ++s) kn[s] = ldfrag(kb + 16 * s);
        for (int tl = 0; tl < ntile; ++tl) {
            bf16x8 kf[4];
#pragma unroll
            for (int s = 0; s < 4; ++s) kf[s] = kn[s];
            const int nl = tl + 1 < ntile ? tl + 1 : tl;
#pragma unroll
            for (int s = 0; s < 4; ++s) kn[s] = ldfrag(kb + (size_t)(32 * nl) * 64 + 16 * s);
            f32x16 S;
#pragma unroll
            for (int i = 0; i < 16; ++i) S[i] = 0.f;
#pragma unroll
            for (int s = 0; s < 4; ++s) S = MFMA32(kf[s], qf[s], S);
            const float neg = NEG; float mx = MFLOOR;
#pragma unroll
            for (int i = 0; i < 16; ++i) { const int key = 32 * tl + 8 * h + 16 * (i >> 3) + (i & 7); const float v = key < nvis ? S[i] : neg; S[i] = v; mx = fmaxf(mx, v); }
            mx = hmaxf_(mx);
            const float mn = fmaxf(m, mx), mc = mn * SM_C;
            float rs = 0.f;
#pragma unroll
            for (int i = 0; i < 16; ++i) rs += fexp2(S[i] * SM_C - mc);
            l = l * fexp2((m - mn) * SM_C) + rs; m = mn;
        }
        const float lt = hsumf_(l);
        const float inv = nvis > 0 ? frcp(lt) : 0.f, mc = m * SM_C;
        f32x16 O[2];
#pragma unroll
        for (int i = 0; i < 16; ++i) { O[0][i] = 0.f; O[1][i] = 0.f; }
        Frag fn; ld_frag(fn, kb, vb0, vb1);
        for (int tl = 0; tl < ntile; ++tl) {
            bf16x8 kf[4], vf[2][2];
#pragma unroll
            for (int s = 0; s < 4; ++s) kf[s] = fn.k[s];
#pragma unroll
            for (int s = 0; s < 2; ++s) { vf[0][s] = fn.v[0][s]; vf[1][s] = fn.v[1][s]; }
            const int nl = tl + 1 < ntile ? tl + 1 : tl;
            ld_frag(fn, kb + (size_t)(32 * nl) * 64, vb0 + 32 * nl, vb1 + 32 * nl);
            f32x16 S;
#pragma unroll
            for (int i = 0; i < 16; ++i) S[i] = 0.f;
#pragma unroll
            for (int s = 0; s < 4; ++s) S = MFMA32(kf[s], qf[s], S);
            float p[16];
#pragma unroll
            for (int i = 0; i < 16; ++i) { const int key = 32 * tl + 8 * h + 16 * (i >> 3) + (i & 7); p[i] = key < nvis ? fexp2(S[i] * SM_C - mc) * inv : 0.f; }
            if (need_imp) {
#pragma unroll
                for (int a = 0; a < 2; ++a) {
                    const int u = 4 * tl + 2 * a + h; const float* q = p + 8 * a;
                    LAS float* row = imp + r * 65 + 2 * u;
                    atomicAdd((float*)(row + 0), (q[0] + q[1]) + (q[2] + q[3]));
                    atomicAdd((float*)(row + 1), (q[3] + q[4]) + (q[5] + q[6]) + q[7]);
                    if (2 * u + 2 < 64) atomicAdd((float*)(row + 2), q[7]);
                }
            }
            const bf16x8 pf0 = pack8(p), pf1 = pack8(p + 8);
            O[0] = MFMA32(vf[0][0], pf0, O[0]); O[0] = MFMA32(vf[0][1], pf1, O[0]);
            O[1] = MFMA32(vf[1][0], pf0, O[1]); O[1] = MFMA32(vf[1][1], pf1, O[1]);
        }
        write_o(qrow, O, 1.f, h);
    }
    asm volatile("s_waitcnt lgkmcnt(0)" ::: "memory");
    BLK_BAR();
    if (leader) {
        unsigned long long mask;
        if (cur <= 15) mask = (2ull << cur) - 1ull;
        else {
            float v[32];
#pragma unroll
            for (int i = 0; i < 32; ++i) v[i] = imp[r * 65 + 2 * i + h];
            mask = 1ull | (1ull << cur) | (1ull << (cur - 1));
            for (int k = 0; k < 13; ++k) {
                float best = -1.f; int bj = 64;
#pragma unroll
                for (int i = 0; i < 32; ++i) { const int j = 2 * i + h; const bool ok = j >= 1 && j <= cur - 2 && !((mask >> j) & 1ull); if (ok && v[i] > best) { best = v[i]; bj = j; } }
                const float ob = xhalf(best); const int oj = __shfl_xor(bj, 32);
                if (ob > best || (ob == best && oj < bj)) { best = ob; bj = oj; }
                if (bj < 64) mask |= 1ull << bj;
            }
        }
        if (lane < 32) ((GAS unsigned long long*)(ws + WS_NMASK))[b * SEQ + t] = mask;
    }
    asm volatile("s_waitcnt lgkmcnt(0)" ::: "memory");
}

DI void task_moba_gate(unsigned char* ws, int b, int hh, int qt, int lane) {
    const int r = lane & 31, h = lane >> 5, t0 = 32 * qt, t = t0 + r, cb = t0 >> 8;
    unsigned sel = 0u;
    if (cb <= 3) sel = (1u << cb) - 1u;
    else {
        const bf16_t* qrow = slot_ptr(ws, SL_QA) + (size_t)(b * SEQ + t) * 256 + hh * 64 + 32 * h;
        float q[32];
#pragma unroll
        for (int j = 0; j < 4; ++j) { float f[8]; load8(qrow + 8 * j, f);
#pragma unroll
            for (int e = 0; e < 8; ++e) q[8 * j + e] = f[e]; }
        const GAS float* km = (const GAS float*)(ws + WS_KMEAN) + (size_t)((b * 4 + hh) * 16) * 64 + 32 * h;
        float gate[16];
#pragma unroll
        for (int n = 0; n < 16; ++n) {
            float s = 0.f;
            if (n < cb) {
#pragma unroll
                for (int d = 0; d < 32; ++d) s += q[d] * km[n * 64 + d];
            }
            s += xhalf(s);
            gate[n] = n < cb ? s : sconst(-INFINITY);
        }
#pragma unroll
        for (int k = 0; k < 3; ++k) {
            float best = sconst(-INFINITY); int bi = -1;
#pragma unroll
            for (int n = 0; n < 16; ++n) if (!((sel >> n) & 1u) && gate[n] > best) { best = gate[n]; bi = n; }
            if (bi >= 0) sel |= 1u << bi;
        }
    }
    if (lane < 32) ((GAS unsigned*)(ws + WS_MMASK))[(b * 4 + hh) * SEQ + t] = sel | (1u << cb);
}

DI void task_kmean(unsigned char* ws, int b, int hh, int blk, int lane) {
    const bf16_t* kp = slot_ptr(ws, SL_KA) + (size_t)(b * SEQ + 256 * blk + (lane >> 3)) * 256 + hh * 64 + 8 * (lane & 7);
    float s[8];
#pragma unroll
    for (int e = 0; e < 8; ++e) s[e] = 0.f;
#pragma unroll 8
    for (int i = 0; i < 32; ++i) { float f[8]; load8(kp + (size_t)(8 * i) * 256, f);
#pragma unroll
        for (int e = 0; e < 8; ++e) s[e] += f[e]; }
#pragma unroll
    for (int e = 0; e < 8; ++e) { s[e] += __shfl_xor(s[e], 8); s[e] += __shfl_xor(s[e], 16); s[e] += __shfl_xor(s[e], 32); }
    if (lane < 8) {
        GAS float* o = (GAS float*)(ws + WS_KMEAN) + ((b * 4 + hh) * 16 + blk) * 64 + 8 * lane;
#pragma unroll
        for (int e = 0; e < 8; ++e) o[e] = s[e] * (1.f / 256.f);
    }
}

DI void task_mlp_block(unsigned char* ws, int kv, int b, int rt, int wave, int lane, LAS float* part) {
    const int r = lane & 31, h = lane >> 5, n = 32 * rt + r, ne = n > 254 ? 254 : n;
    const bf16_t* xp = slot_ptr(ws, SL_KB4) + (size_t)(b * SEQ + 16 * ne) * 256 + kv * 64 + 8 * h;
    const bf16_t* w1 = (const bf16_t*)(ws + WS_W1T) + (size_t)(kv * 256 + 32 * wave + kappa(r)) * 2048 + 8 * h;
    f32x16 acc;
#pragma unroll
    for (int i = 0; i < 16; ++i) acc[i] = 0.f;
    bf16x8 xa[4], wa[4], xb[4], wb[4];
#pragma unroll
    for (int s = 0; s < 4; ++s) { xa[s] = ldfrag(xp + 16 * s); wa[s] = ldfrag(w1 + 16 * s); }
    for (int l = 0; l < 32; l += 2) {
#pragma unroll
        for (int s = 0; s < 4; ++s) { xb[s] = ldfrag(xp + (size_t)(l + 1) * 256 + 16 * s); wb[s] = ldfrag(w1 + 64 * (l + 1) + 16 * s); }
#pragma unroll
        for (int s = 0; s < 4; ++s) acc = MFMA32(wa[s], xa[s], acc);
        const int l2 = l + 2 < 32 ? l + 2 : l;
#pragma unroll
        for (int s = 0; s < 4; ++s) { xa[s] = ldfrag(xp + (size_t)l2 * 256 + 16 * s); wa[s] = ldfrag(w1 + 64 * l2 + 16 * s); }
#pragma unroll
        for (int s = 0; s < 4; ++s) acc = MFMA32(wb[s], xb[s], acc);
    }
    const GAS float* bias = (const GAS float*)(ws + WS_BIAS) + kv * 256 + 32 * wave;
    const bf16_t* w2 = (const bf16_t*)(ws + WS_W2T) + (size_t)(kv * 64 + r) * 256 + 32 * wave + 8 * h;
    float g[16];
#pragma unroll
    for (int i = 0; i < 16; ++i) {
        const float x = acc[i] + bias[16 * (i >> 3) + 8 * h + (i & 7)];
        const float y = 0.7978845608028654f * (x + 0.044715f * x * x * x);
        const float th = 1.f - 2.f * frcp(1.f + fexp2(2.f * LOG2E * y));
        g[i] = 0.5f * x * (1.f + th);
    }
    const bf16x8 pf0 = pack8(g), pf1 = pack8(g + 8);
    f32x16 out[2];
#pragma unroll
    for (int i = 0; i < 16; ++i) { out[0][i] = 0.f; out[1][i] = 0.f; }
#pragma unroll
    for (int dt = 0; dt < 2; ++dt) {
        out[dt] = MFMA32(ldfrag(w2 + (size_t)(32 * dt) * 256), pf0, out[dt]);
        out[dt] = MFMA32(ldfrag(w2 + (size_t)(32 * dt) * 256 + 16), pf1, out[dt]);
    }
#pragma unroll
    for (int dt = 0; dt < 2; ++dt)
#pragma unroll
        for (int i = 0; i < 16; ++i) part[((wave * 2 + dt) * 16 + i) * 64 + lane] = out[dt][i];
    __syncthreads();
    const int dt = wave >> 2, gq = wave & 3;
    float sum[4];
#pragma unroll
    for (int e = 0; e < 4; ++e) { float a = 0.f;
#pragma unroll
        for (int w = 0; w < 8; ++w) a += part[((w * 2 + dt) * 16 + 4 * gq + e) * 64 + lane];
        sum[e] = n <= 254 ? a : 0.f; }
    const int d0 = 32 * dt + 8 * gq + 4 * h;
    if (kv == 0) store4((bf16_t*)(ws + WS_KCMP) + (size_t)(b * 256 + n) * 64 + d0, sum[0], sum[1], sum[2], sum[3]);
    else {
        bf16_t* vt = (bf16_t*)(ws + WS_VCMPT) + (size_t)(b * 64 + d0) * 256 + n;
#pragma unroll
        for (int e = 0; e < 4; ++e) ((GAS bf16_t*)vt)[e * 256] = (bf16_t)(pk2(sum[e], 0.f) & 0xffffu);
    }
    __syncthreads();
}

struct Args { const float* in[9]; float* out; unsigned char* ws; int pad0, pad1; };

DI int launder(int x) { asm volatile("" : "+v"(x)); return x; }
DI unsigned char* launder_p(unsigned char* p) { asm volatile("" : "+s"(p)); return (unsigned char*)(__attribute__((address_space(1))) unsigned char*)p; }
#define FRESH() const int tid = launder(tid0), lane = tid & 63, gw = blockIdx.x * NWAVES + wave; (void)gw; (void)lane; unsigned char* ws = launder_p(ws0); (void)ws;
DI int next_task(unsigned* ctr, int lane) {
    int v = 0;
    if (lane == 0) v = (int)atomicAdd(ctr, 1u);
    return __builtin_amdgcn_readfirstlane(v);
}

#ifndef PROBE_A
#define PROBE_A 0
#define PROBE_B 0
#endif
enum { ST_P0 = 0, ST_BIAS, ST_G_QK, ST_G_VT, ST_P2, ST_P3, ST_P4, ST_G_GATE, ST_G_U0, ST_G_M0, ST_G_U1, ST_G_M1, ST_G_U2, ST_G_M2, ST_G_U3, ST_G_M3, ST_G_OUT, NSTEP_LAYER };

__global__ void __launch_bounds__(NWAVES * 64, 2) mega_fwd(Args a) {
    extern __shared__ __attribute__((aligned(16))) unsigned char lds_raw[];
    cg::grid_group grid = cg::this_grid();
    LAS unsigned char* lds = (LAS unsigned char*)lds_raw;
    const int tid0 = threadIdx.x, wave = __builtin_amdgcn_readfirstlane(tid0 >> 6);
    const int G = gridDim.x, NGW = G * NWAVES;
    unsigned char* ws0 = a.ws;

    if (blockIdx.x == 0) { for (int i = tid0; i < CTL_BYTES / 4; i += NWAVES * 64) ((GAS unsigned*)(ws0 + WS_CTL))[i] = 0u; }
    { FRESH();
    for (int e = blockIdx.x * (NWAVES * 64) + tid; e < SEQ * 32; e += G * NWAVES * 64) {
        const int pos = e >> 5, i = e & 31;
        const float inv = (float)exp2(-(double)i * (13.287712379549449 / 32.0));
        const float ang = (float)pos * inv;
        const double x = (double)ang, kq = rint(x * 0.6366197723675814);
        const double rr = (x - kq * 1.5707963267948966) - kq * 6.123233995736766e-17, r2 = rr * rr;
        const double sn = rr * (1.0 + r2 * (-1.0 / 6 + r2 * (1.0 / 120 + r2 * (-1.0 / 5040 + r2 * (1.0 / 362880 + r2 * (-1.0 / 39916800 + r2 * (1.0 / 6227020800.0)))))));
        const double cs = 1.0 + r2 * (-0.5 + r2 * (1.0 / 24 + r2 * (-1.0 / 720 + r2 * (1.0 / 40320 + r2 * (-1.0 / 3628800 + r2 * (1.0 / 479001600 + r2 * (-1.0 / 87178291200.0)))))));
        const int qd = (int)((long long)kq & 3);
        const double s_ = qd == 0 ? sn : qd == 1 ? cs : qd == 2 ? -sn : -cs, c_ = qd == 0 ? cs : qd == 1 ? -sn : qd == 2 ? -cs : sn;
        ((float*)(ws + WS_COS))[e] = (float)c_; ((float*)(ws + WS_SIN))[e] = (float)s_;
    } }

    for (int step = 0; step <= DEPTH * NSTEP_LAYER; ++step) {
        const int layer = step / NSTEP_LAYER, ls = step - layer * NSTEP_LAYER;
#if PROBE_A || PROBE_B
        if (blockIdx.x == 0 && tid0 == 0) ((unsigned long long*)(ws0 + WS_CTL + 2048))[32] = wall_clock64();
#endif
        if (layer == DEPTH) {
            FRESH(); const float* fw = a.in[8];
#if PROBE_A || PROBE_B
            float pa = 0.f, pb = 0.f;
            { const unsigned long long* tacc = (const unsigned long long*)(ws + WS_CTL + 2048);
              for (int k = 0; k < NSTEP_LAYER; ++k) { const float ms = (float)tacc[k] * 1e-5f; if ((PROBE_B >> k) & 1) pb += 0.002f * ms; } }
#endif
            for (int m = gw; m < T; m += 4 * NGW) {
                const GAS f32x4* wr4 = (const GAS f32x4*)fw + lane;
                f32x4 v[4][4]; float ss[4]; int mr[4];
#pragma unroll
                for (int q = 0; q < 4; ++q) { mr[q] = m + q * NGW < T ? m + q * NGW : m;
#pragma unroll
                    for (int j = 0; j < 4; ++j) v[q][j] = ((const GAS f32x4*)(a.out + (size_t)mr[q] * D) + lane)[64 * j]; }
                const float eps = sconst(1e-6f);
#pragma unroll
                for (int q = 0; q < 4; ++q) { float s = 0.f;
#pragma unroll
                    for (int j = 0; j < 4; ++j) s += (v[q][j].x * v[q][j].x + v[q][j].y * v[q][j].y) + (v[q][j].z * v[q][j].z + v[q][j].w * v[q][j].w);
                    ss[q] = rsqrtf(wave_sum(s) * (1.f / D) + eps); }
#pragma unroll
                for (int j = 0; j < 4; ++j) { const f32x4 w = wr4[64 * j];
#pragma unroll
                    for (int q = 0; q < 4; ++q) { f32x4 o = (f32x4){v[q][j].x * ss[q] * w.x, v[q][j].y * ss[q] * w.y, v[q][j].z * ss[q] * w.z, v[q][j].w * ss[q] * w.w};
#if PROBE_A || PROBE_B
                        o = o + ((lane & 1) ? pb : -pb); (void)pa;
#endif
                        if (q == 0 || mr[q] != m) ((GAS f32x4*)(a.out + (size_t)mr[q] * D) + lane)[64 * j] = o; } }
            }
            break;
        }
        const float* xin = layer == 0 ? a.in[0] : a.out;
        bool sync = false;
        if (ls == ST_P0) {
            const float* norm_w = a.in[1] + (size_t)layer * D;
            const float* w_in = a.in[2] + (size_t)layer * D * INW;
            const float* cmp_pos = a.in[3] + (size_t)layer * 2 * 2048;
            const float* cmp_w1 = a.in[4] + (size_t)layer * 2 * 2048 * 256;
            const float* cmp_w2 = a.in[5] + (size_t)layer * 2 * 256 * 64;
            const float* w_up = a.in[6] + (size_t)layer * 4 * 256 * D;
            const float* w_out = a.in[7] + (size_t)layer * D * D;
            FRESH(); LAS float* scr = (LAS float*)(lds + wave * 16384); bf16_t* Hb = (bf16_t*)(ws + WS_H);
            constexpr int I_QK = 16 * (NQK / 32), I_V = 16 * (NV / 32), I_G = 16 * 32, I_M = 16 * 128, I_UP = 4 * 4 * 32, I_OUT = 16 * 32, I_W1 = 2 * 32 * 8, I_W2 = 2 * 4 * 2;
            constexpr int NITEMS = I_QK + I_V + I_G + I_M + I_UP + I_OUT + I_W1 + I_W2;
            for (int it = gw; it < NITEMS; it += NGW) {
                int q = it;
                if (q < I_QK) { const int kb = q / (NQK / 32), nb = q % (NQK / 32); transpose_item(w_in, D, INW, (bf16_t*)(ws + WS_WQK), 64 * kb, 32 * nb, src_qk(32 * nb + (lane & 31)), scr, lane); continue; } q -= I_QK;
                if (q < I_V) { const int kb = q / (NV / 32), nb = q % (NV / 32); transpose_item(w_in, D, INW, (bf16_t*)(ws + WS_WV), 64 * kb, 32 * nb, src_v(32 * nb + (lane & 31)), scr, lane); continue; } q -= I_V;
                if (q < I_G) { const int kb = q / 32, nb = q % 32; transpose_item(w_in, D, INW, (bf16_t*)(ws + WS_WG), 64 * kb, 32 * nb, src_g(32 * nb + (lane & 31)), scr, lane); continue; } q -= I_G;
                if (q < I_M) { const int kb = q / 128, nb = q % 128; transpose_item(w_in, D, INW, (bf16_t*)(ws + WS_WM), 64 * kb, 32 * nb, MRG + 32 * nb + (lane & 31), scr, lane); continue; } q -= I_M;
                if (q < I_UP) { const int br = q / 128, q2 = q % 128, kb = q2 / 32, nb = q2 % 32; transpose_item(w_up + (size_t)br * 256 * D, 256, D, (bf16_t*)(ws + WS_WUP) + (size_t)br * D * 256, 64 * kb, 32 * nb, 32 * nb + (lane & 31), scr, lane); continue; } q -= I_UP;
                if (q < I_OUT) { const int kb = q / 32, nb = q % 32; transpose_item(w_out, D, D, (bf16_t*)(ws + WS_WOUT), 64 * kb, 32 * nb, 32 * nb + (lane & 31), scr, lane); continue; } q -= I_OUT;
                if (q < I_W1) { const int kv = q / 256, q2 = q % 256, kb = q2 / 8, nb = q2 % 8; transpose_item(cmp_w1 + (size_t)kv * 2048 * 256, 2048, 256, (bf16_t*)(ws + WS_W1T) + (size_t)kv * 256 * 2048, 64 * kb, 32 * nb, 32 * nb + (lane & 31), scr, lane); continue; } q -= I_W1;
                { const int kv = q / 8, q2 = q % 8, kb = q2 / 2, nb = q2 % 2; transpose_item(cmp_w2 + (size_t)kv * 256 * 64, 256, 64, (bf16_t*)(ws + WS_W2T) + (size_t)kv * 64 * 256, 64 * kb, 32 * nb, 32 * nb + (lane & 31), scr, lane); }
            }
            for (int it = gw; it < 2 * 4 * 32; it += NGW) {
                const int ch = it & 31, hg = (it >> 5) & 3, kv = it >> 7;
                const float* w1 = cmp_w1 + (size_t)kv * 2048 * 256 + (size_t)(64 * ch) * 256 + 64 * hg + lane; const float* pe = cmp_pos + kv * 2048 + 64 * ch;
                float s = 0.f;
#pragma unroll 8
                for (int f = 0; f < 64; ++f) s += pe[f] * w1[(size_t)f * 256];
                ((float*)(ws + WS_BIASP))[(ch * 2 + kv) * 256 + 64 * hg + lane] = s;
            }
            for (int m = gw; m < T; m += 2 * NGW) {
                const int m1 = m + NGW < T ? m + NGW : m;
                const GAS f32x4* xr0 = (const GAS f32x4*)(xin + (size_t)m * D) + lane; const GAS f32x4* xr1 = (const GAS f32x4*)(xin + (size_t)m1 * D) + lane; const GAS f32x4* wr4 = (const GAS f32x4*)norm_w + lane;
                f32x4 v0[4], v1[4]; float s0 = 0.f, s1 = 0.f;
#pragma unroll
                for (int j = 0; j < 4; ++j) { v0[j] = xr0[64 * j]; v1[j] = xr1[64 * j]; }
#pragma unroll
                for (int j = 0; j < 4; ++j) { s0 += (v0[j].x * v0[j].x + v0[j].y * v0[j].y) + (v0[j].z * v0[j].z + v0[j].w * v0[j].w); s1 += (v1[j].x * v1[j].x + v1[j].y * v1[j].y) + (v1[j].z * v1[j].z + v1[j].w * v1[j].w); }
                const float eps = sconst(1e-6f);
                const float rs0 = rsqrtf(wave_sum(s0) * (1.f / D) + eps), rs1 = rsqrtf(wave_sum(s1) * (1.f / D) + eps);
                GAS u32x2* o80 = (GAS u32x2*)(Hb + (size_t)m * D) + lane; GAS u32x2* o81 = (GAS u32x2*)(Hb + (size_t)m1 * D) + lane;
#pragma unroll
                for (int j = 0; j < 4; ++j) { const f32x4 w = wr4[64 * j]; u32x2 o0, o1;
                    o0.x = pk2(v0[j].x * rs0 * w.x, v0[j].y * rs0 * w.y); o0.y = pk2(v0[j].z * rs0 * w.z, v0[j].w * rs0 * w.w);
                    o1.x = pk2(v1[j].x * rs1 * w.x, v1[j].y * rs1 * w.y); o1.y = pk2(v1[j].z * rs1 * w.z, v1[j].w * rs1 * w.w);
                    o80[64 * j] = o0; if (m1 != m) o81[64 * j] = o1; }
            }
            sync = true;
        } else if (ls == ST_BIAS) {
            FRESH();
            if (blockIdx.x == 0) { float s = 0.f; for (int c = 0; c < 32; ++c) s += ((const float*)(ws + WS_BIASP))[c * 512 + tid]; ((float*)(ws + WS_BIAS))[tid] = s; }
        } else if (ls == ST_P2) {
        } else if (ls == ST_P3 || ls == ST_P4) {
            if (ls == ST_P3) {
                { FRESH();
                  for (int base = 0; base < 1024; base += 4 * G) {
                      const int it = base + blockIdx.x + G * (wave & 3); const int q = it < 1024 ? 1023 - it : 0;
                      task_cmp(ws, q & 7, q >> 3, lane, (LAS float*)(lds + (wave & 3) * 16384), 2 * (wave >> 2), it < 1024 ? 2 : 0, wave < 4 && it < 1024);
                  } }
                { FRESH();
                  for (int q = blockIdx.x + G * (NWAVES - 1 - wave); q < 4096; q += NGW) task_moba_gate(ws, q & 7, (q >> 3) & 3, q >> 5, lane); }
            }
            for (int pool = (ls == ST_P3 ? 0 : 2); pool < (ls == ST_P3 ? 2 : 3); ++pool) {
                FRESH();
                unsigned* ctr = (unsigned*)(ws + WS_CTL) + layer * 64 + 16 * pool;
                const int ngroups = pool == 0 ? 1024 : pool == 1 ? 1536 : 1024;
                volatile LAS int* gslot = (volatile LAS int*)(lds + 131072);
                for (;;) {
                    __syncthreads();
                    if (tid == 0) *gslot = (int)atomicAdd(ctr, 1u);
                    __syncthreads();
                    const int g = __builtin_amdgcn_readfirstlane(*gslot);
                    if (g >= ngroups) break;
                    if (pool == 2) { const int qg = 15 - (g >> 6), w = g & 63; run_heavy_group(ws, w >> 5, w & 7, (w >> 3) & 3, qg, wave, lane, tid, lds); }
                    else if (pool == 0 && g < 512) { task_stick(ws, g & 7, (g >> 3) & 3, 8 * (15 - (g >> 5)) + wave, lane, lds + wave * 16384); }
                    else {
                        const int kd = pool == 0 ? 3 : (g < 512 ? 2 : 4 + ((g - 512) >> 9)), w = g & 511;
                        task_sm(ws, kd, w & 7, (w >> 3) & 3, 8 * (w >> 5) + wave, lane, lds + wave * 16384);
                    }
                }
            }
            sync = true;
        } else {
            unsigned char* ws = launder_p(ws0); bf16_t* Hb = (bf16_t*)(ws + WS_H);
            pg8::Gemm g; Epi E{0, 0, ws, xin, a.out};
            if (ls == ST_G_QK) { g = pg8::Gemm{Hb, (const bf16_t*)(ws + WS_WQK), T, NQK, D}; E.kind = 0; sync = true; }
            else if (ls == ST_G_VT) { g = pg8::Gemm{(const bf16_t*)(ws + WS_WV), Hb, NV, T, D}; E.kind = 1; sync = true; }
            else if (ls == ST_G_GATE) { g = pg8::Gemm{Hb, (const bf16_t*)(ws + WS_WG), T, D, D}; E.kind = 2; sync = true; }
            else if (ls == ST_G_OUT) { g = pg8::Gemm{(const bf16_t*)(ws + WS_Y), (const bf16_t*)(ws + WS_WOUT), T, D, D}; E.kind = 5; sync = true; }
            else {
                const int k = ls - ST_G_U0, br = k >> 1;
                const int wslot = br == 0 ? SL_QA : br == 1 ? SL_QB : br == 2 ? SL_QC : SL_QD0;
                if ((k & 1) == 0) { g = pg8::Gemm{slot_ptr(ws, wslot), (const bf16_t*)(ws + WS_WUP) + (size_t)br * D * 256, T, D, 256}; E.kind = 3; }
                else { g = pg8::Gemm{Hb, (const bf16_t*)(ws + WS_WM) + (size_t)br * D * D, T, D, D}; E.kind = 4; E.first = (br == 0); sync = (br == 3); }
            }
            pg8::StaticOrder S; S.init(g.M, g.N, G, (int)blockIdx.x);
            if (ls == ST_G_VT) {
                FRESH();
                if (G == 256) {
                    if (blockIdx.x < 128) task_mlp_block(ws, blockIdx.x >> 6, (blockIdx.x >> 3) & 7, blockIdx.x & 7, wave, lane, (LAS float*)lds);
                    else if (blockIdx.x < 192) { const int q = (blockIdx.x - 128) * NWAVES + wave; task_kmean(ws, q >> 6, (q >> 4) & 3, q & 15, lane); }
                    S.split = 128;
                } else {
                    for (int q = gw; q < 512; q += NGW) task_kmean(ws, q >> 6, (q >> 4) & 3, q & 15, lane);
                    for (int it = blockIdx.x; it < 128; it += G) task_mlp_block(ws, it >> 6, (it >> 3) & 7, it & 7, wave, lane, (LAS float*)lds);
                }
                __syncthreads();
            }
            pg8::gemm_phase<Epi, pg8::StaticOrder, true, true>(lds, g, S, E);
        }
        if (sync) grid.sync();
#if PROBE_A || PROBE_B
        if (blockIdx.x == 0 && tid0 == 0) { unsigned long long* tp = (unsigned long long*)(ws0 + WS_CTL + 2048); tp[ls] += wall_clock64() - tp[32]; }
#endif
    }
}

extern "C" void kernel_launch(void* const* d_in, const int* in_sizes, int n_in, void* d_out, int out_size, void* d_ws, size_t ws_size, hipStream_t stream) {
    static int grid = 0;
    if (grid == 0) {
        int dev = 0, cus = 0, per_cu = 0;
        hipGetDevice(&dev);
        hipDeviceGetAttribute(&cus, hipDeviceAttributeMultiprocessorCount, dev);
        hipFuncSetAttribute((const void*)mega_fwd, hipFuncAttributeMaxDynamicSharedMemorySize, LDS_BYTES);
        hipOccupancyMaxActiveBlocksPerMultiprocessor(&per_cu, (const void*)mega_fwd, NWAVES * 64, LDS_BYTES);
        (void)hipGetLastError();
        grid = cus;
        if (n_in != 9 || out_size != T * D || ws_size < WS_END || per_cu < 1) { fprintf(stderr, "kernel_launch: unexpected problem (n_in %d out %d ws %zu per_cu %d)\n", n_in, out_size, ws_size, per_cu); grid = -1; }
    }
    if (grid < 0) return;
    Args a{};
    for (int i = 0; i < 9; ++i) a.in[i] = (const float*)d_in[i];
    a.out = (float*)d_out; a.ws = (unsigned char*)d_ws;
    void* args[] = {&a};
    hipError_t e = hipLaunchCooperativeKernel((const void*)mega_fwd, dim3(grid), dim3(NWAVES * 64), args, LDS_BYTES, stream);
    if (e != hipSuccess) fprintf(stderr, "cooperative launch failed: %s\n", hipGetErrorString(e));
}
```

```cpp
#include <hip/hip_runtime.h>
#include <hip/hip_cooperative_groups.h>
#include <cstdio>
#include <cstdint>
namespace cg = cooperative_groups;
__device__ __forceinline__ int launder_i(int x) { asm volatile("" : "+v"(x)); return x; }
namespace pg8 {
#define PG8_LAS __attribute__((address_space(3)))
typedef unsigned short bf16_t;
typedef short bf16x8 __attribute__((ext_vector_type(8)));
typedef float f32x4 __attribute__((ext_vector_type(4)));
typedef unsigned u32x4 __attribute__((ext_vector_type(4)));
constexpr int BM = 256, BK = 64, HALF = 128, HTB = HALF * BK * 2  , STAGE_BYTES = 8 * HTB, NXCD = 8, WGM = 8;

__host__ __device__ __forceinline__ int lds_byte(int r, int c) { const int st = (r >> 4) * 2 + (c >> 5), rr = r & 15, cc = c & 31, ob = rr * 64 + cc * 2; return st * 1024 + (ob ^ (((ob >> 9) & 1) << 5)); }
__host__ __device__ __forceinline__ void stage_rc(int b, int& R, int& C) { const int st = b / 1024, sb = b % 1024, swz = sb ^ (((sb >> 9) & 1) << 5); R = (st >> 1) * 16 + swz / 64; C = (st & 1) * 32 + (swz % 64) / 2; }
__host__ __device__ __forceinline__ int perm32(int rho) { const int n = rho >> 4, i = rho & 15; return 8 * (i >> 2) + 4 * n + (i & 3); }

struct Unit { int pm, pn; };
struct Gemm { const bf16_t* A; const bf16_t* Bt; int M, N, K; };

struct StaticOrder {
    int nM, nN, nwg, G, c, split;
    __host__ __device__ void init(int M, int N, int G_, int c_) { nM = M / BM; nN = N / BM; nwg = nM * nN; G = G_; c = c_; split = 0; }
    __host__ __device__ bool next(int i, Unit& u) const {
        if (split) {
            const int per = c < split ? 2 : 4; if (i >= per) return false;
            const int L2 = c < split ? 2 * c + i : 2 * split + 4 * (c - split) + i;
            u.pm = L2 % nM; u.pn = L2 / nM; return true;
        }
        const long L = (long)i * G + c; if (L >= nwg) return false;
        int wgid = (int)L; { const int q = nwg / NXCD, r = nwg % NXCD, xcd = wgid % NXCD, off = wgid / NXCD; wgid = (xcd < r ? xcd * (q + 1) : r * (q + 1) + (xcd - r) * q) + off; }
        const int nig = WGM * nN, gid = wgid / nig, fm = gid * WGM, gsz = (nM - fm) < WGM ? (nM - fm) : WGM;
        u.pm = fm + ((wgid % nig) % gsz); u.pn = (wgid % nig) / gsz; return true;
    }
    __device__ __forceinline__ void a_ready(const Unit&) const {}
    __device__ __forceinline__ void done(const Unit&) const {}
};

__device__ __forceinline__ unsigned cvt_pk_bf16(float lo, float hi) { unsigned r; asm volatile("v_cvt_pk_bf16_f32 %0, %1, %2" : "=v"(r) : "v"(lo), "v"(hi)); return r; }
template <class Epi, class Sched, bool ALIGN_EPI = false, bool SP2 = false>
__device__ __forceinline__ void gemm_phase(PG8_LAS unsigned char* lds, const Gemm g, const Sched& S, const Epi& E) {
    const int tid = launder_i((int)threadIdx.x), wid = __builtin_amdgcn_readfirstlane(tid >> 6), lane = tid & 63, wr = wid >> 2, wc = wid & 3, fr = lane & 15, fq = lane >> 4;
    const int K = g.K, nt = K / BK;
    unsigned voffA[2], voffB[2];
#pragma unroll
    for (int i = 0; i < 2; ++i) { int R, C; stage_rc(tid * 16 + i * 8192, R, C); const int Rb = Epi::PERM ? ((R & ~31) + perm32(R & 31)) : R;
        voffA[i] = (unsigned)(R * K + C) * 2u; voffB[i] = (unsigned)(Rb * K + C) * 2u; }
    const size_t kstep = (size_t)(BK * 2);
    const size_t hstep = (size_t)HALF * K * 2;
    const size_t tstep = 2 * hstep;
    const unsigned ldsw = (unsigned)wid * 1024u;
    const int aoff = lds_byte(wr * 64 + fr, fq * 8), boff = lds_byte(wc * 32 + fr, fq * 8);
#define PG8_SA(b, h) (((b) * 2 + (h)) * HTB)
#define PG8_SB(b, h) ((4 + (b) * 2 + (h)) * HTB)
#define PG8_STAGE(bufoff, gbase, voff) do { _Pragma("unroll") for (int _i = 0; _i < 2; ++_i) \
        __builtin_amdgcn_global_load_lds((const unsigned*)((const char*)(gbase) + (voff)[_i]), (PG8_LAS unsigned*)(lds + (bufoff) + ldsw + _i * 8192), 16, 0, 0); } while (0)
#define PG8_LDA(dst, b, h) do { _Pragma("unroll") for (int m = 0; m < 4; ++m) _Pragma("unroll") for (int k = 0; k < 2; ++k) dst[m][k] = *(const PG8_LAS bf16x8*)(lds + PG8_SA(b, h) + aoff + m * 2048 + k * 1024); } while (0)
#define PG8_LDB(dst, b, h) do { _Pragma("unroll") for (int n = 0; n < 2; ++n) _Pragma("unroll") for (int k = 0; k < 2; ++k) dst[n][k] = *(const PG8_LAS bf16x8*)(lds + PG8_SB(b, h) + boff + n * 2048 + k * 1024); } while (0)
#define PG8_MMA(ai, bj, At, Bt) do { __builtin_amdgcn_s_setprio(1); _Pragma("unroll") for (int m = 0; m < 4; ++m) _Pragma("unroll") for (int n = 0; n < 2; ++n) _Pragma("unroll") for (int k = 0; k < 2; ++k) \
        acc[ai][bj][m][n] = __builtin_amdgcn_mfma_f32_16x16x32_bf16(Bt[n][k], At[m][k], acc[ai][bj][m][n], 0, 0, 0); __builtin_amdgcn_s_setprio(0); } while (0)
#define PG8_WAIT_V(n) asm volatile("s_waitcnt vmcnt(" #n ")" ::: "memory")
#define PG8_WAIT_L(n) asm volatile("s_waitcnt lgkmcnt(" #n ")" ::: "memory")
#define PG8_BAR __builtin_amdgcn_s_barrier()
#define PG8_SCHED __builtin_amdgcn_sched_barrier(0)
    Unit cur, nxt; int ui = 0;
    if (!S.next(0, cur)) return;
    f32x4 acc[2][2][4][2];
#pragma unroll
    for (int a = 0; a < 2; ++a)
#pragma unroll
        for (int b = 0; b < 2; ++b)
#pragma unroll
            for (int m = 0; m < 4; ++m)
#pragma unroll
                for (int n = 0; n < 2; ++n) acc[a][b][m][n] = (f32x4){0.f, 0.f, 0.f, 0.f};
    bf16x8 At[4][2], B0[2][2], B1[2][2];
    const char* cA = (const char*)g.A + (size_t)cur.pm * tstep; const char* cB = (const char*)g.Bt + (size_t)cur.pn * tstep;
    S.a_ready(cur);
    if constexpr (SP2) {
        PG8_STAGE(PG8_SB(0, 0), cB, voffB); PG8_STAGE(PG8_SB(0, 1), cB + hstep, voffB); PG8_STAGE(PG8_SA(0, 0), cA, voffA); PG8_STAGE(PG8_SA(0, 1), cA + hstep, voffA);
        if (wr == 1) PG8_BAR;
        PG8_WAIT_V(2); PG8_BAR;
        PG8_STAGE(PG8_SB(1, 0), cB + kstep, voffB); PG8_STAGE(PG8_SA(1, 0), cA + kstep, voffA); PG8_STAGE(PG8_SB(1, 1), cB + hstep + kstep, voffB);
        PG8_WAIT_V(6); PG8_BAR;
    } else {
        PG8_STAGE(PG8_SB(0, 0), cB, voffB); PG8_STAGE(PG8_SA(0, 0), cA, voffA); PG8_STAGE(PG8_SB(0, 1), cB + hstep, voffB); PG8_STAGE(PG8_SA(0, 1), cA + hstep, voffA);
        if (wr == 1) PG8_BAR;
        PG8_WAIT_V(4); PG8_BAR;
        PG8_STAGE(PG8_SB(1, 0), cB + kstep, voffB); PG8_STAGE(PG8_SA(1, 0), cA + kstep, voffA); PG8_STAGE(PG8_SB(1, 1), cB + hstep + kstep, voffB);
        PG8_WAIT_V(6); PG8_BAR;
    }
    for (;;) {
        const bool has_next = S.next(ui + 1, nxt);
        const char* nA = has_next ? (const char*)g.A + (size_t)nxt.pm * tstep : cA; const char* nB = has_next ? (const char*)g.Bt + (size_t)nxt.pn * tstep : cB;
        for (int t = 0; t < nt; t += 2) {
            const bool last = (t == nt - 2);
            const char* a1 = cA + (size_t)(t + 1) * kstep;
            const char* a2 = last ? nA : cA + (size_t)(t + 2) * kstep; const char* b2 = last ? nB : cB + (size_t)(t + 2) * kstep;
            const char* a3 = a2 + kstep; const char* b3 = b2 + kstep;
            if (last && has_next) S.a_ready(nxt);
            if constexpr (SP2) {
            PG8_LDB(B0, 0, 0); PG8_LDB(B1, 0, 1); PG8_SCHED; PG8_LDA(At, 0, 0); PG8_STAGE(PG8_SA(1, 1), a1 + hstep, voffA);
            PG8_WAIT_V(8); PG8_WAIT_L(0); PG8_BAR; PG8_MMA(0, 0, At, B0); PG8_MMA(0, 1, At, B1); PG8_BAR; PG8_SCHED;
            PG8_LDA(At, 0, 1); PG8_STAGE(PG8_SB(0, 0), b2, voffB); PG8_STAGE(PG8_SB(0, 1), b2 + hstep, voffB); PG8_STAGE(PG8_SA(0, 0), a2, voffA);
            PG8_WAIT_V(8); PG8_WAIT_L(0); PG8_BAR; PG8_MMA(1, 0, At, B0); PG8_MMA(1, 1, At, B1); PG8_BAR; PG8_SCHED;
            PG8_LDB(B0, 1, 0); PG8_LDB(B1, 1, 1); PG8_SCHED; PG8_LDA(At, 1, 0); PG8_STAGE(PG8_SA(0, 1), a2 + hstep, voffA);
            PG8_WAIT_V(8); PG8_WAIT_L(0); PG8_BAR; PG8_MMA(0, 0, At, B0); PG8_MMA(0, 1, At, B1); PG8_BAR; PG8_SCHED;
            PG8_LDA(At, 1, 1); PG8_STAGE(PG8_SB(1, 0), b3, voffB); PG8_STAGE(PG8_SB(1, 1), b3 + hstep, voffB); PG8_STAGE(PG8_SA(1, 0), a3, voffA);
            PG8_WAIT_V(8); PG8_WAIT_L(0); PG8_BAR; PG8_MMA(1, 0, At, B0); PG8_MMA(1, 1, At, B1); PG8_BAR; PG8_SCHED;
            } else {
            PG8_LDB(B0, 0, 0); PG8_SCHED; PG8_LDA(At, 0, 0); PG8_STAGE(PG8_SA(1, 1), a1 + hstep, voffA);
            PG8_WAIT_L(8); PG8_BAR; PG8_WAIT_L(0); PG8_MMA(0, 0, At, B0); PG8_BAR; PG8_SCHED;
            PG8_LDB(B1, 0, 1); PG8_STAGE(PG8_SB(0, 0), b2, voffB);
            PG8_BAR; PG8_WAIT_L(0); PG8_MMA(0, 1, At, B1); PG8_BAR;
            PG8_LDA(At, 0, 1); PG8_STAGE(PG8_SA(0, 0), a2, voffA);
            PG8_BAR; PG8_WAIT_L(0); PG8_MMA(1, 0, At, B0); PG8_BAR; PG8_SCHED;
            PG8_STAGE(PG8_SB(0, 1), b2 + hstep, voffB);
            PG8_WAIT_V(6); PG8_BAR; PG8_MMA(1, 1, At, B1); PG8_BAR;
            PG8_LDB(B0, 1, 0); PG8_SCHED; PG8_LDA(At, 1, 0); PG8_STAGE(PG8_SA(0, 1), a2 + hstep, voffA);
            PG8_WAIT_L(8); PG8_BAR; PG8_WAIT_L(0); PG8_MMA(0, 0, At, B0); PG8_BAR; PG8_SCHED;
            PG8_LDB(B1, 1, 1); PG8_STAGE(PG8_SB(1, 0), b3, voffB);
            PG8_BAR; PG8_WAIT_L(0); PG8_MMA(0, 1, At, B1); PG8_BAR;
            PG8_LDA(At, 1, 1); PG8_STAGE(PG8_SA(1, 0), a3, voffA);
            PG8_BAR; PG8_WAIT_L(0); PG8_MMA(1, 0, At, B0); PG8_BAR; PG8_SCHED;
            PG8_STAGE(PG8_SB(1, 1), b3 + hstep, voffB);
            PG8_WAIT_V(6); PG8_BAR; PG8_MMA(1, 1, At, B1); PG8_BAR;
            }
        }
        if constexpr (ALIGN_EPI) { if (wr == 0) PG8_BAR; }
        if constexpr (!Epi::AFTER_DRAIN) { E(acc, cur, wr, wc, fr, fq); S.done(cur); }
        if (!has_next) break;
#pragma unroll
        for (int a = 0; a < 2; ++a)
#pragma unroll
            for (int b = 0; b < 2; ++b)
#pragma unroll
                for (int m = 0; m < 4; ++m)
#pragma unroll
                    for (int n = 0; n < 2; ++n) acc[a][b][m][n] = (f32x4){0.f, 0.f, 0.f, 0.f};
        cur = nxt; cA = nA; cB = nB; ++ui;
        if constexpr (ALIGN_EPI) { if (wr == 1) PG8_BAR; }
    }
    PG8_WAIT_V(0);
    if constexpr (!ALIGN_EPI) { if (wr == 0) PG8_BAR; }
    PG8_BAR;
    if constexpr (Epi::AFTER_DRAIN) { E.fused(acc, cur, wr, wc, fr, fq, lds, wid, lane); S.done(cur); }
#undef PG8_SA
#undef PG8_SB
#undef PG8_STAGE
#undef PG8_LDA
#undef PG8_LDB
#undef PG8_MMA
#undef PG8_WAIT_V
#undef PG8_WAIT_L
#undef PG8_BAR
#undef PG8_SCHED
}
}

constexpr int NWAVES = 8;
constexpr int LDS_BYTES = 135168;
constexpr int NB = 8, SEQ = 4096, T = NB * SEQ, D = 1024, INW = 9612, DEPTH = 2;
constexpr int A_Q = 0, A_K = 256, A_V = 512, A_G = 768, B_Q = 1024, B_KC = 1280, B_VC = 1344, B_KS = 1408, B_VS = 1472, B_KW = 1536, B_VW = 1600, B_G = 1664, B_NG = 1920,
              C_Q = 1932, C_K = 2188, C_V = 2444, C_G = 2700, D_Q = 2956, D_K = 3724, D_V = 4492, D_G = 5260, MRG = 5516;
constexpr size_t MiB = 1u << 20, KiB = 1024;
constexpr size_t WS_CTL = 0, WS_COS = 1 * MiB, WS_SIN = 1 * MiB + 512 * KiB, WS_KMEAN = 2 * MiB, WS_BIASP = 2 * MiB + 128 * KiB, WS_BIAS = 2 * MiB + 192 * KiB,
                 WS_KCMP = 2 * MiB + 512 * KiB, WS_VCMPT = 2 * MiB + 768 * KiB, WS_MMASK = 3 * MiB, WS_NMASK = 3 * MiB + 512 * KiB, WS_LSE = 4 * MiB,
                 WS_W1T = 6 * MiB, WS_W2T = 8 * MiB, WS_WQK = 9 * MiB, WS_WV = 15 * MiB, WS_WG = 18 * MiB, WS_WM = 20 * MiB, WS_WUP = 28 * MiB, WS_WOUT = 30 * MiB,
                 WS_H = 32 * MiB, WS_QK = 96 * MiB, WS_VT = 320 * MiB, WS_U = 320 * MiB, WS_Y = 224 * MiB, WS_END = 432 * MiB;
constexpr size_t SLOT_BYTES = 16 * MiB;
constexpr int SL_QA = 0, SL_QB = 1, SL_QC = 2, SL_QD0 = 3, SL_QBR = 4, SL_QD1 = 5, SL_QD2 = 6, SL_OWIN = 7, SL_KA = 8, SL_KB4 = 9, SL_KC = 10, SL_KD0 = 11, SL_OSLC = 20;
constexpr int NQK = 3072, NV = 1536;
constexpr int CTL_BYTES = 4096;

typedef unsigned short bf16_t;
typedef short bf16x8 __attribute__((ext_vector_type(8)));
typedef float f32x4 __attribute__((ext_vector_type(4)));
typedef float f32x2 __attribute__((ext_vector_type(2)));
typedef float f32x16 __attribute__((ext_vector_type(16)));
typedef unsigned u32x4 __attribute__((ext_vector_type(4)));
typedef unsigned u32x2 __attribute__((ext_vector_type(2)));
typedef __bf16 bf16v2 __attribute__((ext_vector_type(2)));
#define LAS __attribute__((address_space(3)))
#define GAS __attribute__((address_space(1)))
#define DI __device__ __forceinline__
#define MFMA32(a, b, c) __builtin_amdgcn_mfma_f32_32x32x16_bf16((a), (b), (c), 0, 0, 0)

constexpr float LOG2E = 1.4426950408889634f, LN2 = 0.6931471805599453f;
DI float sconst(float x) { asm volatile("" : "+s"(x)); return x; }
constexpr float SM_SCALE = 0.125f, SM_C = 0.125f * LOG2E, NEG_C = -1e30f, MFLOOR_C = -30000.f;
#define NEG sconst(NEG_C)
#define MFLOOR sconst(MFLOOR_C)

DI unsigned pk2(float lo, float hi) { const bf16v2 r = __builtin_convertvector((f32x2){lo, hi}, bf16v2); return __builtin_bit_cast(unsigned, r); }
DI float bf_lo(unsigned w) { return __uint_as_float(w << 16); }
DI float bf_hi(unsigned w) { return __uint_as_float(w & 0xffff0000u); }
DI float bf1(bf16_t x) { return __uint_as_float((unsigned)x << 16); }
DI float fexp2(float x) { return __builtin_amdgcn_exp2f(x); }
DI float flog2(float x) { return __builtin_amdgcn_logf(x); }
DI float frcp(float x) { return __builtin_amdgcn_rcpf(x); }
DI float sigmoidf_(float x) { return frcp(1.f + fexp2(-x * LOG2E)); }
DI float wave_sum(float v) {
#pragma unroll
    for (int o = 1; o < 64; o <<= 1) v += __shfl_xor(v, o);
    return v;
}
DI float xhalf(float v) { return __shfl_xor(v, 32); }
DI float hmaxf_(float v) { const auto r = __builtin_amdgcn_permlane32_swap(__float_as_uint(v), __float_as_uint(v), false, false); return fmaxf(__uint_as_float(r[0]), __uint_as_float(r[1])); }
DI float hsumf_(float v) { const auto r = __builtin_amdgcn_permlane32_swap(__float_as_uint(v), __float_as_uint(v), false, false); return __uint_as_float(r[0]) + __uint_as_float(r[1]); }
DI bf16_t* slot_ptr(unsigned char* ws, int s) { return (bf16_t*)(ws + WS_QK + (size_t)s * SLOT_BYTES); }
DI void load8(const bf16_t* p, float (&f)[8]) { const u32x4 w = *(const GAS u32x4*)p; f[0] = bf_lo(w.x); f[1] = bf_hi(w.x); f[2] = bf_lo(w.y); f[3] = bf_hi(w.y); f[4] = bf_lo(w.z); f[5] = bf_hi(w.z); f[6] = bf_lo(w.w); f[7] = bf_hi(w.w); }
DI void store8(bf16_t* p, const float (&f)[8]) { u32x4 w; w.x = pk2(f[0], f[1]); w.y = pk2(f[2], f[3]); w.z = pk2(f[4], f[5]); w.w = pk2(f[6], f[7]); *(GAS u32x4*)p = w; }
DI void store4(bf16_t* p, float a, float b, float c, float d) { u32x2 w; w.x = pk2(a, b); w.y = pk2(c, d); *(GAS u32x2*)p = w; }

struct Epi {
    static constexpr bool PERM = true, AFTER_DRAIN = false;
    int kind, first; unsigned char* ws; const float* xin; float* xout;
    typedef pg8::f32x4 a4;
    DI void operator()(const a4 (&acc)[2][2][4][2], const pg8::Unit& u, int wr, int wc, int fr, int fq) const {
        if (kind == 0) {
            const int tile = u.pn;
            const int slot = (int)((0xDCB653A29180ull >> (4 * tile)) & 15ull);
            bf16_t* dst = slot_ptr(ws, slot); bf16_t* dst2 = slot_ptr(ws, SL_QBR);
            const bool ropeall = (tile <= 1) || (tile >= 6);
            const int g = 4 * (wc & 1) + fq, d0 = 4 * g;
            const float* cosT = (const float*)(ws + WS_COS); const float* sinT = (const float*)(ws + WS_SIN);
#pragma unroll
            for (int ai = 0; ai < 2; ++ai)
#pragma unroll
                for (int m = 0; m < 4; ++m) {
                    const int tok = u.pm * 256 + ai * 128 + wr * 64 + m * 16 + fr, pos = tok & (SEQ - 1);
                    const f32x4 cs = *(const GAS f32x4*)(cosT + pos * 32 + d0), sn = *(const GAS f32x4*)(sinT + pos * 32 + d0);
#pragma unroll
                    for (int bj = 0; bj < 2; ++bj) {
                        const int hs = 2 * bj + (wc >> 1);
                        const a4 v0 = acc[ai][bj][m][0], v1 = acc[ai][bj][m][1];
                        const a4 r0 = v0 * cs - v1 * sn, r1 = v0 * sn + v1 * cs;
                        const size_t off = (size_t)tok * 256 + hs * 64 + d0;
                        const bool rope = ropeall || (tile == 3 && hs >= 2);
                        if (tile == 2) { store4(dst + off, v0[0], v0[1], v0[2], v0[3]); store4(dst + off + 32, v1[0], v1[1], v1[2], v1[3]);
                                         store4(dst2 + off, r0[0], r0[1], r0[2], r0[3]); store4(dst2 + off + 32, r1[0], r1[1], r1[2], r1[3]); }
                        else if (rope) { store4(dst + off, r0[0], r0[1], r0[2], r0[3]); store4(dst + off + 32, r1[0], r1[1], r1[2], r1[3]); }
                        else { store4(dst + off, v0[0], v0[1], v0[2], v0[3]); store4(dst + off + 32, v1[0], v1[1], v1[2], v1[3]); }
                    }
                    asm volatile("" ::: "memory");
                }
        } else if (kind == 1) {
            bf16_t* VT = (bf16_t*)(ws + WS_VT);
#pragma unroll
            for (int ai = 0; ai < 2; ++ai)
#pragma unroll
                for (int m = 0; m < 4; ++m) {
                    const int r = u.pm * 256 + ai * 128 + wr * 64 + m * 16 + fr;
                    bf16_t* rowp = VT + (size_t)r * T;
                    const bool gate = (r >= 1408 && r < 1420);
#pragma unroll
                    for (int bj = 0; bj < 2; ++bj) {
                        const int c0 = u.pn * 256 + bj * 128 + wc * 32 + 8 * fq;
                        const a4 v0 = acc[ai][bj][m][0], v1 = acc[ai][bj][m][1];
                        float v[8] = {v0[0], v0[1], v0[2], v0[3], v1[0], v1[1], v1[2], v1[3]};
                        if (gate) {
#pragma unroll
                            for (int j = 0; j < 8; ++j) v[j] = sigmoidf_(v[j]);
                        }
                        if (u.pm == 3) {
                            const int b = c0 >> 12, p0 = c0 & (SEQ - 1), mm0 = p0 >> 2;
                            bf16_t* q = rowp + b * SEQ + mm0;
#pragma unroll
                            for (int c = 0; c < 4; ++c) *(GAS unsigned*)(q + c * 1024) = pk2(v[c], v[c + 4]);
                        } else if (u.pm == 4) {
                            const int b = c0 >> 12, p0 = c0 & (SEQ - 1), mm = p0 >> 4, cc0 = p0 & 15;
                            bf16_t* q = rowp + b * SEQ + cc0 * 256 + mm;
#pragma unroll
                            for (int j = 0; j < 8; ++j) ((GAS bf16_t*)q)[j * 256] = (bf16_t)(pk2(v[j], 0.f) & 0xffffu);
                        } else store8(rowp + c0, v);
                    }
                    asm volatile("" ::: "memory");
                }
        } else if (kind == 2) {
            const int br = u.pn;
            const bf16_t* VT = (const bf16_t*)(ws + WS_VT);
            const float* LSE = (const float*)(ws + WS_LSE);
#pragma unroll
            for (int ai = 0; ai < 2; ++ai)
#pragma unroll
                for (int m = 0; m < 4; ++m) {
                    const int tok = u.pm * 256 + ai * 128 + wr * 64 + m * 16 + fr;
#pragma unroll
                    for (int bj = 0; bj < 2; ++bj) {
                        const int cb = bj * 128 + wc * 32 + 8 * fq, head = cb >> 6;
                        const a4 v0 = acc[ai][bj][m][0], v1 = acc[ai][bj][m][1];
                        float gt[8] = {v0[0], v0[1], v0[2], v0[3], v1[0], v1[1], v1[2], v1[3]};
                        const size_t off = (size_t)tok * 256 + cb;
                        float o[8];
                        bf16_t* dst;
                        if (br == 0) { dst = slot_ptr(ws, SL_QA) + off; load8(dst, o); }
                        else if (br == 2) { dst = slot_ptr(ws, SL_QC) + off; load8(dst, o); }
                        else if (br == 1) {
                            dst = slot_ptr(ws, SL_QB) + off;
                            float oc[8], os[8], ow[8]; load8(dst, oc); load8(slot_ptr(ws, SL_OSLC) + off, os); load8(slot_ptr(ws, SL_OWIN) + off, ow);
                            const GAS bf16_t* VTg = (const GAS bf16_t*)VT; const float g0 = bf1(VTg[(size_t)(1408 + head) * T + tok]), g1 = bf1(VTg[(size_t)(1412 + head) * T + tok]), g2 = bf1(VTg[(size_t)(1416 + head) * T + tok]);
#pragma unroll
                            for (int j = 0; j < 8; ++j) o[j] = g0 * oc[j] + g1 * os[j] + g2 * ow[j];
                        } else {
                            dst = slot_ptr(ws, SL_QD0) + off;
                            float o0[8], o1[8], o2[8]; load8(dst, o0); load8(slot_ptr(ws, SL_QD1) + off, o1); load8(slot_ptr(ws, SL_QD2) + off, o2);
                            const GAS float* LSEg = (const GAS float*)LSE; const float l0 = LSEg[((size_t)0 * T + tok) * 4 + head], l1 = LSEg[((size_t)1 * T + tok) * 4 + head], l2 = LSEg[((size_t)2 * T + tok) * 4 + head];
                            const float mx = fmaxf(l0, fmaxf(l1, l2));
                            const float e0 = fexp2((l0 - mx) * LOG2E), e1 = fexp2((l1 - mx) * LOG2E), e2 = fexp2((l2 - mx) * LOG2E);
                            const float inv = frcp(e0 + e1 + e2);
#pragma unroll
                            for (int j = 0; j < 8; ++j) o[j] = (e0 * o0[j] + e1 * o1[j] + e2 * o2[j]) * inv;
                        }
#pragma unroll
                        for (int j = 0; j < 8; ++j) o[j] *= gt[j] * sigmoidf_(gt[j]);
                        store8(dst, o);
                        asm volatile("" ::: "memory");
                    }
                }
        } else {
            bf16_t* U = (bf16_t*)(ws + WS_U); bf16_t* Y = (bf16_t*)(ws + WS_Y);
#pragma unroll
            for (int ai = 0; ai < 2; ++ai)
#pragma unroll
                for (int m = 0; m < 4; ++m) {
                    const int tok = u.pm * 256 + ai * 128 + wr * 64 + m * 16 + fr;
#pragma unroll
                    for (int bj = 0; bj < 2; ++bj) {
                        const int col = u.pn * 256 + bj * 128 + wc * 32 + 8 * fq;
                        const a4 v0 = acc[ai][bj][m][0], v1 = acc[ai][bj][m][1];
                        float v[8] = {v0[0], v0[1], v0[2], v0[3], v1[0], v1[1], v1[2], v1[3]};
                        const size_t off = (size_t)tok * D + col;
                        if (kind == 3) store8(U + off, v);
                        else if (kind == 4) {
                            float uu[8]; load8(U + off, uu);
                            float y[8];
                            if (first) {
#pragma unroll
                                for (int j = 0; j < 8; ++j) y[j] = sigmoidf_(v[j]) * uu[j];
                            } else {
                                load8(Y + off, y);
#pragma unroll
                                for (int j = 0; j < 8; ++j) y[j] += sigmoidf_(v[j]) * uu[j];
                            }
                            store8(Y + off, y);
                        } else {
                            const f32x4 x0 = *(const GAS f32x4*)(xin + off), x1 = *(const GAS f32x4*)(xin + off + 4);
                            *(GAS f32x4*)(xout + off) = (f32x4){x0[0] + v[0], x0[1] + v[1], x0[2] + v[2], x0[3] + v[3]};
                            *(GAS f32x4*)(xout + off + 4) = (f32x4){x1[0] + v[4], x1[1] + v[5], x1[2] + v[6], x1[3] + v[7]};
                        }
                        asm volatile("" ::: "memory");
                    }
                }
        }
    }
};

DI void transpose_item(const float* W, int K, int N, bf16_t* WT, int k0, int n0, int sc, LAS float* scr, int lane) {
    const int sc4 = __shfl(sc, 4 * (lane & 7));
#pragma unroll
    for (int i = 0; i < 8; ++i) {
        const int kk = 8 * i + (lane >> 3);
        const f32x4 w = sc4 >= 0 ? *(const GAS f32x4*)(W + (size_t)(k0 + kk) * N + sc4) : (f32x4){0.f, 0.f, 0.f, 0.f};
        LAS float* d = scr + kk * 33 + 4 * (lane & 7);
        d[0] = w.x; d[1] = w.y; d[2] = w.z; d[3] = w.w;
    }
    asm volatile("s_waitcnt lgkmcnt(0)" ::: "memory");
    const int c = lane & 7;
#pragma unroll
    for (int j = 0; j < 4; ++j) { const int n = (lane >> 3) + 8 * j; const LAS float* s = scr + (8 * c) * 33 + n;
        u32x4 o; o.x = pk2(s[0 * 33], s[1 * 33]); o.y = pk2(s[2 * 33], s[3 * 33]); o.z = pk2(s[4 * 33], s[5 * 33]); o.w = pk2(s[6 * 33], s[7 * 33]);
        *(GAS u32x4*)(WT + (size_t)(n0 + n) * K + k0 + 8 * c) = o; }
    asm volatile("s_waitcnt lgkmcnt(0)" ::: "memory");
}
DI int src_qk(int n) {
    const int tile = n >> 8, hs = (n >> 6) & 3, g = (n >> 3) & 7, e = n & 7, d = 4 * g + (e & 3) + 32 * (e >> 2);
    int base;
    switch (tile) {
        case 0: base = A_Q + 64 * hs; break; case 1: base = A_K + 64 * hs; break; case 2: base = B_Q + 64 * hs; break;
        case 3: base = hs == 0 ? B_KC : hs == 1 ? B_VC : hs == 2 ? B_KS : B_KW; break;
        case 4: base = C_Q + 64 * hs; break; case 5: base = C_K + 64 * hs; break;
        case 6: case 7: case 8: base = D_Q + 256 * (tile - 6) + 64 * hs; break;
        default: base = D_K + 256 * (tile - 9) + 64 * hs; break;
    }
    return base + d;
}
DI int src_v(int n) {
    const int slot = n >> 6, d = n & 63;
    if (slot < 4) return A_V + 64 * slot + d;
    if (slot < 8) return C_V + 64 * (slot - 4) + d;
    if (slot < 20) return D_V + 64 * (slot - 8) + d;
    if (slot == 20) return B_VS + d;
    if (slot == 21) return B_VW + d;
    if (slot == 22 && d < 12) return B_NG + d;
    return -1;
}
DI int src_g(int n) { const int br = n >> 8, c = n & 255; return (br == 0 ? A_G : br == 1 ? B_G : br == 2 ? C_G : D_G) + c; }

DI const bf16_t* launder_vp(const bf16_t* p) { asm volatile("" : "+v"(p)); return p; }
DI int kappa(int rho) { return (rho & 16) | ((rho & 4) << 1) | ((rho & 8) >> 1) | (rho & 3); }
DI bf16x8 ldfrag(const bf16_t* p) { return *(const GAS bf16x8*)p; }
DI bf16x8 pack8(const float* p) { u32x4 w; w.x = pk2(p[0], p[1]); w.y = pk2(p[2], p[3]); w.z = pk2(p[4], p[5]); w.w = pk2(p[6], p[7]); return __builtin_bit_cast(bf16x8, w); }

#define BLK_BAR() do { asm volatile("s_waitcnt lgkmcnt(0)" ::: "memory"); __builtin_amdgcn_s_barrier(); asm volatile("" ::: "memory"); } while (0)
struct SmState { f32x16 O[2]; float m, l; };
DI void sm_init(SmState& st) {
#pragma unroll
    for (int i = 0; i < 16; ++i) { st.O[0][i] = 0.f; st.O[1][i] = 0.f; }
    st.m = MFLOOR; st.l = 0.f;
}
struct Frag { bf16x8 k[4], v[2][2]; };
DI void ld_frag(Frag& f, const bf16_t* kp, const bf16_t* v0p, const bf16_t* v1p) {
#pragma unroll
    for (int s = 0; s < 4; ++s) f.k[s] = ldfrag(kp + 16 * s);
#pragma unroll
    for (int s = 0; s < 2; ++s) { f.v[0][s] = ldfrag(v0p + 16 * s); f.v[1][s] = ldfrag(v1p + 16 * s); }
}
struct FragG { u32x4 k[4], v[4]; };
constexpr int WLDS_BYTES = 4608 + 5120;
DI void ldg(FragG& g, const bf16_t* kq, size_t kstride, const bf16_t* vq, size_t vstride) {
#pragma unroll
    for (int j = 0; j < 4; ++j) g.k[j] = *(const GAS u32x4*)(kq + (size_t)(8 * j) * kstride);
#pragma unroll
    for (int j = 0; j < 4; ++j) g.v[j] = *(const GAS u32x4*)(vq + (size_t)(16 * j) * vstride);
}
DI void stage(const FragG& g, Frag& f, LAS unsigned char* wl, int lane) {
    const int r = lane & 31, h = lane >> 5;
    LAS u32x4* kw = (LAS u32x4*)(wl + (lane >> 3) * 144 + (lane & 7) * 16);
    LAS u32x4* vw = (LAS u32x4*)(wl + 4608 + (lane >> 2) * 80 + (lane & 3) * 16);
#pragma unroll
    for (int j = 0; j < 4; ++j) kw[j * 72] = g.k[j];
#pragma unroll
    for (int j = 0; j < 4; ++j) vw[j * 80] = g.v[j];
    asm volatile("" ::: "memory");
    const LAS unsigned char* kr = wl + kappa(r) * 144 + 16 * h;
    const LAS unsigned char* vr = wl + 4608 + r * 80 + 16 * h;
#pragma unroll
    for (int s = 0; s < 4; ++s) f.k[s] = *(const LAS bf16x8*)(kr + 32 * s);
#pragma unroll
    for (int s = 0; s < 2; ++s) { f.v[0][s] = *(const LAS bf16x8*)(vr + 32 * s); f.v[1][s] = *(const LAS bf16x8*)(vr + 32 * 80 + 32 * s); }
    asm volatile("" ::: "memory");
}
template <int MASK>
DI void sm_compute(SmState& st, const bf16x8 (&qf)[4], const Frag& f, int key0, bool allow, int klo, int khi) {
    f32x16 S;
#pragma unroll
    for (int i = 0; i < 16; ++i) S[i] = 0.f;
#pragma unroll
    for (int s = 0; s < 4; ++s) S = MFMA32(f.k[s], qf[s], S);
    const float neg = NEG, mfl = MFLOOR;
    float p[16]; float mx = mfl;
#pragma unroll
    for (int i = 0; i < 16; ++i) {
        float v = S[i];
        if (MASK == 2) { const int key = key0 + 16 * (i >> 3) + (i & 7); v = (allow && key >= klo && key <= khi) ? v : neg; }
        p[i] = v; mx = fmaxf(mx, v);
    }
    if (MASK == 1) mx = allow ? mx : mfl;
    mx = hmaxf_(mx);
    const float mn = fmaxf(st.m, mx), mc = mn * SM_C;
    const float mcl = (MASK == 1 && !allow) ? sconst(INFINITY) : mc;
    const f32x2 c2 = {SM_C, SM_C}, m2 = {mcl, mcl};
    f32x2 rs2 = {0.f, 0.f};
#pragma unroll
    for (int k = 0; k < 8; ++k) {
        const f32x2 x = (f32x2){p[2 * k], p[2 * k + 1]} * c2 - m2;
        const f32x2 e = {fexp2(x.x), fexp2(x.y)};
        p[2 * k] = e.x; p[2 * k + 1] = e.y; rs2 += e;
    }
    const float rs = rs2.x + rs2.y;
    if (__ballot(mn != st.m) != 0ull) {
        const float alpha = fexp2((st.m - mn) * SM_C);
        st.l *= alpha;
#pragma unroll
        for (int i = 0; i < 16; ++i) { st.O[0][i] *= alpha; st.O[1][i] *= alpha; }
    }
    st.l += rs; st.m = mn;
    const bf16x8 pf0 = pack8(p), pf1 = pack8(p + 8);
    st.O[0] = MFMA32(f.v[0][0], pf0, st.O[0]); st.O[0] = MFMA32(f.v[0][1], pf1, st.O[0]);
    st.O[1] = MFMA32(f.v[1][0], pf0, st.O[1]); st.O[1] = MFMA32(f.v[1][1], pf1, st.O[1]);
}
DI void write_o(bf16_t* orow, const f32x16 (&O)[2], float inv, int h) {
#pragma unroll
    for (int dt = 0; dt < 2; ++dt)
#pragma unroll
        for (int g = 0; g < 4; ++g) store4(orow + 32 * dt + 8 * g + 4 * h, O[dt][4 * g] * inv, O[dt][4 * g + 1] * inv, O[dt][4 * g + 2] * inv, O[dt][4 * g + 3] * inv);
}
DI void load_q(bf16x8 (&qf)[4], const bf16_t* qrow, int h) {
#pragma unroll
    for (int s = 0; s < 4; ++s) qf[s] = ldfrag(qrow + 16 * s + 8 * h);
}

struct SmTask { const bf16_t* qrow; const bf16_t* kb; const bf16_t* vb0; bf16_t* orow; float* lse; size_t kstride; int ti_lo, ti_hi, ti_edge, bshift, klo, khi; unsigned long long need, full, allow; };
DI int sm_next(int ti, int ti_hi, int bshift, unsigned long long need) {
    int nt = ti + 1;
    while (nt <= ti_hi) { if ((need >> (nt >> bshift)) & 1ull) return nt; nt = ((nt >> bshift) + 1) << bshift; }
    return -1;
}
DI void sm_step(SmState& st, const bf16x8 (&qf)[4], const Frag& f, const SmTask& tk, int ti, int h) {
    const int blk = ti >> tk.bshift;
    const bool allow = (tk.allow >> blk) & 1ull;
    if ((ti == tk.ti_hi) || (ti == tk.ti_edge)) sm_compute<2>(st, qf, f, 32 * ti + 8 * h, allow, tk.klo, tk.khi);
    else if (!((tk.full >> blk) & 1ull)) sm_compute<1>(st, qf, f, 32 * ti + 8 * h, allow, 0, 0);
    else sm_compute<0>(st, qf, f, 32 * ti + 8 * h, true, 0, 0);
}
DI void run_sm(const SmTask& tk, int lane, LAS unsigned char* wl) {
    const int h = lane >> 5;
    bf16x8 qf[4]; load_q(qf, tk.qrow, h);
    SmState st; sm_init(st);
    int ti = sm_next(tk.ti_lo - 1, tk.ti_hi, tk.bshift, tk.need);
    FragG GA, GB; Frag F;
    ldg(GA, tk.kb + (size_t)(32 * ti) * tk.kstride, tk.kstride, tk.vb0 + 32 * ti, T);
    for (;;) {
        int nt = sm_next(ti, tk.ti_hi, tk.bshift, tk.need); int lt = nt >= 0 ? nt : ti;
        ldg(GB, tk.kb + (size_t)(32 * lt) * tk.kstride, tk.kstride, tk.vb0 + 32 * lt, T);
        __builtin_amdgcn_sched_barrier(0);
        stage(GA, F, wl, lane);
        sm_step(st, qf, F, tk, ti, h);
        if (nt < 0) break;
        ti = nt;
        nt = sm_next(ti, tk.ti_hi, tk.bshift, tk.need); lt = nt >= 0 ? nt : ti;
        ldg(GA, tk.kb + (size_t)(32 * lt) * tk.kstride, tk.kstride, tk.vb0 + 32 * lt, T);
        __builtin_amdgcn_sched_barrier(0);
        stage(GB, F, wl, lane);
        sm_step(st, qf, F, tk, ti, h);
        if (nt < 0) break;
        ti = nt;
    }
    const float lt_ = hsumf_(st.l);
    write_o(tk.orow, st.O, frcp(lt_), h);
    if (tk.lse != nullptr && h == 0) *(GAS float*)tk.lse = st.m * SM_SCALE + flog2(lt_) * LN2;
}
DI unsigned long long bits_any(unsigned long long m, int n) {
    unsigned long long r = 0ull;
    for (int j = 0; j < n; ++j) if (__ballot((m >> j) & 1ull) != 0ull) r |= 1ull << j;
    return r;
}
DI unsigned long long bits_all(unsigned long long m, int n) {
    unsigned long long r = 0ull;
    for (int j = 0; j < n; ++j) if (__ballot((m >> j) & 1ull) == ~0ull) r |= 1ull << j;
    return r;
}
DI void task_sm(unsigned char* ws, int kind, int b, int hh, int qt, int lane, LAS unsigned char* wl) {
    const int r = lane & 31, kr = lane >> 3, kc = 8 * (lane & 7), vd = lane >> 2, vc = 8 * (lane & 3);
    const bf16_t* VT = (const bf16_t*)(ws + WS_VT);
    SmTask tk;
    tk.lse = nullptr; tk.kstride = 256; tk.ti_edge = -1; tk.klo = -1; tk.ti_lo = 0;
    if (kind <= 2) {
        const int t0 = 32 * qt, t = t0 + r; const size_t row = (size_t)(b * SEQ + t) * 256 + hh * 64;
        tk.ti_hi = qt; tk.khi = t;
        if (kind == 0) {
            const int cb = t0 >> 8;
            const unsigned long long mask = ((const GAS unsigned*)(ws + WS_MMASK))[(b * 4 + hh) * SEQ + t];
            tk.qrow = slot_ptr(ws, SL_QA) + row; tk.orow = slot_ptr(ws, SL_QA) + row;
            tk.kb = slot_ptr(ws, SL_KA) + (size_t)(b * SEQ + kr) * 256 + hh * 64 + kc;
            tk.vb0 = VT + (size_t)(hh * 64 + vd) * T + b * SEQ + vc;
            tk.bshift = 3; tk.allow = mask; tk.need = bits_any(mask, cb + 1); tk.full = bits_all(mask, cb + 1);
        } else if (kind == 1) {
            const int cur = t0 >> 6;
            const unsigned long long mask = ((const GAS unsigned long long*)(ws + WS_NMASK))[b * SEQ + t];
            tk.qrow = slot_ptr(ws, SL_QBR) + row; tk.orow = slot_ptr(ws, SL_OSLC) + row;
            tk.kb = slot_ptr(ws, SL_KB4) + (size_t)(b * SEQ + kr) * 256 + 128 + kc;
            tk.vb0 = VT + (size_t)(1280 + vd) * T + b * SEQ + vc;
            tk.bshift = 1; tk.allow = mask; tk.need = bits_any(mask, cur + 1); tk.full = bits_all(mask, cur + 1);
        } else {
            tk.qrow = slot_ptr(ws, SL_QBR) + row; tk.orow = slot_ptr(ws, SL_OWIN) + row;
            tk.kb = slot_ptr(ws, SL_KB4) + (size_t)(b * SEQ + kr) * 256 + 192 + kc;
            tk.vb0 = VT + (size_t)(1344 + vd) * T + b * SEQ + vc;
            tk.bshift = 8; tk.allow = 1ull; tk.need = 1ull; tk.full = 1ull;
            tk.ti_lo = qt - 16 < 0 ? 0 : qt - 16; tk.ti_edge = qt - 16; tk.klo = t - 511;
        }
    } else {
        const int g = kind - 3, dil = g == 0 ? 1 : g == 1 ? 4 : 16, L = SEQ / dil, nsub = 128 / dil, c = qt / nsub, sq = qt - c * nsub;
        const int mq = 32 * sq + r, tok = b * SEQ + mq * dil + c;
        bf16_t* qr = slot_ptr(ws, g == 0 ? SL_QD0 : g == 1 ? SL_QD1 : SL_QD2) + (size_t)tok * 256 + hh * 64;
        tk.qrow = qr; tk.orow = qr; tk.kstride = (size_t)256 * dil;
        tk.kb = slot_ptr(ws, SL_KD0 + g) + (size_t)(b * SEQ + c) * 256 + (size_t)kr * tk.kstride + hh * 64 + kc;
        tk.vb0 = VT + (size_t)(512 + 256 * g + hh * 64 + vd) * T + b * SEQ + (g == 0 ? 0 : c * L) + vc;
        tk.lse = (float*)(ws + WS_LSE) + ((size_t)g * T + tok) * 4 + hh;
        tk.bshift = 8; tk.allow = 1ull; tk.need = 1ull; tk.full = 1ull;
        tk.ti_hi = sq; tk.ti_lo = sq - 4 < 0 ? 0 : sq - 4; tk.ti_edge = sq - 4; tk.klo = mq - 128; tk.khi = mq;
    }
    run_sm(tk, lane, wl);
}

DI void frag_from_image(Frag& f, const LAS unsigned char* img, int lane) {
    const int r = lane & 31, h = lane >> 5;
    const LAS unsigned char* kr = img + kappa(r) * 144 + 16 * h;
    const LAS unsigned char* vr = img + 4608 + r * 80 + 16 * h;
#pragma unroll
    for (int s = 0; s < 4; ++s) f.k[s] = *(const LAS bf16x8*)(kr + 32 * s);
#pragma unroll
    for (int s = 0; s < 2; ++s) { f.v[0][s] = *(const LAS bf16x8*)(vr + 32 * s); f.v[1][s] = *(const LAS bf16x8*)(vr + 32 * 80 + 32 * s); }
}
DI void run_heavy_group(unsigned char* ws, int kind, int b, int hh_in, int qg, int wave, int lane, int tid, LAS unsigned char* img) {
    const int r = lane & 31, h = lane >> 5;
    const int hh = kind == 2 ? (wave & 3) : hh_in, qt = kind == 2 ? 2 * qg + (wave >> 2) : 8 * qg + wave, t0 = 32 * qt, t = t0 + r;
    const int tend = kind == 2 ? 2 * qg + 1 : 8 * qg + 7, tbeg = kind == 2 ? (2 * qg - 16 < 0 ? 0 : 2 * qg - 16) : 0;
    const size_t row = (size_t)(b * SEQ + t) * 256 + hh * 64;
    SmTask tk; tk.lse = nullptr; tk.kstride = 256; tk.ti_edge = -1; tk.klo = -1; tk.ti_lo = 0; tk.ti_hi = qt; tk.khi = t; tk.kb = nullptr; tk.vb0 = nullptr;
    const bf16_t* gp; size_t gstep; int woff;
    if (kind == 0) {
        const int cb = t0 >> 8;
        const unsigned long long mask = ((const GAS unsigned*)(ws + WS_MMASK))[(b * 4 + hh) * SEQ + t];
        tk.qrow = slot_ptr(ws, SL_QA) + row; tk.orow = slot_ptr(ws, SL_QA) + row;
        tk.bshift = 3; tk.allow = mask; tk.need = bits_any(mask, cb + 1); tk.full = bits_all(mask, cb + 1);
        if (tid < 256) { gp = slot_ptr(ws, SL_KA) + (size_t)(b * SEQ + (tid >> 3)) * 256 + hh * 64 + 8 * (tid & 7); gstep = (size_t)32 * 256; woff = (tid >> 3) * 144 + (tid & 7) * 16; }
        else { const int t2 = tid - 256; gp = (const bf16_t*)(ws + WS_VT) + (size_t)(hh * 64 + (t2 >> 2)) * T + b * SEQ + 8 * (t2 & 3); gstep = 32; woff = 4608 + (t2 >> 2) * 80 + (t2 & 3) * 16; }
    } else {
        if (kind == 1) {
            const int cur = t0 >> 6;
            const unsigned long long mask = ((const GAS unsigned long long*)(ws + WS_NMASK))[b * SEQ + t];
            tk.qrow = slot_ptr(ws, SL_QBR) + row; tk.orow = slot_ptr(ws, SL_OSLC) + row;
            tk.bshift = 1; tk.allow = mask; tk.need = bits_any(mask, cur + 1); tk.full = bits_all(mask, cur + 1);
        } else {
            tk.qrow = slot_ptr(ws, SL_QBR) + row; tk.orow = slot_ptr(ws, SL_OWIN) + row;
            tk.bshift = 8; tk.allow = 1ull; tk.need = 1ull; tk.full = 1ull;
            tk.ti_lo = qt - 16 < 0 ? 0 : qt - 16; tk.ti_edge = qt - 16; tk.klo = t - 511;
        }
        const int koff = kind == 1 ? 128 : 192, vrow = kind == 1 ? 1280 : 1344;
        if (tid < 256) { gp = slot_ptr(ws, SL_KB4) + (size_t)(b * SEQ + (tid >> 3)) * 256 + koff + 8 * (tid & 7); gstep = (size_t)32 * 256; woff = (tid >> 3) * 144 + (tid & 7) * 16; }
        else { const int t2 = tid - 256; gp = (const bf16_t*)(ws + WS_VT) + (size_t)(vrow + (t2 >> 2)) * T + b * SEQ + 8 * (t2 & 3); gstep = 32; woff = 4608 + (t2 >> 2) * 80 + (t2 & 3) * 16; }
    }
    bf16x8 qf[4]; load_q(qf, tk.qrow, h);
    SmState st; sm_init(st);
    LAS unsigned char* img0 = img; LAS unsigned char* img1 = img + WLDS_BYTES;
    int ti = tbeg;
    u32x4 r0 = *(const GAS u32x4*)(gp + gstep * (size_t)ti);
    u32x4 r1 = *(const GAS u32x4*)(gp + gstep * (size_t)(ti + 1 > tend ? tend : ti + 1));
    *(LAS u32x4*)(img0 + woff) = r0;
    r0 = *(const GAS u32x4*)(gp + gstep * (size_t)(ti + 2 > tend ? tend : ti + 2));
    BLK_BAR();
    Frag F;
    for (;;) {
        if (ti >= tk.ti_lo && ti <= tk.ti_hi && ((tk.need >> (ti >> tk.bshift)) & 1ull)) { frag_from_image(F, img0, lane); sm_step(st, qf, F, tk, ti, h); }
        if (ti == tend) break;
        *(LAS u32x4*)(img1 + woff) = r1;
        r1 = *(const GAS u32x4*)(gp + gstep * (size_t)(ti + 3 > tend ? tend : ti + 3));
        BLK_BAR(); ++ti;
        if (ti >= tk.ti_lo && ti <= tk.ti_hi && ((tk.need >> (ti >> tk.bshift)) & 1ull)) { frag_from_image(F, img1, lane); sm_step(st, qf, F, tk, ti, h); }
        if (ti == tend) break;
        *(LAS u32x4*)(img0 + woff) = r0;
        r0 = *(const GAS u32x4*)(gp + gstep * (size_t)(ti + 3 > tend ? tend : ti + 3));
        BLK_BAR(); ++ti;
    }
    const float lt_ = hsumf_(st.l);
    write_o(tk.orow, st.O, frcp(lt_), h);
}

DI void stick_compute(f32x16 (&O)[2], float& carry, const bf16x8 (&qf)[4], const Frag& f, int kt0, int t, int h) {
    f32x16 S;
#pragma unroll
    for (int i = 0; i < 16; ++i) S[i] = 0.f;
#pragma unroll
    for (int s = 0; s < 4; ++s) S = MFMA32(f.k[s], qf[s], S);
    float lsm[16], ls[16]; float sA = 0.f, sB = 0.f;
    const int key0 = kt0 + 8 * h; const float neg = NEG;
#pragma unroll
    for (int i = 0; i < 16; ++i) {
        const int key = key0 + 16 * (i >> 3) + (i & 7);
        const bool valid = key < t;
        const float z = S[i] * SM_SCALE;
        const float sp = fmaxf(z, 0.f) + flog2(1.f + fexp2(-fabsf(z) * LOG2E)) * LN2;
        lsm[i] = valid ? -sp : 0.f;
        ls[i] = valid ? z - sp : neg;
        if (i < 8) sA += lsm[i]; else sB += lsm[i];
    }
    const float pA = xhalf(sA), pB = xhalf(sB);
    const float baseB = carry + (h == 0 ? pB : 0.f), baseA = carry + sB + pB + (h == 0 ? pA : 0.f);
    float p[16]; float run = baseA;
#pragma unroll
    for (int e = 7; e >= 0; --e) { p[e] = fexp2((ls[e] + run) * LOG2E); run += lsm[e]; }
    run = baseB;
#pragma unroll
    for (int e = 15; e >= 8; --e) { p[e] = fexp2((ls[e] + run) * LOG2E); run += lsm[e]; }
    carry += (sA + sB) + (pA + pB);
    const bf16x8 pf0 = pack8(p), pf1 = pack8(p + 8);
    O[0] = MFMA32(f.v[0][0], pf0, O[0]); O[0] = MFMA32(f.v[0][1], pf1, O[0]);
    O[1] = MFMA32(f.v[1][0], pf0, O[1]); O[1] = MFMA32(f.v[1][1], pf1, O[1]);
}
DI void task_stick(unsigned char* ws, int b, int hh, int qt, int lane, LAS unsigned char* wl) {
    const int r = lane & 31, h = lane >> 5, t0 = 32 * qt, t = t0 + r;
    bf16_t* qrow = slot_ptr(ws, SL_QC) + (size_t)(b * SEQ + t) * 256 + hh * 64;
    bf16x8 qf[4]; load_q(qf, qrow, h);
    const bf16_t* kb = slot_ptr(ws, SL_KC) + (size_t)(b * SEQ + (lane >> 3)) * 256 + hh * 64 + 8 * (lane & 7);
    const bf16_t* vb0 = (const bf16_t*)(ws + WS_VT) + (size_t)(256 + hh * 64 + (lane >> 2)) * T + b * SEQ + 8 * (lane & 3);
    f32x16 O[2];
#pragma unroll
    for (int i = 0; i < 16; ++i) { O[0][i] = 0.f; O[1][i] = 0.f; }
    float carry = 0.f;
    int kt0 = t0;
    FragG GA, GB; Frag F;
    ldg(GA, kb + (size_t)kt0 * 256, 256, vb0 + kt0, T);
    for (;;) {
        int nk = kt0 - 32, lk = nk >= 0 ? nk : kt0;
        ldg(GB, kb + (size_t)lk * 256, 256, vb0 + lk, T);
        __builtin_amdgcn_sched_barrier(0);
        stage(GA, F, wl, lane);
        stick_compute(O, carry, qf, F, kt0, t, h);
        if (nk < 0 || __ballot(carry > -104.f) == 0ull) break;
        kt0 = nk; nk = kt0 - 32; lk = nk >= 0 ? nk : kt0;
        ldg(GA, kb + (size_t)lk * 256, 256, vb0 + lk, T);
        __builtin_amdgcn_sched_barrier(0);
        stage(GB, F, wl, lane);
        stick_compute(O, carry, qf, F, kt0, t, h);
        if (nk < 0 || __ballot(carry > -104.f) == 0ull) break;
        kt0 = nk;
    }
    write_o(qrow, O, 1.f, h);
}

DI void task_cmp(unsigned char* ws, int b, int qt, int lane, LAS float* imp, int hh0, int nh, bool leader) {
    const int r = lane & 31, h = lane >> 5, t0 = 32 * qt, t = t0 + r, cur = t0 >> 6;
    const int nvis = t >= 31 ? ((t - 31) >> 4) + 1 : 0;
    const int nvmax = (t0 >> 4) + 1, ntile = (nvmax + 31) >> 5;
    const bool need_imp = cur >= 16;
    if (leader) { for (int i = lane; i < 32 * 65; i += 64) imp[i] = 0.f; }
    BLK_BAR();
    const bf16_t* kb_ = (const bf16_t*)(ws + WS_KCMP) + (size_t)(b * 256 + kappa(r)) * 64 + 8 * h;
    const bf16_t* vb0_ = (const bf16_t*)(ws + WS_VCMPT) + (size_t)(b * 64 + r) * 256 + 8 * h;
    for (int hh = hh0; hh < hh0 + nh; ++hh) {
        const bf16_t* kb = launder_vp(kb_); const bf16_t* vb0 = launder_vp(vb0_); const bf16_t* vb1 = vb0 + 32 * 256;
        bf16_t* qrow = slot_ptr(ws, SL_QB) + (size_t)(b * SEQ + t) * 256 + hh * 64;
        bf16x8 qf[4]; load_q(qf, qrow, h);
        float m = MFLOOR, l = 0.f;
        bf16x8 kn[4];
#pragma unroll
        for (int s = 0; s < 4; ++s) kn[s] = ldfrag(kb + 16 * s);
        for (int tl = 0; tl < ntile; ++tl) {
            bf16x8 kf[4];
#pragma unroll
            for (int s = 0; s < 4; ++s) kf[s] = kn[s];
            const int nl = tl + 1 < ntile ? tl + 1 : tl;
#pragma unroll
            for (int s = 0; s < 4; ++s) kn[s] = ldfrag(kb + (size_t)(32 * nl) * 64 + 16 * s);
            f32x16 S;
#pragma unroll
            for (int i = 0; i < 16; ++i) S[i] = 0.f;
#pragma unroll
            for (int s = 0; s < 4; ++s) S = MFMA32(kf[s], qf[s], S);
            const float neg = NEG; float mx = MFLOOR;
#pragma unroll
            for (int i = 0; i < 16; ++i) { const int key = 32 * tl + 8 * h + 16 * (i >> 3) + (i & 7); const float v = key < nvis ? S[i] : neg; S[i] = v; mx = fmaxf(mx, v); }
            mx = hmaxf_(mx);
            const float mn = fmaxf(m, mx), mc = mn * SM_C;
            float rs = 0.f;
#pragma unroll
            for (int i = 0; i < 16; ++i) rs += fexp2(S[i] * SM_C - mc);
            l = l * fexp2((m - mn) * SM_C) + rs; m = mn;
        }
        const float lt = hsumf_(l);
        const float inv = nvis > 0 ? frcp(lt) : 0.f, mc = m * SM_C;
        f32x16 O[2];
#pragma unroll
        for (int i = 0; i < 16; ++i) { O[0][i] = 0.f; O[1][i] = 0.f; }
        Frag fn; ld_frag(fn, kb, vb0, vb1);
        for (int tl = 0; tl < ntile; ++tl) {
            bf16x8 kf[4], vf[2][2];
#pragma unroll
            for (int s = 0; s < 4; ++s) kf[s] = fn.k[s];
#pragma unroll
            for (int s = 0; s < 2; ++s) { vf[0][s] = fn.v[0][s]; vf[1][s] = fn.v[1][s]; }
            const int nl = tl + 1 < ntile ? tl + 1 : tl;
            ld_frag(fn, kb + (size_t)(32 * nl) * 64, vb0 + 32 * nl, vb1 + 32 * nl);
            f32x16 S;
#pragma unroll
            for (int i = 0; i < 16; ++i) S[i] = 0.f;
#pragma unroll
            for (int s = 0; s < 4; ++s) S = MFMA32(kf[s], qf[s], S);
            float p[16];
#pragma unroll
            for (int i = 0; i < 16; ++i) { const int key = 32 * tl + 8 * h + 16 * (i >> 3) + (i & 7); p[i] = key < nvis ? fexp2(S[i] * SM_C - mc) * inv : 0.f; }
            if (need_imp) {
#pragma unroll
                for (int a = 0; a < 2; ++a) {
                    const int u = 4 * tl + 2 * a + h; const float* q = p + 8 * a;
                    LAS float* row = imp + r * 65 + 2 * u;
                    atomicAdd((float*)(row + 0), (q[0] + q[1]) + (q[2] + q[3]));
                    atomicAdd((float*)(row + 1), (q[3] + q[4]) + (q[5] + q[6]) + q[7]);
                    if (2 * u + 2 < 64) atomicAdd((float*)(row + 2), q[7]);
                }
            }
            const bf16x8 pf0 = pack8(p), pf1 = pack8(p + 8);
            O[0] = MFMA32(vf[0][0], pf0, O[0]); O[0] = MFMA32(vf[0][1], pf1, O[0]);
            O[1] = MFMA32(vf[1][0], pf0, O[1]); O[1] = MFMA32(vf[1][1], pf1, O[1]);
        }
        write_o(qrow, O, 1.f, h);
    }
    asm volatile("s_waitcnt lgkmcnt(0)" ::: "memory");
    BLK_BAR();
    if (leader) {
        unsigned long long mask;
        if (cur <= 15) mask = (2ull << cur) - 1ull;
        else {
            float v[32];
#pragma unroll
            for (int i = 0; i < 32; ++i) v[i] = imp[r * 65 + 2 * i + h];
            mask = 1ull | (1ull << cur) | (1ull << (cur - 1));
            for (int k = 0; k < 13; ++k) {
                float best = -1.f; int bj = 64;
#pragma unroll
                for (int i = 0; i < 32; ++i) { const int j = 2 * i + h; const bool ok = j >= 1 && j <= cur - 2 && !((mask >> j) & 1ull); if (ok && v[i] > best) { best = v[i]; bj = j; } }
                const float ob = xhalf(best); const int oj = __shfl_xor(bj, 32);
                if (ob > best || (ob == best && oj < bj)) { best = ob; bj = oj; }
                if (bj < 64) mask |= 1ull << bj;
            }
        }
        if (lane < 32) ((GAS unsigned long long*)(ws + WS_NMASK))[b * SEQ + t] = mask;
    }
    asm volatile("s_waitcnt lgkmcnt(0)" ::: "memory");
}

DI void task_moba_gate(unsigned char* ws, int b, int hh, int qt, int lane) {
    const int r = lane & 31, h = lane >> 5, t0 = 32 * qt, t = t0 + r, cb = t0 >> 8;
    unsigned sel = 0u;
    if (cb <= 3) sel = (1u << cb) - 1u;
    else {
        const bf16_t* qrow = slot_ptr(ws, SL_QA) + (size_t)(b * SEQ + t) * 256 + hh * 64 + 32 * h;
        float q[32];
#pragma unroll
        for (int j = 0; j < 4; ++j) { float f[8]; load8(qrow + 8 * j, f);
#pragma unroll
            for (int e = 0; e < 8; ++e) q[8 * j + e] = f[e]; }
        const GAS float* km = (const GAS float*)(ws + WS_KMEAN) + (size_t)((b * 4 + hh) * 16) * 64 + 32 * h;
        float gate[16];
#pragma unroll
        for (int n = 0; n < 16; ++n) {
            float s = 0.f;
            if (n < cb) {
#pragma unroll
                for (int d = 0; d < 32; ++d) s += q[d] * km[n * 64 + d];
            }
            s += xhalf(s);
            gate[n] = n < cb ? s : sconst(-INFINITY);
        }
#pragma unroll
        for (int k = 0; k < 3; ++k) {
            float best = sconst(-INFINITY); int bi = -1;
#pragma unroll
            for (int n = 0; n < 16; ++n) if (!((sel >> n) & 1u) && gate[n] > best) { best = gate[n]; bi = n; }
            if (bi >= 0) sel |= 1u << bi;
        }
    }
    if (lane < 32) ((GAS unsigned*)(ws + WS_MMASK))[(b * 4 + hh) * SEQ + t] = sel | (1u << cb);
}

DI void task_kmean(unsigned char* ws, int b, int hh, int blk, int lane) {
    const bf16_t* kp = slot_ptr(ws, SL_KA) + (size_t)(b * SEQ + 256 * blk + (lane >> 3)) * 256 + hh * 64 + 8 * (lane & 7);
    float s[8];
#pragma unroll
    for (int e = 0; e < 8; ++e) s[e] = 0.f;
#pragma unroll 8
    for (int i = 0; i < 32; ++i) { float f[8]; load8(kp + (size_t)(8 * i) * 256, f);
#pragma unroll
        for (int e = 0; e < 8; ++e) s[e] += f[e]; }
#pragma unroll
    for (int e = 0; e < 8; ++e) { s[e] += __shfl_xor(s[e], 8); s[e] += __shfl_xor(s[e], 16); s[e] += __shfl_xor(s[e], 32); }
    if (lane < 8) {
        GAS float* o = (GAS float*)(ws + WS_KMEAN) + ((b * 4 + hh) * 16 + blk) * 64 + 8 * lane;
#pragma unroll
        for (int e = 0; e < 8; ++e) o[e] = s[e] * (1.f / 256.f);
    }
}

DI void task_mlp_block(unsigned char* ws, int kv, int b, int rt, int wave, int lane, LAS float* part) {
    const int r = lane & 31, h = lane >> 5, n = 32 * rt + r, ne = n > 254 ? 254 : n;
    const bf16_t* xp = slot_ptr(ws, SL_KB4) + (size_t)(b * SEQ + 16 * ne) * 256 + kv * 64 + 8 * h;
    const bf16_t* w1 = (const bf16_t*)(ws + WS_W1T) + (size_t)(kv * 256 + 32 * wave + kappa(r)) * 2048 + 8 * h;
    f32x16 acc;
#pragma unroll
    for (int i = 0; i < 16; ++i) acc[i] = 0.f;
    bf16x8 xa[4], wa[4], xb[4], wb[4];
#pragma unroll
    for (int s = 0; s < 4; ++s) { xa[s] = ldfrag(xp + 16 * s); wa[s] = ldfrag(w1 + 16 * s); }
    for (int l = 0; l < 32; l += 2) {
#pragma unroll
        for (int s = 0; s < 4; ++s) { xb[s] = ldfrag(xp + (size_t)(l + 1) * 256 + 16 * s); wb[s] = ldfrag(w1 + 64 * (l + 1) + 16 * s); }
#pragma unroll
        for (int s = 0; s < 4; ++s) acc = MFMA32(wa[s], xa[s], acc);
        const int l2 = l + 2 < 32 ? l + 2 : l;
#pragma unroll
        for (int s = 0; s < 4; ++s) { xa[s] = ldfrag(xp + (size_t)l2 * 256 + 16 * s); wa[s] = ldfrag(w1 + 64 * l2 + 16 * s); }
#pragma unroll
        for (int s = 0; s < 4; ++s) acc = MFMA32(wb[s], xb[s], acc);
    }
    const GAS float* bias = (const GAS float*)(ws + WS_BIAS) + kv * 256 + 32 * wave;
    const bf16_t* w2 = (const bf16_t*)(ws + WS_W2T) + (size_t)(kv * 64 + r) * 256 + 32 * wave + 8 * h;
    float g[16];
#pragma unroll
    for (int i = 0; i < 16; ++i) {
        const float x = acc[i] + bias[16 * (i >> 3) + 8 * h + (i & 7)];
        const float y = 0.7978845608028654f * (x + 0.044715f * x * x * x);
        const float th = 1.f - 2.f * frcp(1.f + fexp2(2.f * LOG2E * y));
        g[i] = 0.5f * x * (1.f + th);
    }
    const bf16x8 pf0 = pack8(g), pf1 = pack8(g + 8);
    f32x16 out[2];
#pragma unroll
    for (int i = 0; i < 16; ++i) { out[0][i] = 0.f; out[1][i] = 0.f; }
#pragma unroll
    for (int dt = 0; dt < 2; ++dt) {
        out[dt] = MFMA32(ldfrag(w2 + (size_t)(32 * dt) * 256), pf0, out[dt]);
        out[dt] = MFMA32(ldfrag(w2 + (size_t)(32 * dt) * 256 + 16), pf1, out[dt]);
    }
#pragma unroll
    for (int dt = 0; dt < 2; ++dt)
#pragma unroll
        for (int i = 0; i < 16; ++i) part[((wave * 2 + dt) * 16 + i) * 64 + lane] = out[dt][i];
    __syncthreads();
    const int dt = wave >> 2, gq = wave & 3;
    float sum[4];
#pragma unroll
    for (int e = 0; e < 4; ++e) { float a = 0.f;
#pragma unroll
        for (int w = 0; w < 8; ++w) a += part[((w * 2 + dt) * 16 + 4 * gq + e) * 64 + lane];
        sum[e] = n <= 254 ? a : 0.f; }
    const int d0 = 32 * dt + 8 * gq + 4 * h;
    if (kv == 0) store4((bf16_t*)(ws + WS_KCMP) + (size_t)(b * 256 + n) * 64 + d0, sum[0], sum[1], sum[2], sum[3]);
    else {
        bf16_t* vt = (bf16_t*)(ws + WS_VCMPT) + (size_t)(b * 64 + d0) * 256 + n;
#pragma unroll
        for (int e = 0; e < 4; ++e) ((GAS bf16_t*)vt)[e * 256] = (bf16_t)(pk2(sum[e], 0.f) & 0xffffu);
    }
    __syncthreads();
}

struct Args { const float* in[9]; float* out; unsigned char* ws; int pad0, pad1; };

DI int launder(int x) { asm volatile("" : "+v"(x)); return x; }
DI unsigned char* launder_p(unsigned char* p) { asm volatile("" : "+s"(p)); return (unsigned char*)(__attribute__((address_space(1))) unsigned char*)p; }
#define FRESH() const int tid = launder(tid0), lane = tid & 63, gw = blockIdx.x * NWAVES + wave; (void)gw; (void)lane; unsigned char* ws = launder_p(ws0); (void)ws;
DI int next_task(unsigned* ctr, int lane) {
    int v = 0;
    if (lane == 0) v = (int)atomicAdd(ctr, 1u);
    return __builtin_amdgcn_readfirstlane(v);
}

#ifndef PROBE_A
#define PROBE_A 0
#define PROBE_B 0
#endif
enum { ST_P0 = 0, ST_BIAS, ST_G_QK, ST_G_VT, ST_P2, ST_P3, ST_P4, ST_G_GATE, ST_G_U0, ST_G_M0, ST_G_U1, ST_G_M1, ST_G_U2, ST_G_M2, ST_G_U3, ST_G_M3, ST_G_OUT, NSTEP_LAYER };

__global__ void __launch_bounds__(NWAVES * 64, 2) mega_fwd(Args a) {
    extern __shared__ __attribute__((aligned(16))) unsigned char lds_raw[];
    cg::grid_group grid = cg::this_grid();
    LAS unsigned char* lds = (LAS unsigned char*)lds_raw;
    const int tid0 = threadIdx.x, wave = __builtin_amdgcn_readfirstlane(tid0 >> 6);
    const int G = gridDim.x, NGW = G * NWAVES;
    unsigned char* ws0 = a.ws;

    if (blockIdx.x == 0) { for (int i = tid0; i < CTL_BYTES / 4; i += NWAVES * 64) ((GAS unsigned*)(ws0 + WS_CTL))[i] = 0u; }
    { FRESH();
    for (int e = blockIdx.x * (NWAVES * 64) + tid; e < SEQ * 32; e += G * NWAVES * 64) {
        const int pos = e >> 5, i = e & 31;
        const float inv = (float)exp2(-(double)i * (13.287712379549449 / 32.0));
        const float ang = (float)pos * inv;
        const double x = (double)ang, kq = rint(x * 0.6366197723675814);
        const double rr = (x - kq * 1.5707963267948966) - kq * 6.123233995736766e-17, r2 = rr * rr;
        const double sn = rr * (1.0 + r2 * (-1.0 / 6 + r2 * (1.0 / 120 + r2 * (-1.0 / 5040 + r2 * (1.0 / 362880 + r2 * (-1.0 / 39916800 + r2 * (1.0 / 6227020800.0)))))));
        const double cs = 1.0 + r2 * (-0.5 + r2 * (1.0 / 24 + r2 * (-1.0 / 720 + r2 * (1.0 / 40320 + r2 * (-1.0 / 3628800 + r2 * (1.0 / 479001600 + r2 * (-1.0 / 87178291200.0)))))));
        const int qd = (int)((long long)kq & 3);
        const double s_ = qd == 0 ? sn : qd == 1 ? cs : qd == 2 ? -sn : -cs, c_ = qd == 0 ? cs : qd == 1 ? -sn : qd == 2 ? -cs : sn;
        ((float*)(ws + WS_COS))[e] = (float)c_; ((float*)(ws + WS_SIN))[e] = (float)s_;
    } }

    for (int step = 0; step <= DEPTH * NSTEP_LAYER; ++step) {
        const int layer = step / NSTEP_LAYER, ls = step - layer * NSTEP_LAYER;
#if PROBE_A || PROBE_B
        if (blockIdx.x == 0 && tid0 == 0) ((unsigned long long*)(ws0 + WS_CTL + 2048))[32] = wall_clock64();
#endif
        if (layer == DEPTH) {
            FRESH(); const float* fw = a.in[8];
#if PROBE_A || PROBE_B
            float pa = 0.f, pb = 0.f;
            { const unsigned long long* tacc = (const unsigned long long*)(ws + WS_CTL + 2048);
              for (int k = 0; k < NSTEP_LAYER; ++k) { const float ms = (float)tacc[k] * 1e-5f; if ((PROBE_B >> k) & 1) pb += 0.002f * ms; } }
#endif
            for (int m = gw; m < T; m += 4 * NGW) {
                const GAS f32x4* wr4 = (const GAS f32x4*)fw + lane;
                f32x4 v[4][4]; float ss[4]; int mr[4];
#pragma unroll
                for (int q = 0; q < 4; ++q) { mr[q] = m + q * NGW < T ? m + q * NGW : m;
#pragma unroll
                    for (int j = 0; j < 4; ++j) v[q][j] = ((const GAS f32x4*)(a.out + (size_t)mr[q] * D) + lane)[64 * j]; }
                const float eps = sconst(1e-6f);
#pragma unroll
                for (int q = 0; q < 4; ++q) { float s = 0.f;
#pragma unroll
                    for (int j = 0; j < 4; ++j) s += (v[q][j].x * v[q][j].x + v[q][j].y * v[q][j].y) + (v[q][j].z * v[q][j].z + v[q][j].w * v[q][j].w);
                    ss[q] = rsqrtf(wave_sum(s) * (1.f / D) + eps); }
#pragma unroll
                for (int j = 0; j < 4; ++j) { const f32x4 w = wr4[64 * j];
#pragma unroll
                    for (int q = 0; q < 4; ++q) { f32x4 o = (f32x4){v[q][j].x * ss[q] * w.x, v[q][j].y * ss[q] * w.y, v[q][j].z * ss[q] * w.z, v[q][j].w * ss[q] * w.w};
#if PROBE_A || PROBE_B
                        o = o + ((lane & 1) ? pb : -pb); (void)pa;
#endif
                        if (q == 0 || mr[q] != m) ((GAS f32x4*)(a.out + (size_t)mr[q] * D) + lane)[64 * j] = o; } }
            }
            break;
        }
        const float* xin = layer == 0 ? a.in[0] : a.out;
        bool sync = false;
        if (ls == ST_P0) {
            const float* norm_w = a.in[1] + (size_t)layer * D;
            const float* w_in = a.in[2] + (size_t)layer * D * INW;
            const float* cmp_pos = a.in[3] + (size_t)layer * 2 * 2048;
            const float* cmp_w1 = a.in[4] + (size_t)layer * 2 * 2048 * 256;
            const float* cmp_w2 = a.in[5] + (size_t)layer * 2 * 256 * 64;
            const float* w_up = a.in[6] + (size_t)layer * 4 * 256 * D;
            const float* w_out = a.in[7] + (size_t)layer * D * D;
            FRESH(); LAS float* scr = (LAS float*)(lds + wave * 16384); bf16_t* Hb = (bf16_t*)(ws + WS_H);
            constexpr int I_QK = 16 * (NQK / 32), I_V = 16 * (NV / 32), I_G = 16 * 32, I_M = 16 * 128, I_UP = 4 * 4 * 32, I_OUT = 16 * 32, I_W1 = 2 * 32 * 8, I_W2 = 2 * 4 * 2;
            constexpr int NITEMS = I_QK + I_V + I_G + I_M + I_UP + I_OUT + I_W1 + I_W2;
            for (int it = gw; it < NITEMS; it += NGW) {
                int q = it;
                if (q < I_QK) { const int kb = q / (NQK / 32), nb = q % (NQK / 32); transpose_item(w_in, D, INW, (bf16_t*)(ws + WS_WQK), 64 * kb, 32 * nb, src_qk(32 * nb + (lane & 31)), scr, lane); continue; } q -= I_QK;
                if (q < I_V) { const int kb = q / (NV / 32), nb = q % (NV / 32); transpose_item(w_in, D, INW, (bf16_t*)(ws + WS_WV), 64 * kb, 32 * nb, src_v(32 * nb + (lane & 31)), scr, lane); continue; } q -= I_V;
                if (q < I_G) { const int kb = q / 32, nb = q % 32; transpose_item(w_in, D, INW, (bf16_t*)(ws + WS_WG), 64 * kb, 32 * nb, src_g(32 * nb + (lane & 31)), scr, lane); continue; } q -= I_G;
                if (q < I_M) { const int kb = q / 128, nb = q % 128; transpose_item(w_in, D, INW, (bf16_t*)(ws + WS_WM), 64 * kb, 32 * nb, MRG + 32 * nb + (lane & 31), scr, lane); continue; } q -= I_M;
                if (q < I_UP) { const int br = q / 128, q2 = q % 128, kb = q2 / 32, nb = q2 % 32; transpose_item(w_up + (size_t)br * 256 * D, 256, D, (bf16_t*)(ws + WS_WUP) + (size_t)br * D * 256, 64 * kb, 32 * nb, 32 * nb + (lane & 31), scr, lane); continue; } q -= I_UP;
                if (q < I_OUT) { const int kb = q / 32, nb = q % 32; transpose_item(w_out, D, D, (bf16_t*)(ws + WS_WOUT), 64 * kb, 32 * nb, 32 * nb + (lane & 31), scr, lane); continue; } q -= I_OUT;
                if (q < I_W1) { const int kv = q / 256, q2 = q % 256, kb = q2 / 8, nb = q2 % 8; transpose_item(cmp_w1 + (size_t)kv * 2048 * 256, 2048, 256, (bf16_t*)(ws + WS_W1T) + (size_t)kv * 256 * 2048, 64 * kb, 32 * nb, 32 * nb + (lane & 31), scr, lane); continue; } q -= I_W1;
                { const int kv = q / 8, q2 = q % 8, kb = q2 / 2, nb = q2 % 2; transpose_item(cmp_w2 + (size_t)kv * 256 * 64, 256, 64, (bf16_t*)(ws + WS_W2T) + (size_t)kv * 64 * 256, 64 * kb, 32 * nb, 32 * nb + (lane & 31), scr, lane); }
            }
            for (int it = gw; it < 2 * 4 * 32; it += NGW) {
                const int ch = it & 31, hg = (it >> 5) & 3, kv = it >> 7;
                const float* w1 = cmp_w1 + (size_t)kv * 2048 * 256 + (size_t)(64 * ch) * 256 + 64 * hg + lane; const float* pe = cmp_pos + kv * 2048 + 64 * ch;
                float s = 0.f;
#pragma unroll 8
                for (int f = 0; f < 64; ++f) s += pe[f] * w1[(size_t)f * 256];
                ((float*)(ws + WS_BIASP))[(ch * 2 + kv) * 256 + 64 * hg + lane] = s;
            }
            for (int m = gw; m < T; m += 2 * NGW) {
                const int m1 = m + NGW < T ? m + NGW : m;
                const GAS f32x4* xr0 = (const GAS f32x4*)(xin + (size_t)m * D) + lane; const GAS f32x4* xr1 = (const GAS f32x4*)(xin + (size_t)m1 * D) + lane; const GAS f32x4* wr4 = (const GAS f32x4*)norm_w + lane;
                f32x4 v0[4], v1[4]; float s0 = 0.f, s1 = 0.f;
#pragma unroll
                for (int j = 0; j < 4; ++j) { v0[j] = xr0[64 * j]; v1[j] = xr1[64 * j]; }
#pragma unroll
                for (int j = 0; j < 4; ++j) { s0 += (v0[j].x * v0[j].x + v0[j].y * v0[j].y) + (v0[j].z * v0[j].z + v0[j].w * v0[j].w); s1 += (v1[j].x * v1[j].x + v1[j].y * v1[j].y) + (v1[j].z * v1[j].z + v1[j].w * v1[j].w); }
                const float eps = sconst(1e-6f);
                const float rs0 = rsqrtf(wave_sum(s0) * (1.f / D) + eps), rs1 = rsqrtf(wave_sum(s1) * (1.f / D) + eps);
                GAS u32x2* o80 = (GAS u32x2*)(Hb + (size_t)m * D) + lane; GAS u32x2* o81 = (GAS u32x2*)(Hb + (size_t)m1 * D) + lane;
#pragma unroll
                for (int j = 0; j < 4; ++j) { const f32x4 w = wr4[64 * j]; u32x2 o0, o1;
                    o0.x = pk2(v0[j].x * rs0 * w.x, v0[j].y * rs0 * w.y); o0.y = pk2(v0[j].z * rs0 * w.z, v0[j].w * rs0 * w.w);
                    o1.x = pk2(v1[j].x * rs1 * w.x, v1[j].y * rs1 * w.y); o1.y = pk2(v1[j].z * rs1 * w.z, v1[j].w * rs1 * w.w);
                    o80[64 * j] = o0; if (m1 != m) o81[64 * j] = o1; }
            }
            sync = true;
        } else if (ls == ST_BIAS) {
            FRESH();
            if (blockIdx.x == 0) { float s = 0.f; for (int c = 0; c < 32; ++c) s += ((const float*)(ws + WS_BIASP))[c * 512 + tid]; ((float*)(ws + WS_BIAS))[tid] = s; }
        } else if (ls == ST_P2) {
        } else if (ls == ST_P3 || ls == ST_P4) {
            if (ls == ST_P3) {
                { FRESH();
                  for (int base = 0; base < 1024; base += 4 * G) {
                      const int it = base + blockIdx.x + G * (wave & 3); const int q = it < 1024 ? 1023 - it : 0;
                      task_cmp(ws, q & 7, q >> 3, lane, (LAS float*)(lds + (wave & 3) * 16384), 2 * (wave >> 2), it < 1024 ? 2 : 0, wave < 4 && it < 1024);
                  } }
                { FRESH();
                  for (int q = blockIdx.x + G * (NWAVES - 1 - wave); q < 4096; q += NGW) task_moba_gate(ws, q & 7, (q >> 3) & 3, q >> 5, lane); }
            }
            for (int pool = (ls == ST_P3 ? 0 : 2); pool < (ls == ST_P3 ? 2 : 3); ++pool) {
                FRESH();
                unsigned* ctr = (unsigned*)(ws + WS_CTL) + layer * 64 + 16 * pool;
                const int ngroups = pool == 0 ? 1024 : pool == 1 ? 1536 : 1024;
                volatile LAS int* gslot = (volatile LAS int*)(lds + 131072);
                for (;;) {
                    __syncthreads();
                    if (tid == 0) *gslot = (int)atomicAdd(ctr, 1u);
                    __syncthreads();
                    const int g = __builtin_amdgcn_readfirstlane(*gslot);
                    if (g >= ngroups) break;
                    const int lane = (int)__builtin_amdgcn_mbcnt_hi(~0u, __builtin_amdgcn_mbcnt_lo(~0u, (unsigned)launder(0))), tid = wave * 64 + lane;
                    if (pool == 2) { const int qg = 15 - (g >> 6), w = g & 63; run_heavy_group(ws, w >> 5, w & 7, (w >> 3) & 3, qg, wave, lane, tid, lds); }
                    else if (pool == 0 && g < 512) { task_stick(ws, g & 7, (g >> 3) & 3, 8 * (15 - (g >> 5)) + wave, lane, lds + wave * 16384); }
                    else {
                        if (pool == 1 && g < 512) run_heavy_group(ws, 2, g & 7, 0, 63 - (g >> 3), wave, lane, tid, lds);
                        else {
                        const int kd = pool == 0 ? 3 : 4 + ((g - 512) >> 9), w = g & 511;
                        task_sm(ws, kd, w & 7, (w >> 3) & 3, 8 * (w >> 5) + wave, lane, lds + wave * 16384);
                        }
                    }
                }
            }
            sync = true;
        } else {
            unsigned char* ws = launder_p(ws0); bf16_t* Hb = (bf16_t*)(ws + WS_H);
            pg8::Gemm g; Epi E{0, 0, ws, xin, a.out};
            if (ls == ST_G_QK) { g = pg8::Gemm{Hb, (const bf16_t*)(ws + WS_WQK), T, NQK, D}; E.kind = 0; sync = true; }
            else if (ls == ST_G_VT) { g = pg8::Gemm{(const bf16_t*)(ws + WS_WV), Hb, NV, T, D}; E.kind = 1; sync = true; }
            else if (ls == ST_G_GATE) { g = pg8::Gemm{Hb, (const bf16_t*)(ws + WS_WG), T, D, D}; E.kind = 2; sync = true; }
            else if (ls == ST_G_OUT) { g = pg8::Gemm{(const bf16_t*)(ws + WS_Y), (const bf16_t*)(ws + WS_WOUT), T, D, D}; E.kind = 5; sync = true; }
            else {
                const int k = ls - ST_G_U0, br = k >> 1;
                const int wslot = br == 0 ? SL_QA : br == 1 ? SL_QB : br == 2 ? SL_QC : SL_QD0;
                if ((k & 1) == 0) { g = pg8::Gemm{slot_ptr(ws, wslot), (const bf16_t*)(ws + WS_WUP) + (size_t)br * D * 256, T, D, 256}; E.kind = 3; }
                else { g = pg8::Gemm{Hb, (const bf16_t*)(ws + WS_WM) + (size_t)br * D * D, T, D, D}; E.kind = 4; E.first = (br == 0); sync = (br == 3); }
            }
            pg8::StaticOrder S; S.init(g.M, g.N, G, (int)blockIdx.x);
            if (ls == ST_G_VT) {
                FRESH();
                if (G == 256) {
                    if (blockIdx.x < 128) task_mlp_block(ws, blockIdx.x >> 6, (blockIdx.x >> 3) & 7, blockIdx.x & 7, wave, lane, (LAS float*)lds);
                    else if (blockIdx.x < 192) { const int q = (blockIdx.x - 128) * NWAVES + wave; task_kmean(ws, q >> 6, (q >> 4) & 3, q & 15, lane); }
                    S.split = 128;
                } else {
                    for (int q = gw; q < 512; q += NGW) task_kmean(ws, q >> 6, (q >> 4) & 3, q & 15, lane);
                    for (int it = blockIdx.x; it < 128; it += G) task_mlp_block(ws, it >> 6, (it >> 3) & 7, it & 7, wave, lane, (LAS float*)lds);
                }
                __syncthreads();
            }
            pg8::gemm_phase<Epi, pg8::StaticOrder, true, true>(lds, g, S, E);
        }
        if (sync) grid.sync();
#if PROBE_A || PROBE_B
        if (blockIdx.x == 0 && tid0 == 0) { unsigned long long* tp = (unsigned long long*)(ws0 + WS_CTL + 2048); tp[ls] += wall_clock64() - tp[32]; }
#endif
    }
}

extern "C" void kernel_launch(void* const* d_in, const int* in_sizes, int n_in, void* d_out, int out_size, void* d_ws, size_t ws_size, hipStream_t stream) {
    static int grid = 0;
    if (grid == 0) {
        int dev = 0, cus = 0, per_cu = 0;
        hipGetDevice(&dev);
        hipDeviceGetAttribute(&cus, hipDeviceAttributeMultiprocessorCount, dev);
        hipFuncSetAttribute((const void*)mega_fwd, hipFuncAttributeMaxDynamicSharedMemorySize, LDS_BYTES);
        hipOccupancyMaxActiveBlocksPerMultiprocessor(&per_cu, (const void*)mega_fwd, NWAVES * 64, LDS_BYTES);
        (void)hipGetLastError();
        grid = cus;
        if (n_in != 9 || out_size != T * D || ws_size < WS_END || per_cu < 1) { fprintf(stderr, "kernel_launch: unexpected problem (n_in %d out %d ws %zu per_cu %d)\n", n_in, out_size, ws_size, per_cu); grid = -1; }
    }
    if (grid < 0) return;
    Args a{};
    for (int i = 0; i < 9; ++i) a.in[i] = (const float*)d_in[i];
    a.out = (float*)d_out; a.ws = (unsigned char*)d_ws;
    void* args[] = {&a};
    hipError_t e = hipLaunchCooperativeKernel((const void*)mega_fwd, dim3(grid), dim3(NWAVES * 64), args, LDS_BYTES, stream);
    if (e != hipSuccess) fprintf(stderr, "cooperative launch failed: %s\n", hipGetErrorString(e));
}
```

```cpp
#include <hip/hip_runtime.h>
#include <hip/hip_cooperative_groups.h>
#include <cstdio>
#include <cstdint>
namespace cg = cooperative_groups;
__device__ __forceinline__ int launder_i(int x) { asm volatile("" : "+v"(x)); return x; }
namespace pg8 {
#define PG8_LAS __attribute__((address_space(3)))
typedef unsigned short bf16_t;
typedef short bf16x8 __attribute__((ext_vector_type(8)));
typedef float f32x4 __attribute__((ext_vector_type(4)));
typedef unsigned u32x4 __attribute__((ext_vector_type(4)));
constexpr int BM = 256, BK = 64, HALF = 128, HTB = HALF * BK * 2  , STAGE_BYTES = 8 * HTB, NXCD = 8, WGM = 8;

__host__ __device__ __forceinline__ int lds_byte(int r, int c) { const int st = (r >> 4) * 2 + (c >> 5), rr = r & 15, cc = c & 31, ob = rr * 64 + cc * 2; return st * 1024 + (ob ^ (((ob >> 9) & 1) << 5)); }
__host__ __device__ __forceinline__ void stage_rc(int b, int& R, int& C) { const int st = b / 1024, sb = b % 1024, swz = sb ^ (((sb >> 9) & 1) << 5); R = (st >> 1) * 16 + swz / 64; C = (st & 1) * 32 + (swz % 64) / 2; }
__host__ __device__ __forceinline__ int perm32(int rho) { const int n = rho >> 4, i = rho & 15; return 8 * (i >> 2) + 4 * n + (i & 3); }

struct Unit { int pm, pn; };
struct Gemm { const bf16_t* A; const bf16_t* Bt; int M, N, K; };

struct StaticOrder {
    int nM, nN, nwg, G, c, split;
    __host__ __device__ void init(int M, int N, int G_, int c_) { nM = M / BM; nN = N / BM; nwg = nM * nN; G = G_; c = c_; split = 0; }
    __host__ __device__ bool next(int i, Unit& u) const {
        if (split) {
            const int per = c < split ? 2 : 4; if (i >= per) return false;
            const int L2 = c < split ? 2 * c + i : 2 * split + 4 * (c - split) + i;
            u.pm = L2 % nM; u.pn = L2 / nM; return true;
        }
        const long L = (long)i * G + c; if (L >= nwg) return false;
        int wgid = (int)L; { const int q = nwg / NXCD, r = nwg % NXCD, xcd = wgid % NXCD, off = wgid / NXCD; wgid = (xcd < r ? xcd * (q + 1) : r * (q + 1) + (xcd - r) * q) + off; }
        const int nig = WGM * nN, gid = wgid / nig, fm = gid * WGM, gsz = (nM - fm) < WGM ? (nM - fm) : WGM;
        u.pm = fm + ((wgid % nig) % gsz); u.pn = (wgid % nig) / gsz; return true;
    }
    __device__ __forceinline__ void a_ready(const Unit&) const {}
    __device__ __forceinline__ void done(const Unit&) const {}
};

__device__ __forceinline__ unsigned cvt_pk_bf16(float lo, float hi) { unsigned r; asm volatile("v_cvt_pk_bf16_f32 %0, %1, %2" : "=v"(r) : "v"(lo), "v"(hi)); return r; }
template <class Epi, class Sched, bool ALIGN_EPI = false, bool SP2 = false>
__device__ __forceinline__ void gemm_phase(PG8_LAS unsigned char* lds, const Gemm g, const Sched& S, const Epi& E) {
    const int tid = launder_i((int)threadIdx.x), wid = __builtin_amdgcn_readfirstlane(tid >> 6), lane = tid & 63, wr = wid >> 2, wc = wid & 3, fr = lane & 15, fq = lane >> 4;
    const int K = g.K, nt = K / BK;
    unsigned voffA[2], voffB[2];
#pragma unroll
    for (int i = 0; i < 2; ++i) { int R, C; stage_rc(tid * 16 + i * 8192, R, C); const int Rb = Epi::PERM ? ((R & ~31) + perm32(R & 31)) : R;
        voffA[i] = (unsigned)(R * K + C) * 2u; voffB[i] = (unsigned)(Rb * K + C) * 2u; }
    const size_t kstep = (size_t)(BK * 2);
    const size_t hstep = (size_t)HALF * K * 2;
    const size_t tstep = 2 * hstep;
    const unsigned ldsw = (unsigned)wid * 1024u;
    const int aoff = lds_byte(wr * 64 + fr, fq * 8), boff = lds_byte(wc * 32 + fr, fq * 8);
#define PG8_SA(b, h) (((b) * 2 + (h)) * HTB)
#define PG8_SB(b, h) ((4 + (b) * 2 + (h)) * HTB)
#define PG8_STAGE(bufoff, gbase, voff) do { _Pragma("unroll") for (int _i = 0; _i < 2; ++_i) \
        __builtin_amdgcn_global_load_lds((const unsigned*)((const char*)(gbase) + (voff)[_i]), (PG8_LAS unsigned*)(lds + (bufoff) + ldsw + _i * 8192), 16, 0, 0); } while (0)
#define PG8_LDA(dst, b, h) do { _Pragma("unroll") for (int m = 0; m < 4; ++m) _Pragma("unroll") for (int k = 0; k < 2; ++k) dst[m][k] = *(const PG8_LAS bf16x8*)(lds + PG8_SA(b, h) + aoff + m * 2048 + k * 1024); } while (0)
#define PG8_LDB(dst, b, h) do { _Pragma("unroll") for (int n = 0; n < 2; ++n) _Pragma("unroll") for (int k = 0; k < 2; ++k) dst[n][k] = *(const PG8_LAS bf16x8*)(lds + PG8_SB(b, h) + boff + n * 2048 + k * 1024); } while (0)
#define PG8_MMA(ai, bj, At, Bt) do { __builtin_amdgcn_s_setprio(1); _Pragma("unroll") for (int m = 0; m < 4; ++m) _Pragma("unroll") for (int n = 0; n < 2; ++n) _Pragma("unroll") for (int k = 0; k < 2; ++k) \
        acc[ai][bj][m][n] = __builtin_amdgcn_mfma_f32_16x16x32_bf16(Bt[n][k], At[m][k], acc[ai][bj][m][n], 0, 0, 0); __builtin_amdgcn_s_setprio(0); } while (0)
#define PG8_WAIT_V(n) asm volatile("s_waitcnt vmcnt(" #n ")" ::: "memory")
#define PG8_WAIT_L(n) asm volatile("s_waitcnt lgkmcnt(" #n ")" ::: "memory")
#define PG8_BAR __builtin_amdgcn_s_barrier()
#define PG8_SCHED __builtin_amdgcn_sched_barrier(0)
    Unit cur, nxt; int ui = 0;
    if (!S.next(0, cur)) return;
    f32x4 acc[2][2][4][2];
#pragma unroll
    for (int a = 0; a < 2; ++a)
#pragma unroll
        for (int b = 0; b < 2; ++b)
#pragma unroll
            for (int m = 0; m < 4; ++m)
#pragma unroll
                for (int n = 0; n < 2; ++n) acc[a][b][m][n] = (f32x4){0.f, 0.f, 0.f, 0.f};
    bf16x8 At[4][2], B0[2][2], B1[2][2];
    const char* cA = (const char*)g.A + (size_t)cur.pm * tstep; const char* cB = (const char*)g.Bt + (size_t)cur.pn * tstep;
    S.a_ready(cur);
    if constexpr (SP2) {
        PG8_STAGE(PG8_SB(0, 0), cB, voffB); PG8_STAGE(PG8_SB(0, 1), cB + hstep, voffB); PG8_STAGE(PG8_SA(0, 0), cA, voffA); PG8_STAGE(PG8_SA(0, 1), cA + hstep, voffA);
        if (wr == 1) PG8_BAR;
        PG8_WAIT_V(2); PG8_BAR;
        PG8_STAGE(PG8_SB(1, 0), cB + kstep, voffB); PG8_STAGE(PG8_SA(1, 0), cA + kstep, voffA); PG8_STAGE(PG8_SB(1, 1), cB + hstep + kstep, voffB);
        PG8_WAIT_V(6); PG8_BAR;
    } else {
        PG8_STAGE(PG8_SB(0, 0), cB, voffB); PG8_STAGE(PG8_SA(0, 0), cA, voffA); PG8_STAGE(PG8_SB(0, 1), cB + hstep, voffB); PG8_STAGE(PG8_SA(0, 1), cA + hstep, voffA);
        if (wr == 1) PG8_BAR;
        PG8_WAIT_V(4); PG8_BAR;
        PG8_STAGE(PG8_SB(1, 0), cB + kstep, voffB); PG8_STAGE(PG8_SA(1, 0), cA + kstep, voffA); PG8_STAGE(PG8_SB(1, 1), cB + hstep + kstep, voffB);
        PG8_WAIT_V(6); PG8_BAR;
    }
    for (;;) {
        const bool has_next = S.next(ui + 1, nxt);
        const char* nA = has_next ? (const char*)g.A + (size_t)nxt.pm * tstep : cA; const char* nB = has_next ? (const char*)g.Bt + (size_t)nxt.pn * tstep : cB;
        for (int t = 0; t < nt; t += 2) {
            const bool last = (t == nt - 2);
            const char* a1 = cA + (size_t)(t + 1) * kstep;
            const char* a2 = last ? nA : cA + (size_t)(t + 2) * kstep; const char* b2 = last ? nB : cB + (size_t)(t + 2) * kstep;
            const char* a3 = a2 + kstep; const char* b3 = b2 + kstep;
            if (last && has_next) S.a_ready(nxt);
            if constexpr (SP2) {
            PG8_LDB(B0, 0, 0); PG8_LDB(B1, 0, 1); PG8_SCHED; PG8_LDA(At, 0, 0); PG8_STAGE(PG8_SA(1, 1), a1 + hstep, voffA);
            PG8_WAIT_V(8); PG8_WAIT_L(0); PG8_BAR; PG8_MMA(0, 0, At, B0); PG8_MMA(0, 1, At, B1); PG8_BAR; PG8_SCHED;
            PG8_LDA(At, 0, 1); PG8_STAGE(PG8_SB(0, 0), b2, voffB); PG8_STAGE(PG8_SB(0, 1), b2 + hstep, voffB); PG8_STAGE(PG8_SA(0, 0), a2, voffA);
            PG8_WAIT_V(8); PG8_WAIT_L(0); PG8_BAR; PG8_MMA(1, 0, At, B0); PG8_MMA(1, 1, At, B1); PG8_BAR; PG8_SCHED;
            PG8_LDB(B0, 1, 0); PG8_LDB(B1, 1, 1); PG8_SCHED; PG8_LDA(At, 1, 0); PG8_STAGE(PG8_SA(0, 1), a2 + hstep, voffA);
            PG8_WAIT_V(8); PG8_WAIT_L(0); PG8_BAR; PG8_MMA(0, 0, At, B0); PG8_MMA(0, 1, At, B1); PG8_BAR; PG8_SCHED;
            PG8_LDA(At, 1, 1); PG8_STAGE(PG8_SB(1, 0), b3, voffB); PG8_STAGE(PG8_SB(1, 1), b3 + hstep, voffB); PG8_STAGE(PG8_SA(1, 0), a3, voffA);
            PG8_WAIT_V(8); PG8_WAIT_L(0); PG8_BAR; PG8_MMA(1, 0, At, B0); PG8_MMA(1, 1, At, B1); PG8_BAR; PG8_SCHED;
            } else {
            PG8_LDB(B0, 0, 0); PG8_SCHED; PG8_LDA(At, 0, 0); PG8_STAGE(PG8_SA(1, 1), a1 + hstep, voffA);
            PG8_WAIT_L(8); PG8_BAR; PG8_WAIT_L(0); PG8_MMA(0, 0, At, B0); PG8_BAR; PG8_SCHED;
            PG8_LDB(B1, 0, 1); PG8_STAGE(PG8_SB(0, 0), b2, voffB);
            PG8_BAR; PG8_WAIT_L(0); PG8_MMA(0, 1, At, B1); PG8_BAR;
            PG8_LDA(At, 0, 1); PG8_STAGE(PG8_SA(0, 0), a2, voffA);
            PG8_BAR; PG8_WAIT_L(0); PG8_MMA(1, 0, At, B0); PG8_BAR; PG8_SCHED;
            PG8_STAGE(PG8_SB(0, 1), b2 + hstep, voffB);
            PG8_WAIT_V(6); PG8_BAR; PG8_MMA(1, 1, At, B1); PG8_BAR;
            PG8_LDB(B0, 1, 0); PG8_SCHED; PG8_LDA(At, 1, 0); PG8_STAGE(PG8_SA(0, 1), a2 + hstep, voffA);
            PG8_WAIT_L(8); PG8_BAR; PG8_WAIT_L(0); PG8_MMA(0, 0, At, B0); PG8_BAR; PG8_SCHED;
            PG8_LDB(B1, 1, 1); PG8_STAGE(PG8_SB(1, 0), b3, voffB);
            PG8_BAR; PG8_WAIT_L(0); PG8_MMA(0, 1, At, B1); PG8_BAR;
            PG8_LDA(At, 1, 1); PG8_STAGE(PG8_SA(1, 0), a3, voffA);
            PG8_BAR; PG8_WAIT_L(0); PG8_MMA(1, 0, At, B0); PG8_BAR; PG8_SCHED;
            PG8_STAGE(PG8_SB(1, 1), b3 + hstep, voffB);
            PG8_WAIT_V(6); PG8_BAR; PG8_MMA(1, 1, At, B1); PG8_BAR;
            }
        }
        if constexpr (ALIGN_EPI) { if (wr == 0) PG8_BAR; }
        if constexpr (!Epi::AFTER_DRAIN) { E(acc, cur, wr, wc, fr, fq); S.done(cur); }
        if (!has_next) break;
#pragma unroll
        for (int a = 0; a < 2; ++a)
#pragma unroll
            for (int b = 0; b < 2; ++b)
#pragma unroll
                for (int m = 0; m < 4; ++m)
#pragma unroll
                    for (int n = 0; n < 2; ++n) acc[a][b][m][n] = (f32x4){0.f, 0.f, 0.f, 0.f};
        cur = nxt; cA = nA; cB = nB; ++ui;
        if constexpr (ALIGN_EPI) { if (wr == 1) PG8_BAR; }
    }
    PG8_WAIT_V(0);
    if constexpr (!ALIGN_EPI) { if (wr == 0) PG8_BAR; }
    PG8_BAR;
    if constexpr (Epi::AFTER_DRAIN) { E.fused(acc, cur, wr, wc, fr, fq, lds, wid, lane); S.done(cur); }
#undef PG8_SA
#undef PG8_SB
#undef PG8_STAGE
#undef PG8_LDA
#undef PG8_LDB
#undef PG8_MMA
#undef PG8_WAIT_V
#undef PG8_WAIT_L
#undef PG8_BAR
#undef PG8_SCHED
}
}

constexpr int NWAVES = 8;
constexpr int LDS_BYTES = 135168;
constexpr int NB = 8, SEQ = 4096, T = NB * SEQ, D = 1024, INW = 9612, DEPTH = 2;
constexpr int A_Q = 0, A_K = 256, A_V = 512, A_G = 768, B_Q = 1024, B_KC = 1280, B_VC = 1344, B_KS = 1408, B_VS = 1472, B_KW = 1536, B_VW = 1600, B_G = 1664, B_NG = 1920,
              C_Q = 1932, C_K = 2188, C_V = 2444, C_G = 2700, D_Q = 2956, D_K = 3724, D_V = 4492, D_G = 5260, MRG = 5516;
constexpr size_t MiB = 1u << 20, KiB = 1024;
constexpr size_t WS_CTL = 0, WS_COS = 1 * MiB, WS_SIN = 1 * MiB + 512 * KiB, WS_KMEAN = 2 * MiB, WS_BIASP = 2 * MiB + 128 * KiB, WS_BIAS = 2 * MiB + 192 * KiB,
                 WS_KCMP = 2 * MiB + 512 * KiB, WS_VCMPT = 2 * MiB + 768 * KiB, WS_MMASK = 3 * MiB, WS_NMASK = 3 * MiB + 512 * KiB, WS_LSE = 4 * MiB,
                 WS_W1T = 6 * MiB, WS_W2T = 8 * MiB, WS_WQK = 9 * MiB, WS_WV = 15 * MiB, WS_WG = 18 * MiB, WS_WM = 20 * MiB, WS_WUP = 28 * MiB, WS_WOUT = 30 * MiB,
                 WS_H = 32 * MiB, WS_QK = 96 * MiB, WS_VT = 320 * MiB, WS_U = 320 * MiB, WS_Y = 224 * MiB, WS_END = 432 * MiB;
constexpr size_t SLOT_BYTES = 16 * MiB;
constexpr int SL_QA = 0, SL_QB = 1, SL_QC = 2, SL_QD0 = 3, SL_QBR = 4, SL_QD1 = 5, SL_QD2 = 6, SL_OWIN = 7, SL_KA = 8, SL_KB4 = 9, SL_KC = 10, SL_KD0 = 11, SL_OSLC = 20;
constexpr int NQK = 3072, NV = 1536;
constexpr int CTL_BYTES = 4096;

typedef unsigned short bf16_t;
typedef short bf16x8 __attribute__((ext_vector_type(8)));
typedef float f32x4 __attribute__((ext_vector_type(4)));
typedef float f32x2 __attribute__((ext_vector_type(2)));
typedef float f32x16 __attribute__((ext_vector_type(16)));
typedef unsigned u32x4 __attribute__((ext_vector_type(4)));
typedef unsigned u32x2 __attribute__((ext_vector_type(2)));
typedef __bf16 bf16v2 __attribute__((ext_vector_type(2)));
#define LAS __attribute__((address_space(3)))
#define GAS __attribute__((address_space(1)))
#define DI __device__ __forceinline__
#define MFMA32(a, b, c) __builtin_amdgcn_mfma_f32_32x32x16_bf16((a), (b), (c), 0, 0, 0)

constexpr float LOG2E = 1.4426950408889634f, LN2 = 0.6931471805599453f;
DI float sconst(float x) { asm volatile("" : "+s"(x)); return x; }
constexpr float SM_SCALE = 0.125f, SM_C = 0.125f * LOG2E, NEG_C = -1e30f, MFLOOR_C = -30000.f;
#define NEG sconst(NEG_C)
#define MFLOOR sconst(MFLOOR_C)

DI unsigned pk2(float lo, float hi) { const bf16v2 r = __builtin_convertvector((f32x2){lo, hi}, bf16v2); return __builtin_bit_cast(unsigned, r); }
DI float bf_lo(unsigned w) { return __uint_as_float(w << 16); }
DI float bf_hi(unsigned w) { return __uint_as_float(w & 0xffff0000u); }
DI float bf1(bf16_t x) { return __uint_as_float((unsigned)x << 16); }
DI float fexp2(float x) { return __builtin_amdgcn_exp2f(x); }
DI float flog2(float x) { return __builtin_amdgcn_logf(x); }
DI float frcp(float x) { return __builtin_amdgcn_rcpf(x); }
DI float sigmoidf_(float x) { return frcp(1.f + fexp2(-x * LOG2E)); }
DI float wave_sum(float v) {
#pragma unroll
    for (int o = 1; o < 64; o <<= 1) v += __shfl_xor(v, o);
    return v;
}
DI float xhalf(float v) { return __shfl_xor(v, 32); }
DI float hmaxf_(float v) { const auto r = __builtin_amdgcn_permlane32_swap(__float_as_uint(v), __float_as_uint(v), false, false); return fmaxf(__uint_as_float(r[0]), __uint_as_float(r[1])); }
DI float hsumf_(float v) { const auto r = __builtin_amdgcn_permlane32_swap(__float_as_uint(v), __float_as_uint(v), false, false); return __uint_as_float(r[0]) + __uint_as_float(r[1]); }
DI bf16_t* slot_ptr(unsigned char* ws, int s) { return (bf16_t*)(ws + WS_QK + (size_t)s * SLOT_BYTES); }
DI void load8(const bf16_t* p, float (&f)[8]) { const u32x4 w = *(const GAS u32x4*)p; f[0] = bf_lo(w.x); f[1] = bf_hi(w.x); f[2] = bf_lo(w.y); f[3] = bf_hi(w.y); f[4] = bf_lo(w.z); f[5] = bf_hi(w.z); f[6] = bf_lo(w.w); f[7] = bf_hi(w.w); }
DI void store8(bf16_t* p, const float (&f)[8]) { u32x4 w; w.x = pk2(f[0], f[1]); w.y = pk2(f[2], f[3]); w.z = pk2(f[4], f[5]); w.w = pk2(f[6], f[7]); *(GAS u32x4*)p = w; }
DI void store4(bf16_t* p, float a, float b, float c, float d) { u32x2 w; w.x = pk2(a, b); w.y = pk2(c, d); *(GAS u32x2*)p = w; }

struct Epi {
    static constexpr bool PERM = true, AFTER_DRAIN = false;
    int kind, first; unsigned char* ws; const float* xin; float* xout;
    typedef pg8::f32x4 a4;
    DI void operator()(const a4 (&acc)[2][2][4][2], const pg8::Unit& u, int wr, int wc, int fr, int fq) const {
        if (kind == 0) {
            const int tile = u.pn;
            const int slot = (int)((0xDCB653A29180ull >> (4 * tile)) & 15ull);
            bf16_t* dst = slot_ptr(ws, slot); bf16_t* dst2 = slot_ptr(ws, SL_QBR);
            const bool ropeall = (tile <= 1) || (tile >= 6);
            const int g = 4 * (wc & 1) + fq, d0 = 4 * g;
            const float* cosT = (const float*)(ws + WS_COS); const float* sinT = (const float*)(ws + WS_SIN);
#pragma unroll
            for (int ai = 0; ai < 2; ++ai)
#pragma unroll
                for (int m = 0; m < 4; ++m) {
                    const int tok = u.pm * 256 + ai * 128 + wr * 64 + m * 16 + fr, pos = tok & (SEQ - 1);
                    const f32x4 cs = *(const GAS f32x4*)(cosT + pos * 32 + d0), sn = *(const GAS f32x4*)(sinT + pos * 32 + d0);
#pragma unroll
                    for (int bj = 0; bj < 2; ++bj) {
                        const int hs = 2 * bj + (wc >> 1);
                        const a4 v0 = acc[ai][bj][m][0], v1 = acc[ai][bj][m][1];
                        const a4 r0 = v0 * cs - v1 * sn, r1 = v0 * sn + v1 * cs;
                        const size_t off = (size_t)tok * 256 + hs * 64 + d0;
                        const bool rope = ropeall || (tile == 3 && hs >= 2);
                        if (tile == 2) { store4(dst + off, v0[0], v0[1], v0[2], v0[3]); store4(dst + off + 32, v1[0], v1[1], v1[2], v1[3]);
                                         store4(dst2 + off, r0[0], r0[1], r0[2], r0[3]); store4(dst2 + off + 32, r1[0], r1[1], r1[2], r1[3]); }
                        else if (rope) { store4(dst + off, r0[0], r0[1], r0[2], r0[3]); store4(dst + off + 32, r1[0], r1[1], r1[2], r1[3]); }
                        else { store4(dst + off, v0[0], v0[1], v0[2], v0[3]); store4(dst + off + 32, v1[0], v1[1], v1[2], v1[3]); }
                    }
                    asm volatile("" ::: "memory");
                }
        } else if (kind == 1) {
            bf16_t* VT = (bf16_t*)(ws + WS_VT);
#pragma unroll
            for (int ai = 0; ai < 2; ++ai)
#pragma unroll
                for (int m = 0; m < 4; ++m) {
                    const int r = u.pm * 256 + ai * 128 + wr * 64 + m * 16 + fr;
                    bf16_t* rowp = VT + (size_t)r * T;
                    const bool gate = (r >= 1408 && r < 1420);
#pragma unroll
                    for (int bj = 0; bj < 2; ++bj) {
                        const int c0 = u.pn * 256 + bj * 128 + wc * 32 + 8 * fq;
                        const a4 v0 = acc[ai][bj][m][0], v1 = acc[ai][bj][m][1];
                        float v[8] = {v0[0], v0[1], v0[2], v0[3], v1[0], v1[1], v1[2], v1[3]};
                        if (gate) {
#pragma unroll
                            for (int j = 0; j < 8; ++j) v[j] = sigmoidf_(v[j]);
                        }
                        if (u.pm == 3) {
                            const int b = c0 >> 12, p0 = c0 & (SEQ - 1), mm0 = p0 >> 2;
                            bf16_t* q = rowp + b * SEQ + mm0;
#pragma unroll
                            for (int c = 0; c < 4; ++c) *(GAS unsigned*)(q + c * 1024) = pk2(v[c], v[c + 4]);
                        } else if (u.pm == 4) {
                            const int b = c0 >> 12, p0 = c0 & (SEQ - 1), mm = p0 >> 4, cc0 = p0 & 15;
                            bf16_t* q = rowp + b * SEQ + cc0 * 256 + mm;
#pragma unroll
                            for (int j = 0; j < 8; ++j) ((GAS bf16_t*)q)[j * 256] = (bf16_t)(pk2(v[j], 0.f) & 0xffffu);
                        } else store8(rowp + c0, v);
                    }
                    asm volatile("" ::: "memory");
                }
        } else if (kind == 2) {
            const int br = u.pn;
            const bf16_t* VT = (const bf16_t*)(ws + WS_VT);
            const float* LSE = (const float*)(ws + WS_LSE);
#pragma unroll
            for (int ai = 0; ai < 2; ++ai)
#pragma unroll
                for (int m = 0; m < 4; ++m) {
                    const int tok = u.pm * 256 + ai * 128 + wr * 64 + m * 16 + fr;
#pragma unroll
                    for (int bj = 0; bj < 2; ++bj) {
                        const int cb = bj * 128 + wc * 32 + 8 * fq, head = cb >> 6;
                        const a4 v0 = acc[ai][bj][m][0], v1 = acc[ai][bj][m][1];
                        float gt[8] = {v0[0], v0[1], v0[2], v0[3], v1[0], v1[1], v1[2], v1[3]};
                        const size_t off = (size_t)tok * 256 + cb;
                        float o[8];
                        bf16_t* dst;
                        if (br == 0) { dst = slot_ptr(ws, SL_QA) + off; load8(dst, o); }
                        else if (br == 2) { dst = slot_ptr(ws, SL_QC) + off; load8(dst, o); }
                        else if (br == 1) {
                            dst = slot_ptr(ws, SL_QB) + off;
                            float oc[8], os[8], ow[8]; load8(dst, oc); load8(slot_ptr(ws, SL_OSLC) + off, os); load8(slot_ptr(ws, SL_OWIN) + off, ow);
                            const GAS bf16_t* VTg = (const GAS bf16_t*)VT; const float g0 = bf1(VTg[(size_t)(1408 + head) * T + tok]), g1 = bf1(VTg[(size_t)(1412 + head) * T + tok]), g2 = bf1(VTg[(size_t)(1416 + head) * T + tok]);
#pragma unroll
                            for (int j = 0; j < 8; ++j) o[j] = g0 * oc[j] + g1 * os[j] + g2 * ow[j];
                        } else {
                            dst = slot_ptr(ws, SL_QD0) + off;
                            float o0[8], o1[8], o2[8]; load8(dst, o0); load8(slot_ptr(ws, SL_QD1) + off, o1); load8(slot_ptr(ws, SL_QD2) + off, o2);
                            const GAS float* LSEg = (const GAS float*)LSE; const float l0 = LSEg[((size_t)0 * T + tok) * 4 + head], l1 = LSEg[((size_t)1 * T + tok) * 4 + head], l2 = LSEg[((size_t)2 * T + tok) * 4 + head];
                            const float mx = fmaxf(l0, fmaxf(l1, l2));
                            const float e0 = fexp2((l0 - mx) * LOG2E), e1 = fexp2((l1 - mx) * LOG2E), e2 = fexp2((l2 - mx) * LOG2E);
                            const float inv = frcp(e0 + e1 + e2);
#pragma unroll
                            for (int j = 0; j < 8; ++j) o[j] = (e0 * o0[j] + e1 * o1[j] + e2 * o2[j]) * inv;
                        }
#pragma unroll
                        for (int j = 0; j < 8; ++j) o[j] *= gt[j] * sigmoidf_(gt[j]);
                        store8(dst, o);
                        asm volatile("" ::: "memory");
                    }
                }
        } else {
            bf16_t* U = (bf16_t*)(ws + WS_U); bf16_t* Y = (bf16_t*)(ws + WS_Y);
#pragma unroll
            for (int ai = 0; ai < 2; ++ai)
#pragma unroll
                for (int m = 0; m < 4; ++m) {
                    const int tok = u.pm * 256 + ai * 128 + wr * 64 + m * 16 + fr;
#pragma unroll
                    for (int bj = 0; bj < 2; ++bj) {
                        const int col = u.pn * 256 + bj * 128 + wc * 32 + 8 * fq;
                        const a4 v0 = acc[ai][bj][m][0], v1 = acc[ai][bj][m][1];
                        float v[8] = {v0[0], v0[1], v0[2], v0[3], v1[0], v1[1], v1[2], v1[3]};
                        const size_t off = (size_t)tok * D + col;
                        if (kind == 3) store8(U + off, v);
                        else if (kind == 4) {
                            float uu[8]; load8(U + off, uu);
                            float y[8];
                            if (first) {
#pragma unroll
                                for (int j = 0; j < 8; ++j) y[j] = sigmoidf_(v[j]) * uu[j];
                            } else {
                                load8(Y + off, y);
#pragma unroll
                                for (int j = 0; j < 8; ++j) y[j] += sigmoidf_(v[j]) * uu[j];
                            }
                            store8(Y + off, y);
                        } else {
                            const f32x4 x0 = *(const GAS f32x4*)(xin + off), x1 = *(const GAS f32x4*)(xin + off + 4);
                            *(GAS f32x4*)(xout + off) = (f32x4){x0[0] + v[0], x0[1] + v[1], x0[2] + v[2], x0[3] + v[3]};
                            *(GAS f32x4*)(xout + off + 4) = (f32x4){x1[0] + v[4], x1[1] + v[5], x1[2] + v[6], x1[3] + v[7]};
                        }
                        asm volatile("" ::: "memory");
                    }
                }
        }
    }
};

DI void transpose_item(const float* W, int K, int N, bf16_t* WT, int k0, int n0, int sc, LAS float* scr, int lane) {
    const int sc4 = __shfl(sc, 4 * (lane & 7));
#pragma unroll
    for (int i = 0; i < 8; ++i) {
        const int kk = 8 * i + (lane >> 3);
        const f32x4 w = sc4 >= 0 ? *(const GAS f32x4*)(W + (size_t)(k0 + kk) * N + sc4) : (f32x4){0.f, 0.f, 0.f, 0.f};
        LAS float* d = scr + kk * 33 + 4 * (lane & 7);
        d[0] = w.x; d[1] = w.y; d[2] = w.z; d[3] = w.w;
    }
    asm volatile("s_waitcnt lgkmcnt(0)" ::: "memory");
    const int c = lane & 7;
#pragma unroll
    for (int j = 0; j < 4; ++j) { const int n = (lane >> 3) + 8 * j; const LAS float* s = scr + (8 * c) * 33 + n;
        u32x4 o; o.x = pk2(s[0 * 33], s[1 * 33]); o.y = pk2(s[2 * 33], s[3 * 33]); o.z = pk2(s[4 * 33], s[5 * 33]); o.w = pk2(s[6 * 33], s[7 * 33]);
        *(GAS u32x4*)(WT + (size_t)(n0 + n) * K + k0 + 8 * c) = o; }
    asm volatile("s_waitcnt lgkmcnt(0)" ::: "memory");
}
DI int src_qk(int n) {
    const int tile = n >> 8, hs = (n >> 6) & 3, g = (n >> 3) & 7, e = n & 7, d = 4 * g + (e & 3) + 32 * (e >> 2);
    int base;
    switch (tile) {
        case 0: base = A_Q + 64 * hs; break; case 1: base = A_K + 64 * hs; break; case 2: base = B_Q + 64 * hs; break;
        case 3: base = hs == 0 ? B_KC : hs == 1 ? B_VC : hs == 2 ? B_KS : B_KW; break;
        case 4: base = C_Q + 64 * hs; break; case 5: base = C_K + 64 * hs; break;
        case 6: case 7: case 8: base = D_Q + 256 * (tile - 6) + 64 * hs; break;
        default: base = D_K + 256 * (tile - 9) + 64 * hs; break;
    }
    return base + d;
}
DI int src_v(int n) {
    const int slot = n >> 6, d = n & 63;
    if (slot < 4) return A_V + 64 * slot + d;
    if (slot < 8) return C_V + 64 * (slot - 4) + d;
    if (slot < 20) return D_V + 64 * (slot - 8) + d;
    if (slot == 20) return B_VS + d;
    if (slot == 21) return B_VW + d;
    if (slot == 22 && d < 12) return B_NG + d;
    return -1;
}
DI int src_g(int n) { const int br = n >> 8, c = n & 255; return (br == 0 ? A_G : br == 1 ? B_G : br == 2 ? C_G : D_G) + c; }

DI const bf16_t* launder_vp(const bf16_t* p) { asm volatile("" : "+v"(p)); return p; }
DI int kappa(int rho) { return (rho & 16) | ((rho & 4) << 1) | ((rho & 8) >> 1) | (rho & 3); }
DI bf16x8 ldfrag(const bf16_t* p) { return *(const GAS bf16x8*)p; }
DI bf16x8 pack8(const float* p) { u32x4 w; w.x = pk2(p[0], p[1]); w.y = pk2(p[2], p[3]); w.z = pk2(p[4], p[5]); w.w = pk2(p[6], p[7]); return __builtin_bit_cast(bf16x8, w); }

#define BLK_BAR() do { asm volatile("s_waitcnt lgkmcnt(0)" ::: "memory"); __builtin_amdgcn_s_barrier(); asm volatile("" ::: "memory"); } while (0)
struct SmState { f32x16 O[2]; float m, l; };
DI void sm_init(SmState& st) {
#pragma unroll
    for (int i = 0; i < 16; ++i) { st.O[0][i] = 0.f; st.O[1][i] = 0.f; }
    st.m = MFLOOR; st.l = 0.f;
}
struct Frag { bf16x8 k[4], v[2][2]; };
DI void ld_frag(Frag& f, const bf16_t* kp, const bf16_t* v0p, const bf16_t* v1p) {
#pragma unroll
    for (int s = 0; s < 4; ++s) f.k[s] = ldfrag(kp + 16 * s);
#pragma unroll
    for (int s = 0; s < 2; ++s) { f.v[0][s] = ldfrag(v0p + 16 * s); f.v[1][s] = ldfrag(v1p + 16 * s); }
}
struct FragG { u32x4 k[4], v[4]; };
constexpr int WLDS_BYTES = 4608 + 5120;
DI void ldg(FragG& g, const bf16_t* kq, size_t kstride, const bf16_t* vq, size_t vstride) {
#pragma unroll
    for (int j = 0; j < 4; ++j) g.k[j] = *(const GAS u32x4*)(kq + (size_t)(8 * j) * kstride);
#pragma unroll
    for (int j = 0; j < 4; ++j) g.v[j] = *(const GAS u32x4*)(vq + (size_t)(16 * j) * vstride);
}
DI void stage(const FragG& g, Frag& f, LAS unsigned char* wl, int lane) {
    const int r = lane & 31, h = lane >> 5;
    LAS u32x4* kw = (LAS u32x4*)(wl + (lane >> 3) * 144 + (lane & 7) * 16);
    LAS u32x4* vw = (LAS u32x4*)(wl + 4608 + (lane >> 2) * 80 + (lane & 3) * 16);
#pragma unroll
    for (int j = 0; j < 4; ++j) kw[j * 72] = g.k[j];
#pragma unroll
    for (int j = 0; j < 4; ++j) vw[j * 80] = g.v[j];
    asm volatile("" ::: "memory");
    const LAS unsigned char* kr = wl + kappa(r) * 144 + 16 * h;
    const LAS unsigned char* vr = wl + 4608 + r * 80 + 16 * h;
#pragma unroll
    for (int s = 0; s < 4; ++s) f.k[s] = *(const LAS bf16x8*)(kr + 32 * s);
#pragma unroll
    for (int s = 0; s < 2; ++s) { f.v[0][s] = *(const LAS bf16x8*)(vr + 32 * s); f.v[1][s] = *(const LAS bf16x8*)(vr + 32 * 80 + 32 * s); }
    asm volatile("" ::: "memory");
}
template <int MASK>
DI void sm_compute(SmState& st, const bf16x8 (&qf)[4], const Frag& f, int key0, bool allow, int klo, int khi) {
    f32x16 S;
#pragma unroll
    for (int i = 0; i < 16; ++i) S[i] = 0.f;
#pragma unroll
    for (int s = 0; s < 4; ++s) S = MFMA32(f.k[s], qf[s], S);
    const float neg = NEG, mfl = MFLOOR;
    float p[16]; float mx = mfl;
#pragma unroll
    for (int i = 0; i < 16; ++i) {
        float v = S[i];
        if (MASK == 2) { const int key = key0 + 16 * (i >> 3) + (i & 7); v = (allow && key >= klo && key <= khi) ? v : neg; }
        p[i] = v; mx = fmaxf(mx, v);
    }
    if (MASK == 1) mx = allow ? mx : mfl;
    mx = hmaxf_(mx);
    const float mn = fmaxf(st.m, mx), mc = mn * SM_C;
    const float mcl = (MASK == 1 && !allow) ? sconst(INFINITY) : mc;
    const f32x2 c2 = {SM_C, SM_C}, m2 = {mcl, mcl};
    f32x2 rs2 = {0.f, 0.f};
#pragma unroll
    for (int k = 0; k < 8; ++k) {
        const f32x2 x = (f32x2){p[2 * k], p[2 * k + 1]} * c2 - m2;
        const f32x2 e = {fexp2(x.x), fexp2(x.y)};
        p[2 * k] = e.x; p[2 * k + 1] = e.y; rs2 += e;
    }
    const float rs = rs2.x + rs2.y;
    if (__ballot(mn != st.m) != 0ull) {
        const float alpha = fexp2((st.m - mn) * SM_C);
        st.l *= alpha;
#pragma unroll
        for (int i = 0; i < 16; ++i) { st.O[0][i] *= alpha; st.O[1][i] *= alpha; }
    }
    st.l += rs; st.m = mn;
    const bf16x8 pf0 = pack8(p), pf1 = pack8(p + 8);
    st.O[0] = MFMA32(f.v[0][0], pf0, st.O[0]); st.O[0] = MFMA32(f.v[0][1], pf1, st.O[0]);
    st.O[1] = MFMA32(f.v[1][0], pf0, st.O[1]); st.O[1] = MFMA32(f.v[1][1], pf1, st.O[1]);
}
DI void write_o(bf16_t* orow, const f32x16 (&O)[2], float inv, int h) {
#pragma unroll
    for (int dt = 0; dt < 2; ++dt)
#pragma unroll
        for (int g = 0; g < 4; ++g) store4(orow + 32 * dt + 8 * g + 4 * h, O[dt][4 * g] * inv, O[dt][4 * g + 1] * inv, O[dt][4 * g + 2] * inv, O[dt][4 * g + 3] * inv);
}
DI void load_q(bf16x8 (&qf)[4], const bf16_t* qrow, int h) {
#pragma unroll
    for (int s = 0; s < 4; ++s) qf[s] = ldfrag(qrow + 16 * s + 8 * h);
}

struct SmTask { const bf16_t* qrow; const bf16_t* kb; const bf16_t* vb0; bf16_t* orow; float* lse; size_t kstride; int ti_lo, ti_hi, ti_edge, bshift, klo, khi; unsigned long long need, full, allow; };
DI int sm_next(int ti, int ti_hi, int bshift, unsigned long long need) {
    int nt = ti + 1;
    while (nt <= ti_hi) { if ((need >> (nt >> bshift)) & 1ull) return nt; nt = ((nt >> bshift) + 1) << bshift; }
    return -1;
}
DI void sm_step(SmState& st, const bf16x8 (&qf)[4], const Frag& f, const SmTask& tk, int ti, int h) {
    const int blk = ti >> tk.bshift;
    const bool allow = (tk.allow >> blk) & 1ull;
    if ((ti == tk.ti_hi) || (ti == tk.ti_edge)) sm_compute<2>(st, qf, f, 32 * ti + 8 * h, allow, tk.klo, tk.khi);
    else if (!((tk.full >> blk) & 1ull)) sm_compute<1>(st, qf, f, 32 * ti + 8 * h, allow, 0, 0);
    else sm_compute<0>(st, qf, f, 32 * ti + 8 * h, true, 0, 0);
}
DI void run_sm(const SmTask& tk, int lane, LAS unsigned char* wl) {
    const int h = lane >> 5;
    bf16x8 qf[4]; load_q(qf, tk.qrow, h);
    SmState st; sm_init(st);
    int ti = sm_next(tk.ti_lo - 1, tk.ti_hi, tk.bshift, tk.need);
    FragG GA, GB; Frag F;
    ldg(GA, tk.kb + (size_t)(32 * ti) * tk.kstride, tk.kstride, tk.vb0 + 32 * ti, T);
    for (;;) {
        int nt = sm_next(ti, tk.ti_hi, tk.bshift, tk.need); int lt = nt >= 0 ? nt : ti;
        ldg(GB, tk.kb + (size_t)(32 * lt) * tk.kstride, tk.kstride, tk.vb0 + 32 * lt, T);
        __builtin_amdgcn_sched_barrier(0);
        stage(GA, F, wl, lane);
        sm_step(st, qf, F, tk, ti, h);
        if (nt < 0) break;
        ti = nt;
        nt = sm_next(ti, tk.ti_hi, tk.bshift, tk.need); lt = nt >= 0 ? nt : ti;
        ldg(GA, tk.kb + (size_t)(32 * lt) * tk.kstride, tk.kstride, tk.vb0 + 32 * lt, T);
        __builtin_amdgcn_sched_barrier(0);
        stage(GB, F, wl, lane);
        sm_step(st, qf, F, tk, ti, h);
        if (nt < 0) break;
        ti = nt;
    }
    const float lt_ = hsumf_(st.l);
    write_o(tk.orow, st.O, frcp(lt_), h);
    if (tk.lse != nullptr && h == 0) *(GAS float*)tk.lse = st.m * SM_SCALE + flog2(lt_) * LN2;
}
DI unsigned long long bits_any(unsigned long long m, int n) {
    unsigned long long r = 0ull;
    for (int j = 0; j < n; ++j) if (__ballot((m >> j) & 1ull) != 0ull) r |= 1ull << j;
    return r;
}
DI unsigned long long bits_all(unsigned long long m, int n) {
    unsigned long long r = 0ull;
    for (int j = 0; j < n; ++j) if (__ballot((m >> j) & 1ull) == ~0ull) r |= 1ull << j;
    return r;
}
DI void task_sm(unsigned char* ws, int kind, int b, int hh, int qt, int lane, LAS unsigned char* wl) {
    const int r = lane & 31, kr = lane >> 3, kc = 8 * (lane & 7), vd = lane >> 2, vc = 8 * (lane & 3);
    const bf16_t* VT = (const bf16_t*)(ws + WS_VT);
    SmTask tk;
    tk.lse = nullptr; tk.kstride = 256; tk.ti_edge = -1; tk.klo = -1; tk.ti_lo = 0;
    if (kind <= 2) {
        const int t0 = 32 * qt, t = t0 + r; const size_t row = (size_t)(b * SEQ + t) * 256 + hh * 64;
        tk.ti_hi = qt; tk.khi = t;
        if (kind == 0) {
            const int cb = t0 >> 8;
            const unsigned long long mask = ((const GAS unsigned*)(ws + WS_MMASK))[(b * 4 + hh) * SEQ + t];
            tk.qrow = slot_ptr(ws, SL_QA) + row; tk.orow = slot_ptr(ws, SL_QA) + row;
            tk.kb = slot_ptr(ws, SL_KA) + (size_t)(b * SEQ + kr) * 256 + hh * 64 + kc;
            tk.vb0 = VT + (size_t)(hh * 64 + vd) * T + b * SEQ + vc;
            tk.bshift = 3; tk.allow = mask; tk.need = bits_any(mask, cb + 1); tk.full = bits_all(mask, cb + 1);
        } else if (kind == 1) {
            const int cur = t0 >> 6;
            const unsigned long long mask = ((const GAS unsigned long long*)(ws + WS_NMASK))[b * SEQ + t];
            tk.qrow = slot_ptr(ws, SL_QBR) + row; tk.orow = slot_ptr(ws, SL_OSLC) + row;
            tk.kb = slot_ptr(ws, SL_KB4) + (size_t)(b * SEQ + kr) * 256 + 128 + kc;
            tk.vb0 = VT + (size_t)(1280 + vd) * T + b * SEQ + vc;
            tk.bshift = 1; tk.allow = mask; tk.need = bits_any(mask, cur + 1); tk.full = bits_all(mask, cur + 1);
        } else {
            tk.qrow = slot_ptr(ws, SL_QBR) + row; tk.orow = slot_ptr(ws, SL_OWIN) + row;
            tk.kb = slot_ptr(ws, SL_KB4) + (size_t)(b * SEQ + kr) * 256 + 192 + kc;
            tk.vb0 = VT + (size_t)(1344 + vd) * T + b * SEQ + vc;
            tk.bshift = 8; tk.allow = 1ull; tk.need = 1ull; tk.full = 1ull;
            tk.ti_lo = qt - 16 < 0 ? 0 : qt - 16; tk.ti_edge = qt - 16; tk.klo = t - 511;
        }
    } else {
        const int g = kind - 3, dil = g == 0 ? 1 : g == 1 ? 4 : 16, L = SEQ / dil, nsub = 128 / dil, c = qt / nsub, sq = qt - c * nsub;
        const int mq = 32 * sq + r, tok = b * SEQ + mq * dil + c;
        bf16_t* qr = slot_ptr(ws, g == 0 ? SL_QD0 : g == 1 ? SL_QD1 : SL_QD2) + (size_t)tok * 256 + hh * 64;
        tk.qrow = qr; tk.orow = qr; tk.kstride = (size_t)256 * dil;
        tk.kb = slot_ptr(ws, SL_KD0 + g) + (size_t)(b * SEQ + c) * 256 + (size_t)kr * tk.kstride + hh * 64 + kc;
        tk.vb0 = VT + (size_t)(512 + 256 * g + hh * 64 + vd) * T + b * SEQ + (g == 0 ? 0 : c * L) + vc;
        tk.lse = (float*)(ws + WS_LSE) + ((size_t)g * T + tok) * 4 + hh;
        tk.bshift = 8; tk.allow = 1ull; tk.need = 1ull; tk.full = 1ull;
        tk.ti_hi = sq; tk.ti_lo = sq - 4 < 0 ? 0 : sq - 4; tk.ti_edge = sq - 4; tk.klo = mq - 128; tk.khi = mq;
    }
    run_sm(tk, lane, wl);
}

DI void frag_from_image(Frag& f, const LAS unsigned char* img, int lane) {
    const int r = lane & 31, h = lane >> 5;
    const LAS unsigned char* kr = img + kappa(r) * 144 + 16 * h;
    const LAS unsigned char* vr = img + 4608 + r * 80 + 16 * h;
#pragma unroll
    for (int s = 0; s < 4; ++s) f.k[s] = *(const LAS bf16x8*)(kr + 32 * s);
#pragma unroll
    for (int s = 0; s < 2; ++s) { f.v[0][s] = *(const LAS bf16x8*)(vr + 32 * s); f.v[1][s] = *(const LAS bf16x8*)(vr + 32 * 80 + 32 * s); }
}
DI void run_heavy_group(unsigned char* ws, int kind, int b, int hh_in, int qg, int wave, int lane, int tid, LAS unsigned char* img) {
    const int r = lane & 31, h = lane >> 5;
    const bool packed = kind >= 1;
    const int hh = packed ? (wave & 3) : hh_in, qt = packed ? 2 * qg + (wave >> 2) : 8 * qg + wave, t0 = 32 * qt, t = t0 + r;
    const int tend = packed ? 2 * qg + 1 : 8 * qg + 7, tbeg = kind == 2 ? (2 * qg - 16 < 0 ? 0 : 2 * qg - 16) : 0;
    const size_t row = (size_t)(b * SEQ + t) * 256 + hh * 64;
    SmTask tk; tk.lse = nullptr; tk.kstride = 256; tk.ti_edge = -1; tk.klo = -1; tk.ti_lo = 0; tk.ti_hi = qt; tk.khi = t; tk.kb = nullptr; tk.vb0 = nullptr;
    const bf16_t* gp; size_t gstep; int woff;
    if (kind == 0) {
        const int cb = t0 >> 8;
        const unsigned long long mask = ((const GAS unsigned*)(ws + WS_MMASK))[(b * 4 + hh) * SEQ + t];
        tk.qrow = slot_ptr(ws, SL_QA) + row; tk.orow = slot_ptr(ws, SL_QA) + row;
        tk.bshift = 3; tk.allow = mask; tk.need = bits_any(mask, cb + 1); tk.full = bits_all(mask, cb + 1);
        if (tid < 256) { gp = slot_ptr(ws, SL_KA) + (size_t)(b * SEQ + (tid >> 3)) * 256 + hh * 64 + 8 * (tid & 7); gstep = (size_t)32 * 256; woff = (tid >> 3) * 144 + (tid & 7) * 16; }
        else { const int t2 = tid - 256; gp = (const bf16_t*)(ws + WS_VT) + (size_t)(hh * 64 + (t2 >> 2)) * T + b * SEQ + 8 * (t2 & 3); gstep = 32; woff = 4608 + (t2 >> 2) * 80 + (t2 & 3) * 16; }
    } else {
        if (kind == 1) {
            const int cur = t0 >> 6;
            const unsigned long long mask = ((const GAS unsigned long long*)(ws + WS_NMASK))[b * SEQ + t];
            tk.qrow = slot_ptr(ws, SL_QBR) + row; tk.orow = slot_ptr(ws, SL_OSLC) + row;
            tk.bshift = 1; tk.allow = mask; tk.need = bits_any(mask, cur + 1); tk.full = bits_all(mask, cur + 1);
        } else {
            tk.qrow = slot_ptr(ws, SL_QBR) + row; tk.orow = slot_ptr(ws, SL_OWIN) + row;
            tk.bshift = 8; tk.allow = 1ull; tk.need = 1ull; tk.full = 1ull;
            tk.ti_lo = qt - 16 < 0 ? 0 : qt - 16; tk.ti_edge = qt - 16; tk.klo = t - 511;
        }
        const int koff = kind == 1 ? 128 : 192, vrow = kind == 1 ? 1280 : 1344;
        if (tid < 256) { gp = slot_ptr(ws, SL_KB4) + (size_t)(b * SEQ + (tid >> 3)) * 256 + koff + 8 * (tid & 7); gstep = (size_t)32 * 256; woff = (tid >> 3) * 144 + (tid & 7) * 16; }
        else { const int t2 = tid - 256; gp = (const bf16_t*)(ws + WS_VT) + (size_t)(vrow + (t2 >> 2)) * T + b * SEQ + 8 * (t2 & 3); gstep = 32; woff = 4608 + (t2 >> 2) * 80 + (t2 & 3) * 16; }
    }
    bf16x8 qf[4]; load_q(qf, tk.qrow, h);
    SmState st; sm_init(st);
    LAS unsigned char* img0 = img; LAS unsigned char* img1 = img + WLDS_BYTES;
    int ti = tbeg;
    u32x4 r0 = *(const GAS u32x4*)(gp + gstep * (size_t)ti);
    u32x4 r1 = *(const GAS u32x4*)(gp + gstep * (size_t)(ti + 1 > tend ? tend : ti + 1));
    *(LAS u32x4*)(img0 + woff) = r0;
    r0 = *(const GAS u32x4*)(gp + gstep * (size_t)(ti + 2 > tend ? tend : ti + 2));
    BLK_BAR();
    Frag F;
    for (;;) {
        if (ti >= tk.ti_lo && ti <= tk.ti_hi && ((tk.need >> (ti >> tk.bshift)) & 1ull)) { frag_from_image(F, img0, lane); sm_step(st, qf, F, tk, ti, h); }
        if (ti == tend) break;
        *(LAS u32x4*)(img1 + woff) = r1;
        r1 = *(const GAS u32x4*)(gp + gstep * (size_t)(ti + 3 > tend ? tend : ti + 3));
        BLK_BAR(); ++ti;
        if (ti >= tk.ti_lo && ti <= tk.ti_hi && ((tk.need >> (ti >> tk.bshift)) & 1ull)) { frag_from_image(F, img1, lane); sm_step(st, qf, F, tk, ti, h); }
        if (ti == tend) break;
        *(LAS u32x4*)(img0 + woff) = r0;
        r0 = *(const GAS u32x4*)(gp + gstep * (size_t)(ti + 3 > tend ? tend : ti + 3));
        BLK_BAR(); ++ti;
    }
    const float lt_ = hsumf_(st.l);
    write_o(tk.orow, st.O, frcp(lt_), h);
}

DI void stick_compute(f32x16 (&O)[2], float& carry, const bf16x8 (&qf)[4], const Frag& f, int kt0, int t, int h) {
    f32x16 S;
#pragma unroll
    for (int i = 0; i < 16; ++i) S[i] = 0.f;
#pragma unroll
    for (int s = 0; s < 4; ++s) S = MFMA32(f.k[s], qf[s], S);
    float lsm[16], ls[16]; float sA = 0.f, sB = 0.f;
    const int key0 = kt0 + 8 * h; const float neg = NEG;
#pragma unroll
    for (int i = 0; i < 16; ++i) {
        const int key = key0 + 16 * (i >> 3) + (i & 7);
        const bool valid = key < t;
        const float z = S[i] * SM_SCALE;
        const float sp = fmaxf(z, 0.f) + flog2(1.f + fexp2(-fabsf(z) * LOG2E)) * LN2;
        lsm[i] = valid ? -sp : 0.f;
        ls[i] = valid ? z - sp : neg;
        if (i < 8) sA += lsm[i]; else sB += lsm[i];
    }
    const float pA = xhalf(sA), pB = xhalf(sB);
    const float baseB = carry + (h == 0 ? pB : 0.f), baseA = carry + sB + pB + (h == 0 ? pA : 0.f);
    float p[16]; float run = baseA;
#pragma unroll
    for (int e = 7; e >= 0; --e) { p[e] = fexp2((ls[e] + run) * LOG2E); run += lsm[e]; }
    run = baseB;
#pragma unroll
    for (int e = 15; e >= 8; --e) { p[e] = fexp2((ls[e] + run) * LOG2E); run += lsm[e]; }
    carry += (sA + sB) + (pA + pB);
    const bf16x8 pf0 = pack8(p), pf1 = pack8(p + 8);
    O[0] = MFMA32(f.v[0][0], pf0, O[0]); O[0] = MFMA32(f.v[0][1], pf1, O[0]);
    O[1] = MFMA32(f.v[1][0], pf0, O[1]); O[1] = MFMA32(f.v[1][1], pf1, O[1]);
}
DI void task_stick(unsigned char* ws, int b, int hh, int qt, int lane, LAS unsigned char* wl) {
    const int r = lane & 31, h = lane >> 5, t0 = 32 * qt, t = t0 + r;
    bf16_t* qrow = slot_ptr(ws, SL_QC) + (size_t)(b * SEQ + t) * 256 + hh * 64;
    bf16x8 qf[4]; load_q(qf, qrow, h);
    const bf16_t* kb = slot_ptr(ws, SL_KC) + (size_t)(b * SEQ + (lane >> 3)) * 256 + hh * 64 + 8 * (lane & 7);
    const bf16_t* vb0 = (const bf16_t*)(ws + WS_VT) + (size_t)(256 + hh * 64 + (lane >> 2)) * T + b * SEQ + 8 * (lane & 3);
    f32x16 O[2];
#pragma unroll
    for (int i = 0; i < 16; ++i) { O[0][i] = 0.f; O[1][i] = 0.f; }
    float carry = 0.f;
    int kt0 = t0;
    FragG GA, GB; Frag F;
    ldg(GA, kb + (size_t)kt0 * 256, 256, vb0 + kt0, T);
    for (;;) {
        int nk = kt0 - 32, lk = nk >= 0 ? nk : kt0;
        ldg(GB, kb + (size_t)lk * 256, 256, vb0 + lk, T);
        __builtin_amdgcn_sched_barrier(0);
        stage(GA, F, wl, lane);
        stick_compute(O, carry, qf, F, kt0, t, h);
        if (nk < 0 || __ballot(carry > -104.f) == 0ull) break;
        kt0 = nk; nk = kt0 - 32; lk = nk >= 0 ? nk : kt0;
        ldg(GA, kb + (size_t)lk * 256, 256, vb0 + lk, T);
        __builtin_amdgcn_sched_barrier(0);
        stage(GB, F, wl, lane);
        stick_compute(O, carry, qf, F, kt0, t, h);
        if (nk < 0 || __ballot(carry > -104.f) == 0ull) break;
        kt0 = nk;
    }
    write_o(qrow, O, 1.f, h);
}

DI void task_cmp(unsigned char* ws, int b, int qt, int lane, LAS float* imp, int hh0, int nh, bool leader) {
    const int r = lane & 31, h = lane >> 5, t0 = 32 * qt, t = t0 + r, cur = t0 >> 6;
    const int nvis = t >= 31 ? ((t - 31) >> 4) + 1 : 0;
    const int nvmax = (t0 >> 4) + 1, ntile = (nvmax + 31) >> 5;
    const bool need_imp = cur >= 16;
    if (leader) { for (int i = lane; i < 32 * 65; i += 64) imp[i] = 0.f; }
    BLK_BAR();
    const bf16_t* kb_ = (const bf16_t*)(ws + WS_KCMP) + (size_t)(b * 256 + kappa(r)) * 64 + 8 * h;
    const bf16_t* vb0_ = (const bf16_t*)(ws + WS_VCMPT) + (size_t)(b * 64 + r) * 256 + 8 * h;
    for (int hh = hh0; hh < hh0 + nh; ++hh) {
        const bf16_t* kb = launder_vp(kb_); const bf16_t* vb0 = launder_vp(vb0_); const bf16_t* vb1 = vb0 + 32 * 256;
        bf16_t* qrow = slot_ptr(ws, SL_QB) + (size_t)(b * SEQ + t) * 256 + hh * 64;
        bf16x8 qf[4]; load_q(qf, qrow, h);
        float m = MFLOOR, l = 0.f;
        bf16x8 kn[4];
#pragma unroll
        for (int s = 0; s < 4; ++s) kn[s] = ldfrag(kb + 16 * s);
        for (int tl = 0; tl < ntile; ++tl) {
            bf16x8 kf[4];
#pragma unroll
            for (int s = 0; s < 4; ++s) kf[s] = kn[s];
            const int nl = tl + 1 < ntile ? tl + 1 : tl;
#pragma unroll
            for (int s = 0; s < 4; ++s) kn[s] = ldfrag(kb + (size_t)(32 * nl) * 64 + 16 * s);
            f32x16 S;
#pragma unroll
            for (int i = 0; i < 16; ++i) S[i] = 0.f;
#pragma unroll
            for (int s = 0; s < 4; ++s) S = MFMA32(kf[s], qf[s], S);
            const float neg = NEG; float mx = MFLOOR;
#pragma unroll
            for (int i = 0; i < 16; ++i) { const int key = 32 * tl + 8 * h + 16 * (i >> 3) + (i & 7); const float v = key < nvis ? S[i] : neg; S[i] = v; mx = fmaxf(mx, v); }
            mx = hmaxf_(mx);
            const float mn = fmaxf(m, mx), mc = mn * SM_C;
            float rs = 0.f;
#pragma unroll
            for (int i = 0; i < 16; ++i) rs += fexp2(S[i] * SM_C - mc);
            l = l * fexp2((m - mn) * SM_C) + rs; m = mn;
        }
        const float lt = hsumf_(l);
        const float inv = nvis > 0 ? frcp(lt) : 0.f, mc = m * SM_C;
        f32x16 O[2];
#pragma unroll
        for (int i = 0; i < 16; ++i) { O[0][i] = 0.f; O[1][i] = 0.f; }
        Frag fn; ld_frag(fn, kb, vb0, vb1);
        for (int tl = 0; tl < ntile; ++tl) {
            bf16x8 kf[4], vf[2][2];
#pragma unroll
            for (int s = 0; s < 4; ++s) kf[s] = fn.k[s];
#pragma unroll
            for (int s = 0; s < 2; ++s) { vf[0][s] = fn.v[0][s]; vf[1][s] = fn.v[1][s]; }
            const int nl = tl + 1 < ntile ? tl + 1 : tl;
            ld_frag(fn, kb + (size_t)(32 * nl) * 64, vb0 + 32 * nl, vb1 + 32 * nl);
            f32x16 S;
#pragma unroll
            for (int i = 0; i < 16; ++i) S[i] = 0.f;
#pragma unroll
            for (int s = 0; s < 4; ++s) S = MFMA32(kf[s], qf[s], S);
            float p[16];
#pragma unroll
            for (int i = 0; i < 16; ++i) { const int key = 32 * tl + 8 * h + 16 * (i >> 3) + (i & 7); p[i] = key < nvis ? fexp2(S[i] * SM_C - mc) * inv : 0.f; }
            if (need_imp) {
#pragma unroll
                for (int a = 0; a < 2; ++a) {
                    const int u = 4 * tl + 2 * a + h; const float* q = p + 8 * a;
                    LAS float* row = imp + r * 65 + 2 * u;
                    atomicAdd((float*)(row + 0), (q[0] + q[1]) + (q[2] + q[3]));
                    atomicAdd((float*)(row + 1), (q[3] + q[4]) + (q[5] + q[6]) + q[7]);
                    if (2 * u + 2 < 64) atomicAdd((float*)(row + 2), q[7]);
                }
            }
            const bf16x8 pf0 = pack8(p), pf1 = pack8(p + 8);
            O[0] = MFMA32(vf[0][0], pf0, O[0]); O[0] = MFMA32(vf[0][1], pf1, O[0]);
            O[1] = MFMA32(vf[1][0], pf0, O[1]); O[1] = MFMA32(vf[1][1], pf1, O[1]);
        }
        write_o(qrow, O, 1.f, h);
    }
    asm volatile("s_waitcnt lgkmcnt(0)" ::: "memory");
    BLK_BAR();
    if (leader) {
        unsigned long long mask;
        if (cur <= 15) mask = (2ull << cur) - 1ull;
        else {
            float v[32];
#pragma unroll
            for (int i = 0; i < 32; ++i) v[i] = imp[r * 65 + 2 * i + h];
            mask = 1ull | (1ull << cur) | (1ull << (cur - 1));
            for (int k = 0; k < 13; ++k) {
                float best = -1.f; int bj = 64;
#pragma unroll
                for (int i = 0; i < 32; ++i) { const int j = 2 * i + h; const bool ok = j >= 1 && j <= cur - 2 && !((mask >> j) & 1ull); if (ok && v[i] > best) { best = v[i]; bj = j; } }
                const float ob = xhalf(best); const int oj = __shfl_xor(bj, 32);
                if (ob > best || (ob == best && oj < bj)) { best = ob; bj = oj; }
                if (bj < 64) mask |= 1ull << bj;
            }
        }
        if (lane < 32) ((GAS unsigned long long*)(ws + WS_NMASK))[b * SEQ + t] = mask;
    }
    asm volatile("s_waitcnt lgkmcnt(0)" ::: "memory");
}

DI void task_moba_gate(unsigned char* ws, int b, int hh, int qt, int lane) {
    const int r = lane & 31, h = lane >> 5, t0 = 32 * qt, t = t0 + r, cb = t0 >> 8;
    unsigned sel = 0u;
    if (cb <= 3) sel = (1u << cb) - 1u;
    else {
        const bf16_t* qrow = slot_ptr(ws, SL_QA) + (size_t)(b * SEQ + t) * 256 + hh * 64 + 32 * h;
        float q[32];
#pragma unroll
        for (int j = 0; j < 4; ++j) { float f[8]; load8(qrow + 8 * j, f);
#pragma unroll
            for (int e = 0; e < 8; ++e) q[8 * j + e] = f[e]; }
        const GAS float* km = (const GAS float*)(ws + WS_KMEAN) + (size_t)((b * 4 + hh) * 16) * 64 + 32 * h;
        float gate[16];
#pragma unroll
        for (int n = 0; n < 16; ++n) {
            float s = 0.f;
            if (n < cb) {
#pragma unroll
                for (int d = 0; d < 32; ++d) s += q[d] * km[n * 64 + d];
            }
            s += xhalf(s);
            gate[n] = n < cb ? s : sconst(-INFINITY);
        }
#pragma unroll
        for (int k = 0; k < 3; ++k) {
            float best = sconst(-INFINITY); int bi = -1;
#pragma unroll
            for (int n = 0; n < 16; ++n) if (!((sel >> n) & 1u) && gate[n] > best) { best = gate[n]; bi = n; }
            if (bi >= 0) sel |= 1u << bi;
        }
    }
    if (lane < 32) ((GAS unsigned*)(ws + WS_MMASK))[(b * 4 + hh) * SEQ + t] = sel | (1u << cb);
}

DI void task_kmean(unsigned char* ws, int b, int hh, int blk, int lane) {
    const bf16_t* kp = slot_ptr(ws, SL_KA) + (size_t)(b * SEQ + 256 * blk + (lane >> 3)) * 256 + hh * 64 + 8 * (lane & 7);
    float s[8];
#pragma unroll
    for (int e = 0; e < 8; ++e) s[e] = 0.f;
#pragma unroll 8
    for (int i = 0; i < 32; ++i) { float f[8]; load8(kp + (size_t)(8 * i) * 256, f);
#pragma unroll
        for (int e = 0; e < 8; ++e) s[e] += f[e]; }
#pragma unroll
    for (int e = 0; e < 8; ++e) { s[e] += __shfl_xor(s[e], 8); s[e] += __shfl_xor(s[e], 16); s[e] += __shfl_xor(s[e], 32); }
    if (lane < 8) {
        GAS float* o = (GAS float*)(ws + WS_KMEAN) + ((b * 4 + hh) * 16 + blk) * 64 + 8 * lane;
#pragma unroll
        for (int e = 0; e < 8; ++e) o[e] = s[e] * (1.f / 256.f);
    }
}

DI void task_mlp_block(unsigned char* ws, int kv, int b, int rt, int wave, int lane, LAS float* part) {
    const int r = lane & 31, h = lane >> 5, n = 32 * rt + r, ne = n > 254 ? 254 : n;
    const bf16_t* xp = slot_ptr(ws, SL_KB4) + (size_t)(b * SEQ + 16 * ne) * 256 + kv * 64 + 8 * h;
    const bf16_t* w1 = (const bf16_t*)(ws + WS_W1T) + (size_t)(kv * 256 + 32 * wave + kappa(r)) * 2048 + 8 * h;
    f32x16 acc;
#pragma unroll
    for (int i = 0; i < 16; ++i) acc[i] = 0.f;
    bf16x8 xa[4], wa[4], xb[4], wb[4];
#pragma unroll
    for (int s = 0; s < 4; ++s) { xa[s] = ldfrag(xp + 16 * s); wa[s] = ldfrag(w1 + 16 * s); }
    for (int l = 0; l < 32; l += 2) {
#pragma unroll
        for (int s = 0; s < 4; ++s) { xb[s] = ldfrag(xp + (size_t)(l + 1) * 256 + 16 * s); wb[s] = ldfrag(w1 + 64 * (l + 1) + 16 * s); }
#pragma unroll
        for (int s = 0; s < 4; ++s) acc = MFMA32(wa[s], xa[s], acc);
        const int l2 = l + 2 < 32 ? l + 2 : l;
#pragma unroll
        for (int s = 0; s < 4; ++s) { xa[s] = ldfrag(xp + (size_t)l2 * 256 + 16 * s); wa[s] = ldfrag(w1 + 64 * l2 + 16 * s); }
#pragma unroll
        for (int s = 0; s < 4; ++s) acc = MFMA32(wb[s], xb[s], acc);
    }
    const GAS float* bias = (const GAS float*)(ws + WS_BIAS) + kv * 256 + 32 * wave;
    const bf16_t* w2 = (const bf16_t*)(ws + WS_W2T) + (size_t)(kv * 64 + r) * 256 + 32 * wave + 8 * h;
    float g[16];
#pragma unroll
    for (int i = 0; i < 16; ++i) {
        const float x = acc[i] + bias[16 * (i >> 3) + 8 * h + (i & 7)];
        const float y = 0.7978845608028654f * (x + 0.044715f * x * x * x);
        const float th = 1.f - 2.f * frcp(1.f + fexp2(2.f * LOG2E * y));
        g[i] = 0.5f * x * (1.f + th);
    }
    const bf16x8 pf0 = pack8(g), pf1 = pack8(g + 8);
    f32x16 out[2];
#pragma unroll
    for (int i = 0; i < 16; ++i) { out[0][i] = 0.f; out[1][i] = 0.f; }
#pragma unroll
    for (int dt = 0; dt < 2; ++dt) {
        out[dt] = MFMA32(ldfrag(w2 + (size_t)(32 * dt) * 256), pf0, out[dt]);
        out[dt] = MFMA32(ldfrag(w2 + (size_t)(32 * dt) * 256 + 16), pf1, out[dt]);
    }
#pragma unroll
    for (int dt = 0; dt < 2; ++dt)
#pragma unroll
        for (int i = 0; i < 16; ++i) part[((wave * 2 + dt) * 16 + i) * 64 + lane] = out[dt][i];
    __syncthreads();
    const int dt = wave >> 2, gq = wave & 3;
    float sum[4];
#pragma unroll
    for (int e = 0; e < 4; ++e) { float a = 0.f;
#pragma unroll
        for (int w = 0; w < 8; ++w) a += part[((w * 2 + dt) * 16 + 4 * gq + e) * 64 + lane];
        sum[e] = n <= 254 ? a : 0.f; }
    const int d0 = 32 * dt + 8 * gq + 4 * h;
    if (kv == 0) store4((bf16_t*)(ws + WS_KCMP) + (size_t)(b * 256 + n) * 64 + d0, sum[0], sum[1], sum[2], sum[3]);
    else {
        bf16_t* vt = (bf16_t*)(ws + WS_VCMPT) + (size_t)(b * 64 + d0) * 256 + n;
#pragma unroll
        for (int e = 0; e < 4; ++e) ((GAS bf16_t*)vt)[e * 256] = (bf16_t)(pk2(sum[e], 0.f) & 0xffffu);
    }
    __syncthreads();
}

struct Args { const float* in[9]; float* out; unsigned char* ws; int pad0, pad1; };

DI int launder(int x) { asm volatile("" : "+v"(x)); return x; }
DI unsigned char* launder_p(unsigned char* p) { asm volatile("" : "+s"(p)); return (unsigned char*)(__attribute__((address_space(1))) unsigned char*)p; }
#define FRESH() const int tid = launder(tid0), lane = tid & 63, gw = blockIdx.x * NWAVES + wave; (void)gw; (void)lane; unsigned char* ws = launder_p(ws0); (void)ws;
DI int next_task(unsigned* ctr, int lane) {
    int v = 0;
    if (lane == 0) v = (int)atomicAdd(ctr, 1u);
    return __builtin_amdgcn_readfirstlane(v);
}

#ifndef PROBE_A
#define PROBE_A 0
#define PROBE_B 0
#endif
enum { ST_P0 = 0, ST_BIAS, ST_G_QK, ST_G_VT, ST_P2, ST_P3, ST_P4, ST_G_GATE, ST_G_U0, ST_G_M0, ST_G_U1, ST_G_M1, ST_G_U2, ST_G_M2, ST_G_U3, ST_G_M3, ST_G_OUT, NSTEP_LAYER };

__global__ void __launch_bounds__(NWAVES * 64, 2) mega_fwd(Args a) {
    extern __shared__ __attribute__((aligned(16))) unsigned char lds_raw[];
    cg::grid_group grid = cg::this_grid();
    LAS unsigned char* lds = (LAS unsigned char*)lds_raw;
    const int tid0 = threadIdx.x, wave = __builtin_amdgcn_readfirstlane(tid0 >> 6);
    const int G = gridDim.x, NGW = G * NWAVES;
    unsigned char* ws0 = a.ws;

    if (blockIdx.x == 0) { for (int i = tid0; i < CTL_BYTES / 4; i += NWAVES * 64) ((GAS unsigned*)(ws0 + WS_CTL))[i] = 0u; }
    { FRESH();
    for (int e = blockIdx.x * (NWAVES * 64) + tid; e < SEQ * 32; e += G * NWAVES * 64) {
        const int pos = e >> 5, i = e & 31;
        const float inv = (float)exp2(-(double)i * (13.287712379549449 / 32.0));
        const float ang = (float)pos * inv;
        const double x = (double)ang, kq = rint(x * 0.6366197723675814);
        const double rr = (x - kq * 1.5707963267948966) - kq * 6.123233995736766e-17, r2 = rr * rr;
        const double sn = rr * (1.0 + r2 * (-1.0 / 6 + r2 * (1.0 / 120 + r2 * (-1.0 / 5040 + r2 * (1.0 / 362880 + r2 * (-1.0 / 39916800 + r2 * (1.0 / 6227020800.0)))))));
        const double cs = 1.0 + r2 * (-0.5 + r2 * (1.0 / 24 + r2 * (-1.0 / 720 + r2 * (1.0 / 40320 + r2 * (-1.0 / 3628800 + r2 * (1.0 / 479001600 + r2 * (-1.0 / 87178291200.0)))))));
        const int qd = (int)((long long)kq & 3);
        const double s_ = qd == 0 ? sn : qd == 1 ? cs : qd == 2 ? -sn : -cs, c_ = qd == 0 ? cs : qd == 1 ? -sn : qd == 2 ? -cs : sn;
        ((float*)(ws + WS_COS))[e] = (float)c_; ((float*)(ws + WS_SIN))[e] = (float)s_;
    } }

    for (int step = 0; step <= DEPTH * NSTEP_LAYER; ++step) {
        const int layer = step / NSTEP_LAYER, ls = step - layer * NSTEP_LAYER;
#if PROBE_A || PROBE_B
        if (blockIdx.x == 0 && tid0 == 0) ((unsigned long long*)(ws0 + WS_CTL + 2048))[32] = wall_clock64();
#endif
        if (layer == DEPTH) {
            FRESH(); const float* fw = a.in[8];
#if PROBE_A || PROBE_B
            float pa = 0.f, pb = 0.f;
            { const unsigned long long* tacc = (const unsigned long long*)(ws + WS_CTL + 2048);
              for (int k = 0; k < NSTEP_LAYER; ++k) { const float ms = (float)tacc[k] * 1e-5f; if ((PROBE_B >> k) & 1) pb += 0.002f * ms; } }
#endif
            for (int m = gw; m < T; m += 4 * NGW) {
                const GAS f32x4* wr4 = (const GAS f32x4*)fw + lane;
                f32x4 v[4][4]; float ss[4]; int mr[4];
#pragma unroll
                for (int q = 0; q < 4; ++q) { mr[q] = m + q * NGW < T ? m + q * NGW : m;
#pragma unroll
                    for (int j = 0; j < 4; ++j) v[q][j] = ((const GAS f32x4*)(a.out + (size_t)mr[q] * D) + lane)[64 * j]; }
                const float eps = sconst(1e-6f);
#pragma unroll
                for (int q = 0; q < 4; ++q) { float s = 0.f;
#pragma unroll
                    for (int j = 0; j < 4; ++j) s += (v[q][j].x * v[q][j].x + v[q][j].y * v[q][j].y) + (v[q][j].z * v[q][j].z + v[q][j].w * v[q][j].w);
                    ss[q] = rsqrtf(wave_sum(s) * (1.f / D) + eps); }
#pragma unroll
                for (int j = 0; j < 4; ++j) { const f32x4 w = wr4[64 * j];
#pragma unroll
                    for (int q = 0; q < 4; ++q) { f32x4 o = (f32x4){v[q][j].x * ss[q] * w.x, v[q][j].y * ss[q] * w.y, v[q][j].z * ss[q] * w.z, v[q][j].w * ss[q] * w.w};
#if PROBE_A || PROBE_B
                        o = o + ((lane & 1) ? pb : -pb); (void)pa;
#endif
                        if (q == 0 || mr[q] != m) ((GAS f32x4*)(a.out + (size_t)mr[q] * D) + lane)[64 * j] = o; } }
            }
            break;
        }
        const float* xin = layer == 0 ? a.in[0] : a.out;
        bool sync = false;
        if (ls == ST_P0) {
            const float* norm_w = a.in[1] + (size_t)layer * D;
            const float* w_in = a.in[2] + (size_t)layer * D * INW;
            const float* cmp_pos = a.in[3] + (size_t)layer * 2 * 2048;
            const float* cmp_w1 = a.in[4] + (size_t)layer * 2 * 2048 * 256;
            const float* cmp_w2 = a.in[5] + (size_t)layer * 2 * 256 * 64;
            const float* w_up = a.in[6] + (size_t)layer * 4 * 256 * D;
            const float* w_out = a.in[7] + (size_t)layer * D * D;
            FRESH(); LAS float* scr = (LAS float*)(lds + wave * 16384); bf16_t* Hb = (bf16_t*)(ws + WS_H);
            constexpr int I_QK = 16 * (NQK / 32), I_V = 16 * (NV / 32), I_G = 16 * 32, I_M = 16 * 128, I_UP = 4 * 4 * 32, I_OUT = 16 * 32, I_W1 = 2 * 32 * 8, I_W2 = 2 * 4 * 2;
            constexpr int NITEMS = I_QK + I_V + I_G + I_M + I_UP + I_OUT + I_W1 + I_W2;
            for (int it = gw; it < NITEMS; it += NGW) {
                int q = it;
                if (q < I_QK) { const int kb = q / (NQK / 32), nb = q % (NQK / 32); transpose_item(w_in, D, INW, (bf16_t*)(ws + WS_WQK), 64 * kb, 32 * nb, src_qk(32 * nb + (lane & 31)), scr, lane); continue; } q -= I_QK;
                if (q < I_V) { const int kb = q / (NV / 32), nb = q % (NV / 32); transpose_item(w_in, D, INW, (bf16_t*)(ws + WS_WV), 64 * kb, 32 * nb, src_v(32 * nb + (lane & 31)), scr, lane); continue; } q -= I_V;
                if (q < I_G) { const int kb = q / 32, nb = q % 32; transpose_item(w_in, D, INW, (bf16_t*)(ws + WS_WG), 64 * kb, 32 * nb, src_g(32 * nb + (lane & 31)), scr, lane); continue; } q -= I_G;
                if (q < I_M) { const int kb = q / 128, nb = q % 128; transpose_item(w_in, D, INW, (bf16_t*)(ws + WS_WM), 64 * kb, 32 * nb, MRG + 32 * nb + (lane & 31), scr, lane); continue; } q -= I_M;
                if (q < I_UP) { const int br = q / 128, q2 = q % 128, kb = q2 / 32, nb = q2 % 32; transpose_item(w_up + (size_t)br * 256 * D, 256, D, (bf16_t*)(ws + WS_WUP) + (size_t)br * D * 256, 64 * kb, 32 * nb, 32 * nb + (lane & 31), scr, lane); continue; } q -= I_UP;
                if (q < I_OUT) { const int kb = q / 32, nb = q % 32; transpose_item(w_out, D, D, (bf16_t*)(ws + WS_WOUT), 64 * kb, 32 * nb, 32 * nb + (lane & 31), scr, lane); continue; } q -= I_OUT;
                if (q < I_W1) { const int kv = q / 256, q2 = q % 256, kb = q2 / 8, nb = q2 % 8; transpose_item(cmp_w1 + (size_t)kv * 2048 * 256, 2048, 256, (bf16_t*)(ws + WS_W1T) + (size_t)kv * 256 * 2048, 64 * kb, 32 * nb, 32 * nb + (lane & 31), scr, lane); continue; } q -= I_W1;
                { const int kv = q / 8, q2 = q % 8, kb = q2 / 2, nb = q2 % 2; transpose_item(cmp_w2 + (size_t)kv * 256 * 64, 256, 64, (bf16_t*)(ws + WS_W2T) + (size_t)kv * 64 * 256, 64 * kb, 32 * nb, 32 * nb + (lane & 31), scr, lane); }
            }
            for (int it = gw; it < 2 * 4 * 32; it += NGW) {
                const int ch = it & 31, hg = (it >> 5) & 3, kv = it >> 7;
                const float* w1 = cmp_w1 + (size_t)kv * 2048 * 256 + (size_t)(64 * ch) * 256 + 64 * hg + lane; const float* pe = cmp_pos + kv * 2048 + 64 * ch;
                float s = 0.f;
#pragma unroll 8
                for (int f = 0; f < 64; ++f) s += pe[f] * w1[(size_t)f * 256];
                ((float*)(ws + WS_BIASP))[(ch * 2 + kv) * 256 + 64 * hg + lane] = s;
            }
            for (int m = gw; m < T; m += 2 * NGW) {
                const int m1 = m + NGW < T ? m + NGW : m;
                const GAS f32x4* xr0 = (const GAS f32x4*)(xin + (size_t)m * D) + lane; const GAS f32x4* xr1 = (const GAS f32x4*)(xin + (size_t)m1 * D) + lane; const GAS f32x4* wr4 = (const GAS f32x4*)norm_w + lane;
                f32x4 v0[4], v1[4]; float s0 = 0.f, s1 = 0.f;
#pragma unroll
                for (int j = 0; j < 4; ++j) { v0[j] = xr0[64 * j]; v1[j] = xr1[64 * j]; }
#pragma unroll
                for (int j = 0; j < 4; ++j) { s0 += (v0[j].x * v0[j].x + v0[j].y * v0[j].y) + (v0[j].z * v0[j].z + v0[j].w * v0[j].w); s1 += (v1[j].x * v1[j].x + v1[j].y * v1[j].y) + (v1[j].z * v1[j].z + v1[j].w * v1[j].w); }
                const float eps = sconst(1e-6f);
                const float rs0 = rsqrtf(wave_sum(s0) * (1.f / D) + eps), rs1 = rsqrtf(wave_sum(s1) * (1.f / D) + eps);
                GAS u32x2* o80 = (GAS u32x2*)(Hb + (size_t)m * D) + lane; GAS u32x2* o81 = (GAS u32x2*)(Hb + (size_t)m1 * D) + lane;
#pragma unroll
                for (int j = 0; j < 4; ++j) { const f32x4 w = wr4[64 * j]; u32x2 o0, o1;
                    o0.x = pk2(v0[j].x * rs0 * w.x, v0[j].y * rs0 * w.y); o0.y = pk2(v0[j].z * rs0 * w.z, v0[j].w * rs0 * w.w);
                    o1.x = pk2(v1[j].x * rs1 * w.x, v1[j].y * rs1 * w.y); o1.y = pk2(v1[j].z * rs1 * w.z, v1[j].w * rs1 * w.w);
                    o80[64 * j] = o0; if (m1 != m) o81[64 * j] = o1; }
            }
            sync = true;
        } else if (ls == ST_BIAS) {
            FRESH();
            if (blockIdx.x == 0) { float s = 0.f; for (int c = 0; c < 32; ++c) s += ((const float*)(ws + WS_BIASP))[c * 512 + tid]; ((float*)(ws + WS_BIAS))[tid] = s; }
        } else if (ls == ST_P2) {
        } else if (ls == ST_P3 || ls == ST_P4) {
            if (ls == ST_P3) {
                { FRESH();
                  for (int base = 0; base < 1024; base += 4 * G) {
                      const int it = base + blockIdx.x + G * (wave & 3); const int q = it < 1024 ? 1023 - it : 0;
                      task_cmp(ws, q & 7, q >> 3, lane, (LAS float*)(lds + (wave & 3) * 16384), 2 * (wave >> 2), it < 1024 ? 2 : 0, wave < 4 && it < 1024);
                  } }
                { FRESH();
                  for (int q = blockIdx.x + G * (NWAVES - 1 - wave); q < 4096; q += NGW) task_moba_gate(ws, q & 7, (q >> 3) & 3, q >> 5, lane); }
            }
            for (int pool = (ls == ST_P3 ? 0 : 2); pool < (ls == ST_P3 ? 2 : 3); ++pool) {
                FRESH();
                unsigned* ctr = (unsigned*)(ws + WS_CTL) + layer * 64 + 16 * pool;
                const int ngroups = pool == 0 ? 1024 : pool == 1 ? 1536 : 1024;
                volatile LAS int* gslot = (volatile LAS int*)(lds + 131072);
                for (;;) {
                    __syncthreads();
                    if (tid == 0) *gslot = (int)atomicAdd(ctr, 1u);
                    __syncthreads();
                    const int g = __builtin_amdgcn_readfirstlane(*gslot);
                    if (g >= ngroups) break;
                    const int lane = (int)__builtin_amdgcn_mbcnt_hi(~0u, __builtin_amdgcn_mbcnt_lo(~0u, (unsigned)launder(0))), tid = wave * 64 + lane;
                    if (pool == 2) {
                        const int lvl = 15 - (g >> 6), w = g & 63;
                        if (w < 32) run_heavy_group(ws, 0, w & 7, w >> 3, lvl, wave, lane, tid, lds);
                        else run_heavy_group(ws, 1, w & 7, 0, 4 * lvl + 3 - ((w - 32) >> 3), wave, lane, tid, lds);
                    }
                    else if (pool == 0 && g < 512) { task_stick(ws, g & 7, (g >> 3) & 3, 8 * (15 - (g >> 5)) + wave, lane, lds + wave * 16384); }
                    else {
                        if (pool == 1 && g < 512) run_heavy_group(ws, 2, g & 7, 0, 63 - (g >> 3), wave, lane, tid, lds);
                        else {
                        const int kd = pool == 0 ? 3 : 4 + ((g - 512) >> 9), w = g & 511;
                        task_sm(ws, kd, w & 7, (w >> 3) & 3, 8 * (w >> 5) + wave, lane, lds + wave * 16384);
                        }
                    }
                }
            }
            sync = true;
        } else {
            unsigned char* ws = launder_p(ws0); bf16_t* Hb = (bf16_t*)(ws + WS_H);
            pg8::Gemm g; Epi E{0, 0, ws, xin, a.out};
            if (ls == ST_G_QK) { g = pg8::Gemm{Hb, (const bf16_t*)(ws + WS_WQK), T, NQK, D}; E.kind = 0; sync = true; }
            else if (ls == ST_G_VT) { g = pg8::Gemm{(const bf16_t*)(ws + WS_WV), Hb, NV, T, D}; E.kind = 1; sync = true; }
            else if (ls == ST_G_GATE) { g = pg8::Gemm{Hb, (const bf16_t*)(ws + WS_WG), T, D, D}; E.kind = 2; sync = true; }
            else if (ls == ST_G_OUT) { g = pg8::Gemm{(const bf16_t*)(ws + WS_Y), (const bf16_t*)(ws + WS_WOUT), T, D, D}; E.kind = 5; sync = true; }
            else {
                const int k = ls - ST_G_U0, br = k >> 1;
                const int wslot = br == 0 ? SL_QA : br == 1 ? SL_QB : br == 2 ? SL_QC : SL_QD0;
                if ((k & 1) == 0) { g = pg8::Gemm{slot_ptr(ws, wslot), (const bf16_t*)(ws + WS_WUP) + (size_t)br * D * 256, T, D, 256}; E.kind = 3; }
                else { g = pg8::Gemm{Hb, (const bf16_t*)(ws + WS_WM) + (size_t)br * D * D, T, D, D}; E.kind = 4; E.first = (br == 0); sync = (br == 3); }
            }
            pg8::StaticOrder S; S.init(g.M, g.N, G, (int)blockIdx.x);
            if (ls == ST_G_VT) {
                FRESH();
                if (G == 256) {
                    if (blockIdx.x < 128) task_mlp_block(ws, blockIdx.x >> 6, (blockIdx.x >> 3) & 7, blockIdx.x & 7, wave, lane, (LAS float*)lds);
                    else if (blockIdx.x < 192) { const int q = (blockIdx.x - 128) * NWAVES + wave; task_kmean(ws, q >> 6, (q >> 4) & 3, q & 15, lane); }
                    S.split = 128;
                } else {
                    for (int q = gw; q < 512; q += NGW) task_kmean(ws, q >> 6, (q >> 4) & 3, q & 15, lane);
                    for (int it = blockIdx.x; it < 128; it += G) task_mlp_block(ws, it >> 6, (it >> 3) & 7, it & 7, wave, lane, (LAS float*)lds);
                }
                __syncthreads();
            }
            pg8::gemm_phase<Epi, pg8::StaticOrder, true, true>(lds, g, S, E);
        }
        if (sync) grid.sync();
#if PROBE_A || PROBE_B
        if (blockIdx.x == 0 && tid0 == 0) { unsigned long long* tp = (unsigned long long*)(ws0 + WS_CTL + 2048); tp[ls] += wall_clock64() - tp[32]; }
#endif
    }
}

extern "C" void kernel_launch(void* const* d_in, const int* in_sizes, int n_in, void* d_out, int out_size, void* d_ws, size_t ws_size, hipStream_t stream) {
    static int grid = 0;
    if (grid == 0) {
        int dev = 0, cus = 0, per_cu = 0;
        hipGetDevice(&dev);
        hipDeviceGetAttribute(&cus, hipDeviceAttributeMultiprocessorCount, dev);
        hipFuncSetAttribute((const void*)mega_fwd, hipFuncAttributeMaxDynamicSharedMemorySize, LDS_BYTES);
        hipOccupancyMaxActiveBlocksPerMultiprocessor(&per_cu, (const void*)mega_fwd, NWAVES * 64, LDS_BYTES);
        (void)hipGetLastError();
        grid = cus;
        if (n_in != 9 || out_size != T * D || ws_size < WS_END || per_cu < 1) { fprintf(stderr, "kernel_launch: unexpected problem (n_in %d out %d ws %zu per_cu %d)\n", n_in, out_size, ws_size, per_cu); grid = -1; }
    }
    if (grid < 0) return;
    Args a{};
    for (int i = 0; i < 9; ++i) a.in[i] = (const float*)d_in[i];
    a.out = (float*)d_out; a.ws = (unsigned char*)d_ws;
    void* args[] = {&a};
    hipError_t e = hipLaunchCooperativeKernel((const void*)mega_fwd, dim3(grid), dim3(NWAVES * 64), args, LDS_BYTES, stream);
    if (e != hipSuccess) fprintf(stderr, "cooperative launch failed: %s\n", hipGetErrorString(e));
}
```

```cpp
#include <hip/hip_runtime.h>
#include <hip/hip_cooperative_groups.h>
#include <cstdio>
#include <cstdint>
namespace cg = cooperative_groups;
__device__ __forceinline__ int launder_i(int x) { asm volatile("" : "+v"(x)); return x; }
namespace pg8 {
#define PG8_LAS __attribute__((address_space(3)))
typedef unsigned short bf16_t;
typedef short bf16x8 __attribute__((ext_vector_type(8)));
typedef float f32x4 __attribute__((ext_vector_type(4)));
typedef unsigned u32x4 __attribute__((ext_vector_type(4)));
constexpr int BM = 256, BK = 64, HALF = 128, HTB = HALF * BK * 2  , STAGE_BYTES = 8 * HTB, NXCD = 8, WGM = 8;

__host__ __device__ __forceinline__ int lds_byte(int r, int c) { const int st = (r >> 4) * 2 + (c >> 5), rr = r & 15, cc = c & 31, ob = rr * 64 + cc * 2; return st * 1024 + (ob ^ (((ob >> 9) & 1) << 5)); }
__host__ __device__ __forceinline__ void stage_rc(int b, int& R, int& C) { const int st = b / 1024, sb = b % 1024, swz = sb ^ (((sb >> 9) & 1) << 5); R = (st >> 1) * 16 + swz / 64; C = (st & 1) * 32 + (swz % 64) / 2; }
__host__ __device__ __forceinline__ int perm32(int rho) { const int n = rho >> 4, i = rho & 15; return 8 * (i >> 2) + 4 * n + (i & 3); }

struct Unit { int pm, pn; };
struct Gemm { const bf16_t* A; const bf16_t* Bt; int M, N, K; };

struct StaticOrder {
    int nM, nN, nwg, G, c, split;
    __host__ __device__ void init(int M, int N, int G_, int c_) { nM = M / BM; nN = N / BM; nwg = nM * nN; G = G_; c = c_; split = 0; }
    __host__ __device__ bool next(int i, Unit& u) const {
        if (split) {
            const int per = c < split ? 2 : 4; if (i >= per) return false;
            const int L2 = c < split ? 2 * c + i : 2 * split + 4 * (c - split) + i;
            u.pm = L2 % nM; u.pn = L2 / nM; return true;
        }
        const long L = (long)i * G + c; if (L >= nwg) return false;
        int wgid = (int)L; { const int q = nwg / NXCD, r = nwg % NXCD, xcd = wgid % NXCD, off = wgid / NXCD; wgid = (xcd < r ? xcd * (q + 1) : r * (q + 1) + (xcd - r) * q) + off; }
        const int nig = WGM * nN, gid = wgid / nig, fm = gid * WGM, gsz = (nM - fm) < WGM ? (nM - fm) : WGM;
        u.pm = fm + ((wgid % nig) % gsz); u.pn = (wgid % nig) / gsz; return true;
    }
    __device__ __forceinline__ void a_ready(const Unit&) const {}
    __device__ __forceinline__ void done(const Unit&) const {}
};

__device__ __forceinline__ unsigned cvt_pk_bf16(float lo, float hi) { unsigned r; asm volatile("v_cvt_pk_bf16_f32 %0, %1, %2" : "=v"(r) : "v"(lo), "v"(hi)); return r; }
template <class Epi, class Sched, bool ALIGN_EPI = false, bool SP2 = false>
__device__ __forceinline__ void gemm_phase(PG8_LAS unsigned char* lds, const Gemm g, const Sched& S, const Epi& E) {
    const int tid = launder_i((int)threadIdx.x), wid = __builtin_amdgcn_readfirstlane(tid >> 6), lane = tid & 63, wr = wid >> 2, wc = wid & 3, fr = lane & 15, fq = lane >> 4;
    const int K = g.K, nt = K / BK;
    unsigned voffA[2], voffB[2];
#pragma unroll
    for (int i = 0; i < 2; ++i) { int R, C; stage_rc(tid * 16 + i * 8192, R, C); const int Rb = Epi::PERM ? ((R & ~31) + perm32(R & 31)) : R;
        voffA[i] = (unsigned)(R * K + C) * 2u; voffB[i] = (unsigned)(Rb * K + C) * 2u; }
    const size_t kstep = (size_t)(BK * 2);
    const size_t hstep = (size_t)HALF * K * 2;
    const size_t tstep = 2 * hstep;
    const unsigned ldsw = (unsigned)wid * 1024u;
    const int aoff = lds_byte(wr * 64 + fr, fq * 8), boff = lds_byte(wc * 32 + fr, fq * 8);
#define PG8_SA(b, h) (((b) * 2 + (h)) * HTB)
#define PG8_SB(b, h) ((4 + (b) * 2 + (h)) * HTB)
#define PG8_STAGE(bufoff, gbase, voff) do { _Pragma("unroll") for (int _i = 0; _i < 2; ++_i) \
        __builtin_amdgcn_global_load_lds((const unsigned*)((const char*)(gbase) + (voff)[_i]), (PG8_LAS unsigned*)(lds + (bufoff) + ldsw + _i * 8192), 16, 0, 0); } while (0)
#define PG8_LDA(dst, b, h) do { _Pragma("unroll") for (int m = 0; m < 4; ++m) _Pragma("unroll") for (int k = 0; k < 2; ++k) dst[m][k] = *(const PG8_LAS bf16x8*)(lds + PG8_SA(b, h) + aoff + m * 2048 + k * 1024); } while (0)
#define PG8_LDB(dst, b, h) do { _Pragma("unroll") for (int n = 0; n < 2; ++n) _Pragma("unroll") for (int k = 0; k < 2; ++k) dst[n][k] = *(const PG8_LAS bf16x8*)(lds + PG8_SB(b, h) + boff + n * 2048 + k * 1024); } while (0)
#define PG8_MMA(ai, bj, At, Bt) do { __builtin_amdgcn_s_setprio(1); _Pragma("unroll") for (int m = 0; m < 4; ++m) _Pragma("unroll") for (int n = 0; n < 2; ++n) _Pragma("unroll") for (int k = 0; k < 2; ++k) \
        acc[ai][bj][m][n] = __builtin_amdgcn_mfma_f32_16x16x32_bf16(Bt[n][k], At[m][k], acc[ai][bj][m][n], 0, 0, 0); __builtin_amdgcn_s_setprio(0); } while (0)
#define PG8_WAIT_V(n) asm volatile("s_waitcnt vmcnt(" #n ")" ::: "memory")
#define PG8_WAIT_L(n) asm volatile("s_waitcnt lgkmcnt(" #n ")" ::: "memory")
#define PG8_BAR __builtin_amdgcn_s_barrier()
#define PG8_SCHED __builtin_amdgcn_sched_barrier(0)
    Unit cur, nxt; int ui = 0;
    if (!S.next(0, cur)) return;
    f32x4 acc[2][2][4][2];
#pragma unroll
    for (int a = 0; a < 2; ++a)
#pragma unroll
        for (int b = 0; b < 2; ++b)
#pragma unroll
            for (int m = 0; m < 4; ++m)
#pragma unroll
                for (int n = 0; n < 2; ++n) acc[a][b][m][n] = (f32x4){0.f, 0.f, 0.f, 0.f};
    bf16x8 At[4][2], B0[2][2], B1[2][2];
    const char* cA = (const char*)g.A + (size_t)cur.pm * tstep; const char* cB = (const char*)g.Bt + (size_t)cur.pn * tstep;
    S.a_ready(cur);
    if constexpr (SP2) {
        PG8_STAGE(PG8_SB(0, 0), cB, voffB); PG8_STAGE(PG8_SB(0, 1), cB + hstep, voffB); PG8_STAGE(PG8_SA(0, 0), cA, voffA); PG8_STAGE(PG8_SA(0, 1), cA + hstep, voffA);
        if (wr == 1) PG8_BAR;
        PG8_WAIT_V(2); PG8_BAR;
        PG8_STAGE(PG8_SB(1, 0), cB + kstep, voffB); PG8_STAGE(PG8_SA(1, 0), cA + kstep, voffA); PG8_STAGE(PG8_SB(1, 1), cB + hstep + kstep, voffB);
        PG8_WAIT_V(6); PG8_BAR;
    } else {
        PG8_STAGE(PG8_SB(0, 0), cB, voffB); PG8_STAGE(PG8_SA(0, 0), cA, voffA); PG8_STAGE(PG8_SB(0, 1), cB + hstep, voffB); PG8_STAGE(PG8_SA(0, 1), cA + hstep, voffA);
        if (wr == 1) PG8_BAR;
        PG8_WAIT_V(4); PG8_BAR;
        PG8_STAGE(PG8_SB(1, 0), cB + kstep, voffB); PG8_STAGE(PG8_SA(1, 0), cA + kstep, voffA); PG8_STAGE(PG8_SB(1, 1), cB + hstep + kstep, voffB);
        PG8_WAIT_V(6); PG8_BAR;
    }
    for (;;) {
        const bool has_next = S.next(ui + 1, nxt);
        const char* nA = has_next ? (const char*)g.A + (size_t)nxt.pm * tstep : cA; const char* nB = has_next ? (const char*)g.Bt + (size_t)nxt.pn * tstep : cB;
        for (int t = 0; t < nt; t += 2) {
            const bool last = (t == nt - 2);
            const char* a1 = cA + (size_t)(t + 1) * kstep;
            const char* a2 = last ? nA : cA + (size_t)(t + 2) * kstep; const char* b2 = last ? nB : cB + (size_t)(t + 2) * kstep;
            const char* a3 = a2 + kstep; const char* b3 = b2 + kstep;
            if (last && has_next) S.a_ready(nxt);
            if constexpr (SP2) {
            PG8_LDB(B0, 0, 0); PG8_LDB(B1, 0, 1); PG8_SCHED; PG8_LDA(At, 0, 0); PG8_STAGE(PG8_SA(1, 1), a1 + hstep, voffA);
            PG8_WAIT_V(8); PG8_WAIT_L(0); PG8_BAR; PG8_MMA(0, 0, At, B0); PG8_MMA(0, 1, At, B1); PG8_BAR; PG8_SCHED;
            PG8_LDA(At, 0, 1); PG8_STAGE(PG8_SB(0, 0), b2, voffB); PG8_STAGE(PG8_SB(0, 1), b2 + hstep, voffB); PG8_STAGE(PG8_SA(0, 0), a2, voffA);
            PG8_WAIT_V(8); PG8_WAIT_L(0); PG8_BAR; PG8_MMA(1, 0, At, B0); PG8_MMA(1, 1, At, B1); PG8_BAR; PG8_SCHED;
            PG8_LDB(B0, 1, 0); PG8_LDB(B1, 1, 1); PG8_SCHED; PG8_LDA(At, 1, 0); PG8_STAGE(PG8_SA(0, 1), a2 + hstep, voffA);
            PG8_WAIT_V(8); PG8_WAIT_L(0); PG8_BAR; PG8_MMA(0, 0, At, B0); PG8_MMA(0, 1, At, B1); PG8_BAR; PG8_SCHED;
            PG8_LDA(At, 1, 1); PG8_STAGE(PG8_SB(1, 0), b3, voffB); PG8_STAGE(PG8_SB(1, 1), b3 + hstep, voffB); PG8_STAGE(PG8_SA(1, 0), a3, voffA);
            PG8_WAIT_V(8); PG8_WAIT_L(0); PG8_BAR; PG8_MMA(1, 0, At, B0); PG8_MMA(1, 1, At, B1); PG8_BAR; PG8_SCHED;
            } else {
            PG8_LDB(B0, 0, 0); PG8_SCHED; PG8_LDA(At, 0, 0); PG8_STAGE(PG8_SA(1, 1), a1 + hstep, voffA);
            PG8_WAIT_L(8); PG8_BAR; PG8_WAIT_L(0); PG8_MMA(0, 0, At, B0); PG8_BAR; PG8_SCHED;
            PG8_LDB(B1, 0, 1); PG8_STAGE(PG8_SB(0, 0), b2, voffB);
            PG8_BAR; PG8_WAIT_L(0); PG8_MMA(0, 1, At, B1); PG8_BAR;
            PG8_LDA(At, 0, 1); PG8_STAGE(PG8_SA(0, 0), a2, voffA);
            PG8_BAR; PG8_WAIT_L(0); PG8_MMA(1, 0, At, B0); PG8_BAR; PG8_SCHED;
            PG8_STAGE(PG8_SB(0, 1), b2 + hstep, voffB);
            PG8_WAIT_V(6); PG8_BAR; PG8_MMA(1, 1, At, B1); PG8_BAR;
            PG8_LDB(B0, 1, 0); PG8_SCHED; PG8_LDA(At, 1, 0); PG8_STAGE(PG8_SA(0, 1), a2 + hstep, voffA);
            PG8_WAIT_L(8); PG8_BAR; PG8_WAIT_L(0); PG8_MMA(0, 0, At, B0); PG8_BAR; PG8_SCHED;
            PG8_LDB(B1, 1, 1); PG8_STAGE(PG8_SB(1, 0), b3, voffB);
            PG8_BAR; PG8_WAIT_L(0); PG8_MMA(0, 1, At, B1); PG8_BAR;
            PG8_LDA(At, 1, 1); PG8_STAGE(PG8_SA(1, 0), a3, voffA);
            PG8_BAR; PG8_WAIT_L(0); PG8_MMA(1, 0, At, B0); PG8_BAR; PG8_SCHED;
            PG8_STAGE(PG8_SB(1, 1), b3 + hstep, voffB);
            PG8_WAIT_V(6); PG8_BAR; PG8_MMA(1, 1, At, B1); PG8_BAR;
            }
        }
        if constexpr (ALIGN_EPI) { if (wr == 0) PG8_BAR; }
        if constexpr (!Epi::AFTER_DRAIN) { E(acc, cur, wr, wc, fr, fq); S.done(cur); }
        if (!has_next) break;
#pragma unroll
        for (int a = 0; a < 2; ++a)
#pragma unroll
            for (int b = 0; b < 2; ++b)
#pragma unroll
                for (int m = 0; m < 4; ++m)
#pragma unroll
                    for (int n = 0; n < 2; ++n) acc[a][b][m][n] = (f32x4){0.f, 0.f, 0.f, 0.f};
        cur = nxt; cA = nA; cB = nB; ++ui;
        if constexpr (ALIGN_EPI) { if (wr == 1) PG8_BAR; }
    }
    PG8_WAIT_V(0);
    if constexpr (!ALIGN_EPI) { if (wr == 0) PG8_BAR; }
    PG8_BAR;
    if constexpr (Epi::AFTER_DRAIN) { E.fused(acc, cur, wr, wc, fr, fq, lds, wid, lane); S.done(cur); }
#undef PG8_SA
#undef PG8_SB
#undef PG8_STAGE
#undef PG8_LDA
#undef PG8_LDB
#undef PG8_MMA
#undef PG8_WAIT_V
#undef PG8_WAIT_L
#undef PG8_BAR
#undef PG8_SCHED
}
}

constexpr int NWAVES = 8;
constexpr int LDS_BYTES = 135168;
constexpr int NB = 8, SEQ = 4096, T = NB * SEQ, D = 1024, INW = 9612, DEPTH = 2;
constexpr int A_Q = 0, A_K = 256, A_V = 512, A_G = 768, B_Q = 1024, B_KC = 1280, B_VC = 1344, B_KS = 1408, B_VS = 1472, B_KW = 1536, B_VW = 1600, B_G = 1664, B_NG = 1920,
              C_Q = 1932, C_K = 2188, C_V = 2444, C_G = 2700, D_Q = 2956, D_K = 3724, D_V = 4492, D_G = 5260, MRG = 5516;
constexpr size_t MiB = 1u << 20, KiB = 1024;
constexpr size_t WS_CTL = 0, WS_COS = 1 * MiB, WS_SIN = 1 * MiB + 512 * KiB, WS_KMEAN = 2 * MiB, WS_BIASP = 2 * MiB + 128 * KiB, WS_BIAS = 2 * MiB + 192 * KiB,
                 WS_KCMP = 2 * MiB + 512 * KiB, WS_VCMPT = 2 * MiB + 768 * KiB, WS_MMASK = 3 * MiB, WS_NMASK = 3 * MiB + 512 * KiB, WS_LSE = 4 * MiB,
                 WS_W1T = 6 * MiB, WS_W2T = 8 * MiB, WS_WQK = 9 * MiB, WS_WV = 15 * MiB, WS_WG = 18 * MiB, WS_WM = 20 * MiB, WS_WUP = 28 * MiB, WS_WOUT = 30 * MiB,
                 WS_H = 32 * MiB, WS_QK = 96 * MiB, WS_VT = 320 * MiB, WS_U = 320 * MiB, WS_Y = 224 * MiB, WS_END = 432 * MiB;
constexpr size_t SLOT_BYTES = 16 * MiB;
constexpr int SL_QA = 0, SL_QB = 1, SL_QC = 2, SL_QD0 = 3, SL_QBR = 4, SL_QD1 = 5, SL_QD2 = 6, SL_OWIN = 7, SL_KA = 8, SL_KB4 = 9, SL_KC = 10, SL_KD0 = 11, SL_OSLC = 20;
constexpr int NQK = 3072, NV = 1536;
constexpr int CTL_BYTES = 4096 + 16384;
constexpr size_t CTL_BAR = 4096;

typedef unsigned short bf16_t;
typedef short bf16x8 __attribute__((ext_vector_type(8)));
typedef float f32x4 __attribute__((ext_vector_type(4)));
typedef float f32x2 __attribute__((ext_vector_type(2)));
typedef float f32x16 __attribute__((ext_vector_type(16)));
typedef unsigned u32x4 __attribute__((ext_vector_type(4)));
typedef unsigned u32x2 __attribute__((ext_vector_type(2)));
typedef __bf16 bf16v2 __attribute__((ext_vector_type(2)));
#define LAS __attribute__((address_space(3)))
#define GAS __attribute__((address_space(1)))
#define DI __device__ __forceinline__
#define MFMA32(a, b, c) __builtin_amdgcn_mfma_f32_32x32x16_bf16((a), (b), (c), 0, 0, 0)

constexpr float LOG2E = 1.4426950408889634f, LN2 = 0.6931471805599453f;
DI float sconst(float x) { asm volatile("" : "+s"(x)); return x; }
constexpr float SM_SCALE = 0.125f, SM_C = 0.125f * LOG2E, NEG_C = -1e30f, MFLOOR_C = -30000.f;
#define NEG sconst(NEG_C)
#define MFLOOR sconst(MFLOOR_C)

DI unsigned pk2(float lo, float hi) { const bf16v2 r = __builtin_convertvector((f32x2){lo, hi}, bf16v2); return __builtin_bit_cast(unsigned, r); }
DI float bf_lo(unsigned w) { return __uint_as_float(w << 16); }
DI float bf_hi(unsigned w) { return __uint_as_float(w & 0xffff0000u); }
DI float bf1(bf16_t x) { return __uint_as_float((unsigned)x << 16); }
DI float fexp2(float x) { return __builtin_amdgcn_exp2f(x); }
DI float flog2(float x) { return __builtin_amdgcn_logf(x); }
DI float frcp(float x) { return __builtin_amdgcn_rcpf(x); }
DI float sigmoidf_(float x) { return frcp(1.f + fexp2(-x * LOG2E)); }
DI float wave_sum(float v) {
#pragma unroll
    for (int o = 1; o < 64; o <<= 1) v += __shfl_xor(v, o);
    return v;
}
DI float xhalf(float v) { return __shfl_xor(v, 32); }
DI float hmaxf_(float v) { const auto r = __builtin_amdgcn_permlane32_swap(__float_as_uint(v), __float_as_uint(v), false, false); return fmaxf(__uint_as_float(r[0]), __uint_as_float(r[1])); }
DI float hsumf_(float v) { const auto r = __builtin_amdgcn_permlane32_swap(__float_as_uint(v), __float_as_uint(v), false, false); return __uint_as_float(r[0]) + __uint_as_float(r[1]); }
DI bf16_t* slot_ptr(unsigned char* ws, int s) { return (bf16_t*)(ws + WS_QK + (size_t)s * SLOT_BYTES); }
DI void load8(const bf16_t* p, float (&f)[8]) { const u32x4 w = *(const GAS u32x4*)p; f[0] = bf_lo(w.x); f[1] = bf_hi(w.x); f[2] = bf_lo(w.y); f[3] = bf_hi(w.y); f[4] = bf_lo(w.z); f[5] = bf_hi(w.z); f[6] = bf_lo(w.w); f[7] = bf_hi(w.w); }
DI void store8(bf16_t* p, const float (&f)[8]) { u32x4 w; w.x = pk2(f[0], f[1]); w.y = pk2(f[2], f[3]); w.z = pk2(f[4], f[5]); w.w = pk2(f[6], f[7]); *(GAS u32x4*)p = w; }
DI void store4(bf16_t* p, float a, float b, float c, float d) { u32x2 w; w.x = pk2(a, b); w.y = pk2(c, d); *(GAS u32x2*)p = w; }

struct Epi {
    static constexpr bool PERM = true, AFTER_DRAIN = false;
    int kind, first; unsigned char* ws; const float* xin; float* xout;
    typedef pg8::f32x4 a4;
    DI void operator()(const a4 (&acc)[2][2][4][2], const pg8::Unit& u, int wr, int wc, int fr, int fq) const {
        if (kind == 0) {
            const int tile = u.pn;
            const int slot = (int)((0xDCB653A29180ull >> (4 * tile)) & 15ull);
            bf16_t* dst = slot_ptr(ws, slot); bf16_t* dst2 = slot_ptr(ws, SL_QBR);
            const bool ropeall = (tile <= 1) || (tile >= 6);
            const int g = 4 * (wc & 1) + fq, d0 = 4 * g;
            const float* cosT = (const float*)(ws + WS_COS); const float* sinT = (const float*)(ws + WS_SIN);
#pragma unroll
            for (int ai = 0; ai < 2; ++ai)
#pragma unroll
                for (int m = 0; m < 4; ++m) {
                    const int tok = u.pm * 256 + ai * 128 + wr * 64 + m * 16 + fr, pos = tok & (SEQ - 1);
                    const f32x4 cs = *(const GAS f32x4*)(cosT + pos * 32 + d0), sn = *(const GAS f32x4*)(sinT + pos * 32 + d0);
#pragma unroll
                    for (int bj = 0; bj < 2; ++bj) {
                        const int hs = 2 * bj + (wc >> 1);
                        const a4 v0 = acc[ai][bj][m][0], v1 = acc[ai][bj][m][1];
                        const a4 r0 = v0 * cs - v1 * sn, r1 = v0 * sn + v1 * cs;
                        const size_t off = (size_t)tok * 256 + hs * 64 + d0;
                        const bool rope = ropeall || (tile == 3 && hs >= 2);
                        if (tile == 2) { store4(dst + off, v0[0], v0[1], v0[2], v0[3]); store4(dst + off + 32, v1[0], v1[1], v1[2], v1[3]);
                                         store4(dst2 + off, r0[0], r0[1], r0[2], r0[3]); store4(dst2 + off + 32, r1[0], r1[1], r1[2], r1[3]); }
                        else if (rope) { store4(dst + off, r0[0], r0[1], r0[2], r0[3]); store4(dst + off + 32, r1[0], r1[1], r1[2], r1[3]); }
                        else { store4(dst + off, v0[0], v0[1], v0[2], v0[3]); store4(dst + off + 32, v1[0], v1[1], v1[2], v1[3]); }
                    }
                    asm volatile("" ::: "memory");
                }
        } else if (kind == 1) {
            bf16_t* VT = (bf16_t*)(ws + WS_VT);
#pragma unroll
            for (int ai = 0; ai < 2; ++ai)
#pragma unroll
                for (int m = 0; m < 4; ++m) {
                    const int r = u.pm * 256 + ai * 128 + wr * 64 + m * 16 + fr;
                    bf16_t* rowp = VT + (size_t)r * T;
                    const bool gate = (r >= 1408 && r < 1420);
#pragma unroll
                    for (int bj = 0; bj < 2; ++bj) {
                        const int c0 = u.pn * 256 + bj * 128 + wc * 32 + 8 * fq;
                        const a4 v0 = acc[ai][bj][m][0], v1 = acc[ai][bj][m][1];
                        float v[8] = {v0[0], v0[1], v0[2], v0[3], v1[0], v1[1], v1[2], v1[3]};
                        if (gate) {
#pragma unroll
                            for (int j = 0; j < 8; ++j) v[j] = sigmoidf_(v[j]);
                        }
                        if (u.pm == 3) {
                            const int b = c0 >> 12, p0 = c0 & (SEQ - 1), mm0 = p0 >> 2;
                            bf16_t* q = rowp + b * SEQ + mm0;
#pragma unroll
                            for (int c = 0; c < 4; ++c) *(GAS unsigned*)(q + c * 1024) = pk2(v[c], v[c + 4]);
                        } else if (u.pm == 4) {
                            const int b = c0 >> 12, p0 = c0 & (SEQ - 1), mm = p0 >> 4, cc0 = p0 & 15;
                            bf16_t* q = rowp + b * SEQ + cc0 * 256 + mm;
#pragma unroll
                            for (int j = 0; j < 8; ++j) ((GAS bf16_t*)q)[j * 256] = (bf16_t)(pk2(v[j], 0.f) & 0xffffu);
                        } else store8(rowp + c0, v);
                    }
                    asm volatile("" ::: "memory");
                }
        } else if (kind == 2) {
            const int br = u.pn;
            const bf16_t* VT = (const bf16_t*)(ws + WS_VT);
            const float* LSE = (const float*)(ws + WS_LSE);
#pragma unroll
            for (int ai = 0; ai < 2; ++ai)
#pragma unroll
                for (int m = 0; m < 4; ++m) {
                    const int tok = u.pm * 256 + ai * 128 + wr * 64 + m * 16 + fr;
#pragma unroll
                    for (int bj = 0; bj < 2; ++bj) {
                        const int cb = bj * 128 + wc * 32 + 8 * fq, head = cb >> 6;
                        const a4 v0 = acc[ai][bj][m][0], v1 = acc[ai][bj][m][1];
                        float gt[8] = {v0[0], v0[1], v0[2], v0[3], v1[0], v1[1], v1[2], v1[3]};
                        const size_t off = (size_t)tok * 256 + cb;
                        float o[8];
                        bf16_t* dst;
                        if (br == 0) { dst = slot_ptr(ws, SL_QA) + off; load8(dst, o); }
                        else if (br == 2) { dst = slot_ptr(ws, SL_QC) + off; load8(dst, o); }
                        else if (br == 1) {
                            dst = slot_ptr(ws, SL_QB) + off;
                            float oc[8], os[8], ow[8]; load8(dst, oc); load8(slot_ptr(ws, SL_OSLC) + off, os); load8(slot_ptr(ws, SL_OWIN) + off, ow);
                            const GAS bf16_t* VTg = (const GAS bf16_t*)VT; const float g0 = bf1(VTg[(size_t)(1408 + head) * T + tok]), g1 = bf1(VTg[(size_t)(1412 + head) * T + tok]), g2 = bf1(VTg[(size_t)(1416 + head) * T + tok]);
#pragma unroll
                            for (int j = 0; j < 8; ++j) o[j] = g0 * oc[j] + g1 * os[j] + g2 * ow[j];
                        } else {
                            dst = slot_ptr(ws, SL_QD0) + off;
                            float o0[8], o1[8], o2[8]; load8(dst, o0); load8(slot_ptr(ws, SL_QD1) + off, o1); load8(slot_ptr(ws, SL_QD2) + off, o2);
                            const GAS float* LSEg = (const GAS float*)LSE; const float l0 = LSEg[((size_t)0 * T + tok) * 4 + head], l1 = LSEg[((size_t)1 * T + tok) * 4 + head], l2 = LSEg[((size_t)2 * T + tok) * 4 + head];
                            const float mx = fmaxf(l0, fmaxf(l1, l2));
                            const float e0 = fexp2((l0 - mx) * LOG2E), e1 = fexp2((l1 - mx) * LOG2E), e2 = fexp2((l2 - mx) * LOG2E);
                            const float inv = frcp(e0 + e1 + e2);
#pragma unroll
                            for (int j = 0; j < 8; ++j) o[j] = (e0 * o0[j] + e1 * o1[j] + e2 * o2[j]) * inv;
                        }
#pragma unroll
                        for (int j = 0; j < 8; ++j) o[j] *= gt[j] * sigmoidf_(gt[j]);
                        store8(dst, o);
                        asm volatile("" ::: "memory");
                    }
                }
        } else {
            bf16_t* U = (bf16_t*)(ws + WS_U); bf16_t* Y = (bf16_t*)(ws + WS_Y);
#pragma unroll
            for (int ai = 0; ai < 2; ++ai)
#pragma unroll
                for (int m = 0; m < 4; ++m) {
                    const int tok = u.pm * 256 + ai * 128 + wr * 64 + m * 16 + fr;
#pragma unroll
                    for (int bj = 0; bj < 2; ++bj) {
                        const int col = u.pn * 256 + bj * 128 + wc * 32 + 8 * fq;
                        const a4 v0 = acc[ai][bj][m][0], v1 = acc[ai][bj][m][1];
                        float v[8] = {v0[0], v0[1], v0[2], v0[3], v1[0], v1[1], v1[2], v1[3]};
                        const size_t off = (size_t)tok * D + col;
                        if (kind == 3) store8(U + off, v);
                        else if (kind == 4) {
                            float uu[8]; load8(U + off, uu);
                            float y[8];
                            if (first) {
#pragma unroll
                                for (int j = 0; j < 8; ++j) y[j] = sigmoidf_(v[j]) * uu[j];
                            } else {
                                load8(Y + off, y);
#pragma unroll
                                for (int j = 0; j < 8; ++j) y[j] += sigmoidf_(v[j]) * uu[j];
                            }
                            store8(Y + off, y);
                        } else {
                            const f32x4 x0 = *(const GAS f32x4*)(xin + off), x1 = *(const GAS f32x4*)(xin + off + 4);
                            *(GAS f32x4*)(xout + off) = (f32x4){x0[0] + v[0], x0[1] + v[1], x0[2] + v[2], x0[3] + v[3]};
                            *(GAS f32x4*)(xout + off + 4) = (f32x4){x1[0] + v[4], x1[1] + v[5], x1[2] + v[6], x1[3] + v[7]};
                        }
                        asm volatile("" ::: "memory");
                    }
                }
        }
    }
};

DI void transpose_item(const float* W, int K, int N, bf16_t* WT, int k0, int n0, int sc, LAS float* scr, int lane) {
    const int sc4 = __shfl(sc, 4 * (lane & 7));
#pragma unroll
    for (int i = 0; i < 8; ++i) {
        const int kk = 8 * i + (lane >> 3);
        const f32x4 w = sc4 >= 0 ? *(const GAS f32x4*)(W + (size_t)(k0 + kk) * N + sc4) : (f32x4){0.f, 0.f, 0.f, 0.f};
        LAS float* d = scr + kk * 33 + 4 * (lane & 7);
        d[0] = w.x; d[1] = w.y; d[2] = w.z; d[3] = w.w;
    }
    asm volatile("s_waitcnt lgkmcnt(0)" ::: "memory");
    const int c = lane & 7;
#pragma unroll
    for (int j = 0; j < 4; ++j) { const int n = (lane >> 3) + 8 * j; const LAS float* s = scr + (8 * c) * 33 + n;
        u32x4 o; o.x = pk2(s[0 * 33], s[1 * 33]); o.y = pk2(s[2 * 33], s[3 * 33]); o.z = pk2(s[4 * 33], s[5 * 33]); o.w = pk2(s[6 * 33], s[7 * 33]);
        *(GAS u32x4*)(WT + (size_t)(n0 + n) * K + k0 + 8 * c) = o; }
    asm volatile("s_waitcnt lgkmcnt(0)" ::: "memory");
}
DI int src_qk(int n) {
    const int tile = n >> 8, hs = (n >> 6) & 3, g = (n >> 3) & 7, e = n & 7, d = 4 * g + (e & 3) + 32 * (e >> 2);
    int base;
    switch (tile) {
        case 0: base = A_Q + 64 * hs; break; case 1: base = A_K + 64 * hs; break; case 2: base = B_Q + 64 * hs; break;
        case 3: base = hs == 0 ? B_KC : hs == 1 ? B_VC : hs == 2 ? B_KS : B_KW; break;
        case 4: base = C_Q + 64 * hs; break; case 5: base = C_K + 64 * hs; break;
        case 6: case 7: case 8: base = D_Q + 256 * (tile - 6) + 64 * hs; break;
        default: base = D_K + 256 * (tile - 9) + 64 * hs; break;
    }
    return base + d;
}
DI int src_v(int n) {
    const int slot = n >> 6, d = n & 63;
    if (slot < 4) return A_V + 64 * slot + d;
    if (slot < 8) return C_V + 64 * (slot - 4) + d;
    if (slot < 20) return D_V + 64 * (slot - 8) + d;
    if (slot == 20) return B_VS + d;
    if (slot == 21) return B_VW + d;
    if (slot == 22 && d < 12) return B_NG + d;
    return -1;
}
DI int src_g(int n) { const int br = n >> 8, c = n & 255; return (br == 0 ? A_G : br == 1 ? B_G : br == 2 ? C_G : D_G) + c; }

DI const bf16_t* launder_vp(const bf16_t* p) { asm volatile("" : "+v"(p)); return p; }
DI int kappa(int rho) { return (rho & 16) | ((rho & 4) << 1) | ((rho & 8) >> 1) | (rho & 3); }
DI bf16x8 ldfrag(const bf16_t* p) { return *(const GAS bf16x8*)p; }
DI bf16x8 pack8(const float* p) { u32x4 w; w.x = pk2(p[0], p[1]); w.y = pk2(p[2], p[3]); w.z = pk2(p[4], p[5]); w.w = pk2(p[6], p[7]); return __builtin_bit_cast(bf16x8, w); }

#define BLK_BAR() do { asm volatile("s_waitcnt lgkmcnt(0)" ::: "memory"); __builtin_amdgcn_s_barrier(); asm volatile("" ::: "memory"); } while (0)
struct SmState { f32x16 O[2]; float m, l; };
DI void sm_init(SmState& st) {
#pragma unroll
    for (int i = 0; i < 16; ++i) { st.O[0][i] = 0.f; st.O[1][i] = 0.f; }
    st.m = MFLOOR; st.l = 0.f;
}
struct Frag { bf16x8 k[4], v[2][2]; };
DI void ld_frag(Frag& f, const bf16_t* kp, const bf16_t* v0p, const bf16_t* v1p) {
#pragma unroll
    for (int s = 0; s < 4; ++s) f.k[s] = ldfrag(kp + 16 * s);
#pragma unroll
    for (int s = 0; s < 2; ++s) { f.v[0][s] = ldfrag(v0p + 16 * s); f.v[1][s] = ldfrag(v1p + 16 * s); }
}
struct FragG { u32x4 k[4], v[4]; };
constexpr int WLDS_BYTES = 4608 + 5120;
DI void ldg(FragG& g, const bf16_t* kq, size_t kstride, const bf16_t* vq, size_t vstride) {
#pragma unroll
    for (int j = 0; j < 4; ++j) g.k[j] = *(const GAS u32x4*)(kq + (size_t)(8 * j) * kstride);
#pragma unroll
    for (int j = 0; j < 4; ++j) g.v[j] = *(const GAS u32x4*)(vq + (size_t)(16 * j) * vstride);
}
DI void stage(const FragG& g, Frag& f, LAS unsigned char* wl, int lane) {
    const int r = lane & 31, h = lane >> 5;
    LAS u32x4* kw = (LAS u32x4*)(wl + (lane >> 3) * 144 + (lane & 7) * 16);
    LAS u32x4* vw = (LAS u32x4*)(wl + 4608 + (lane >> 2) * 80 + (lane & 3) * 16);
#pragma unroll
    for (int j = 0; j < 4; ++j) kw[j * 72] = g.k[j];
#pragma unroll
    for (int j = 0; j < 4; ++j) vw[j * 80] = g.v[j];
    asm volatile("" ::: "memory");
    const LAS unsigned char* kr = wl + kappa(r) * 144 + 16 * h;
    const LAS unsigned char* vr = wl + 4608 + r * 80 + 16 * h;
#pragma unroll
    for (int s = 0; s < 4; ++s) f.k[s] = *(const LAS bf16x8*)(kr + 32 * s);
#pragma unroll
    for (int s = 0; s < 2; ++s) { f.v[0][s] = *(const LAS bf16x8*)(vr + 32 * s); f.v[1][s] = *(const LAS bf16x8*)(vr + 32 * 80 + 32 * s); }
    asm volatile("" ::: "memory");
}
template <int MASK>
DI void sm_compute(SmState& st, const bf16x8 (&qf)[4], const Frag& f, int key0, bool allow, int klo, int khi) {
    f32x16 S;
#pragma unroll
    for (int i = 0; i < 16; ++i) S[i] = 0.f;
#pragma unroll
    for (int s = 0; s < 4; ++s) S = MFMA32(f.k[s], qf[s], S);
    const float neg = NEG, mfl = MFLOOR;
    float p[16]; float mx = mfl;
#pragma unroll
    for (int i = 0; i < 16; ++i) {
        float v = S[i];
        if (MASK == 2) { const int key = key0 + 16 * (i >> 3) + (i & 7); v = (allow && key >= klo && key <= khi) ? v : neg; }
        p[i] = v; mx = fmaxf(mx, v);
    }
    if (MASK == 1) mx = allow ? mx : mfl;
    mx = hmaxf_(mx);
    const float mn = fmaxf(st.m, mx), mc = mn * SM_C;
    const float mcl = (MASK == 1 && !allow) ? sconst(INFINITY) : mc;
    const f32x2 c2 = {SM_C, SM_C}, m2 = {mcl, mcl};
    f32x2 rs2 = {0.f, 0.f};
#pragma unroll
    for (int k = 0; k < 8; ++k) {
        const f32x2 x = (f32x2){p[2 * k], p[2 * k + 1]} * c2 - m2;
        const f32x2 e = {fexp2(x.x), fexp2(x.y)};
        p[2 * k] = e.x; p[2 * k + 1] = e.y; rs2 += e;
    }
    const float rs = rs2.x + rs2.y;
    if (__ballot(mn != st.m) != 0ull) {
        const float alpha = fexp2((st.m - mn) * SM_C);
        st.l *= alpha;
#pragma unroll
        for (int i = 0; i < 16; ++i) { st.O[0][i] *= alpha; st.O[1][i] *= alpha; }
    }
    st.l += rs; st.m = mn;
    const bf16x8 pf0 = pack8(p), pf1 = pack8(p + 8);
    st.O[0] = MFMA32(f.v[0][0], pf0, st.O[0]); st.O[0] = MFMA32(f.v[0][1], pf1, st.O[0]);
    st.O[1] = MFMA32(f.v[1][0], pf0, st.O[1]); st.O[1] = MFMA32(f.v[1][1], pf1, st.O[1]);
}
DI void write_o(bf16_t* orow, const f32x16 (&O)[2], float inv, int h) {
#pragma unroll
    for (int dt = 0; dt < 2; ++dt)
#pragma unroll
        for (int g = 0; g < 4; ++g) store4(orow + 32 * dt + 8 * g + 4 * h, O[dt][4 * g] * inv, O[dt][4 * g + 1] * inv, O[dt][4 * g + 2] * inv, O[dt][4 * g + 3] * inv);
}
DI void load_q(bf16x8 (&qf)[4], const bf16_t* qrow, int h) {
#pragma unroll
    for (int s = 0; s < 4; ++s) qf[s] = ldfrag(qrow + 16 * s + 8 * h);
}

struct SmTask { const bf16_t* qrow; const bf16_t* kb; const bf16_t* vb0; bf16_t* orow; float* lse; size_t kstride; int ti_lo, ti_hi, ti_edge, bshift, klo, khi; unsigned long long need, full, allow; };
DI int sm_next(int ti, int ti_hi, int bshift, unsigned long long need) {
    int nt = ti + 1;
    while (nt <= ti_hi) { if ((need >> (nt >> bshift)) & 1ull) return nt; nt = ((nt >> bshift) + 1) << bshift; }
    return -1;
}
DI void sm_step(SmState& st, const bf16x8 (&qf)[4], const Frag& f, const SmTask& tk, int ti, int h) {
    const int blk = ti >> tk.bshift;
    const bool allow = (tk.allow >> blk) & 1ull;
    if ((ti == tk.ti_hi) || (ti == tk.ti_edge)) sm_compute<2>(st, qf, f, 32 * ti + 8 * h, allow, tk.klo, tk.khi);
    else if (!((tk.full >> blk) & 1ull)) sm_compute<1>(st, qf, f, 32 * ti + 8 * h, allow, 0, 0);
    else sm_compute<0>(st, qf, f, 32 * ti + 8 * h, true, 0, 0);
}
DI void run_sm(const SmTask& tk, int lane, LAS unsigned char* wl) {
    const int h = lane >> 5;
    bf16x8 qf[4]; load_q(qf, tk.qrow, h);
    SmState st; sm_init(st);
    int ti = sm_next(tk.ti_lo - 1, tk.ti_hi, tk.bshift, tk.need);
    FragG GA, GB; Frag F;
    ldg(GA, tk.kb + (size_t)(32 * ti) * tk.kstride, tk.kstride, tk.vb0 + 32 * ti, T);
    for (;;) {
        int nt = sm_next(ti, tk.ti_hi, tk.bshift, tk.need); int lt = nt >= 0 ? nt : ti;
        ldg(GB, tk.kb + (size_t)(32 * lt) * tk.kstride, tk.kstride, tk.vb0 + 32 * lt, T);
        __builtin_amdgcn_sched_barrier(0);
        stage(GA, F, wl, lane);
        sm_step(st, qf, F, tk, ti, h);
        if (nt < 0) break;
        ti = nt;
        nt = sm_next(ti, tk.ti_hi, tk.bshift, tk.need); lt = nt >= 0 ? nt : ti;
        ldg(GA, tk.kb + (size_t)(32 * lt) * tk.kstride, tk.kstride, tk.vb0 + 32 * lt, T);
        __builtin_amdgcn_sched_barrier(0);
        stage(GB, F, wl, lane);
        sm_step(st, qf, F, tk, ti, h);
        if (nt < 0) break;
        ti = nt;
    }
    const float lt_ = hsumf_(st.l);
    write_o(tk.orow, st.O, frcp(lt_), h);
    if (tk.lse != nullptr && h == 0) *(GAS float*)tk.lse = st.m * SM_SCALE + flog2(lt_) * LN2;
}
DI unsigned long long bits_any(unsigned long long m, int n) {
    unsigned long long r = 0ull;
    for (int j = 0; j < n; ++j) if (__ballot((m >> j) & 1ull) != 0ull) r |= 1ull << j;
    return r;
}
DI unsigned long long bits_all(unsigned long long m, int n) {
    unsigned long long r = 0ull;
    for (int j = 0; j < n; ++j) if (__ballot((m >> j) & 1ull) == ~0ull) r |= 1ull << j;
    return r;
}
DI void task_sm(unsigned char* ws, int kind, int b, int hh, int qt, int lane, LAS unsigned char* wl) {
    const int r = lane & 31, kr = lane >> 3, kc = 8 * (lane & 7), vd = lane >> 2, vc = 8 * (lane & 3);
    const bf16_t* VT = (const bf16_t*)(ws + WS_VT);
    SmTask tk;
    tk.lse = nullptr; tk.kstride = 256; tk.ti_edge = -1; tk.klo = -1; tk.ti_lo = 0;
    if (kind <= 2) {
        const int t0 = 32 * qt, t = t0 + r; const size_t row = (size_t)(b * SEQ + t) * 256 + hh * 64;
        tk.ti_hi = qt; tk.khi = t;
        if (kind == 0) {
            const int cb = t0 >> 8;
            const unsigned long long mask = ((const GAS unsigned*)(ws + WS_MMASK))[(b * 4 + hh) * SEQ + t];
            tk.qrow = slot_ptr(ws, SL_QA) + row; tk.orow = slot_ptr(ws, SL_QA) + row;
            tk.kb = slot_ptr(ws, SL_KA) + (size_t)(b * SEQ + kr) * 256 + hh * 64 + kc;
            tk.vb0 = VT + (size_t)(hh * 64 + vd) * T + b * SEQ + vc;
            tk.bshift = 3; tk.allow = mask; tk.need = bits_any(mask, cb + 1); tk.full = bits_all(mask, cb + 1);
        } else if (kind == 1) {
            const int cur = t0 >> 6;
            const unsigned long long mask = ((const GAS unsigned long long*)(ws + WS_NMASK))[b * SEQ + t];
            tk.qrow = slot_ptr(ws, SL_QBR) + row; tk.orow = slot_ptr(ws, SL_OSLC) + row;
            tk.kb = slot_ptr(ws, SL_KB4) + (size_t)(b * SEQ + kr) * 256 + 128 + kc;
            tk.vb0 = VT + (size_t)(1280 + vd) * T + b * SEQ + vc;
            tk.bshift = 1; tk.allow = mask; tk.need = bits_any(mask, cur + 1); tk.full = bits_all(mask, cur + 1);
        } else {
            tk.qrow = slot_ptr(ws, SL_QBR) + row; tk.orow = slot_ptr(ws, SL_OWIN) + row;
            tk.kb = slot_ptr(ws, SL_KB4) + (size_t)(b * SEQ + kr) * 256 + 192 + kc;
            tk.vb0 = VT + (size_t)(1344 + vd) * T + b * SEQ + vc;
            tk.bshift = 8; tk.allow = 1ull; tk.need = 1ull; tk.full = 1ull;
            tk.ti_lo = qt - 16 < 0 ? 0 : qt - 16; tk.ti_edge = qt - 16; tk.klo = t - 511;
        }
    } else {
        const int g = kind - 3, dil = g == 0 ? 1 : g == 1 ? 4 : 16, L = SEQ / dil, nsub = 128 / dil, c = qt / nsub, sq = qt - c * nsub;
        const int mq = 32 * sq + r, tok = b * SEQ + mq * dil + c;
        bf16_t* qr = slot_ptr(ws, g == 0 ? SL_QD0 : g == 1 ? SL_QD1 : SL_QD2) + (size_t)tok * 256 + hh * 64;
        tk.qrow = qr; tk.orow = qr; tk.kstride = (size_t)256 * dil;
        tk.kb = slot_ptr(ws, SL_KD0 + g) + (size_t)(b * SEQ + c) * 256 + (size_t)kr * tk.kstride + hh * 64 + kc;
        tk.vb0 = VT + (size_t)(512 + 256 * g + hh * 64 + vd) * T + b * SEQ + (g == 0 ? 0 : c * L) + vc;
        tk.lse = (float*)(ws + WS_LSE) + ((size_t)g * T + tok) * 4 + hh;
        tk.bshift = 8; tk.allow = 1ull; tk.need = 1ull; tk.full = 1ull;
        tk.ti_hi = sq; tk.ti_lo = sq - 4 < 0 ? 0 : sq - 4; tk.ti_edge = sq - 4; tk.klo = mq - 128; tk.khi = mq;
    }
    run_sm(tk, lane, wl);
}

DI void frag_from_image(Frag& f, const LAS unsigned char* img, int lane) {
    const int r = lane & 31, h = lane >> 5;
    const LAS unsigned char* kr = img + kappa(r) * 144 + 16 * h;
    const LAS unsigned char* vr = img + 4608 + r * 80 + 16 * h;
#pragma unroll
    for (int s = 0; s < 4; ++s) f.k[s] = *(const LAS bf16x8*)(kr + 32 * s);
#pragma unroll
    for (int s = 0; s < 2; ++s) { f.v[0][s] = *(const LAS bf16x8*)(vr + 32 * s); f.v[1][s] = *(const LAS bf16x8*)(vr + 32 * 80 + 32 * s); }
}
DI void run_heavy_group(unsigned char* ws, int kind, int b, int hh_in, int qg, int wave, int lane, int tid, LAS unsigned char* img) {
    const int r = lane & 31, h = lane >> 5;
    const bool packed = kind >= 1;
    const int hh = packed ? (wave & 3) : hh_in, qt = packed ? 2 * qg + (wave >> 2) : 8 * qg + wave, t0 = 32 * qt, t = t0 + r;
    const int tend = packed ? 2 * qg + 1 : 8 * qg + 7, tbeg = kind == 2 ? (2 * qg - 16 < 0 ? 0 : 2 * qg - 16) : 0;
    const size_t row = (size_t)(b * SEQ + t) * 256 + hh * 64;
    SmTask tk; tk.lse = nullptr; tk.kstride = 256; tk.ti_edge = -1; tk.klo = -1; tk.ti_lo = 0; tk.ti_hi = qt; tk.khi = t; tk.kb = nullptr; tk.vb0 = nullptr;
    const bf16_t* gp; size_t gstep; int woff;
    if (kind == 0) {
        const int cb = t0 >> 8;
        const unsigned long long mask = ((const GAS unsigned*)(ws + WS_MMASK))[(b * 4 + hh) * SEQ + t];
        tk.qrow = slot_ptr(ws, SL_QA) + row; tk.orow = slot_ptr(ws, SL_QA) + row;
        tk.bshift = 3; tk.allow = mask; tk.need = bits_any(mask, cb + 1); tk.full = bits_all(mask, cb + 1);
        if (tid < 256) { gp = slot_ptr(ws, SL_KA) + (size_t)(b * SEQ + (tid >> 3)) * 256 + hh * 64 + 8 * (tid & 7); gstep = (size_t)32 * 256; woff = (tid >> 3) * 144 + (tid & 7) * 16; }
        else { const int t2 = tid - 256; gp = (const bf16_t*)(ws + WS_VT) + (size_t)(hh * 64 + (t2 >> 2)) * T + b * SEQ + 8 * (t2 & 3); gstep = 32; woff = 4608 + (t2 >> 2) * 80 + (t2 & 3) * 16; }
    } else {
        if (kind == 1) {
            const int cur = t0 >> 6;
            const unsigned long long mask = ((const GAS unsigned long long*)(ws + WS_NMASK))[b * SEQ + t];
            tk.qrow = slot_ptr(ws, SL_QBR) + row; tk.orow = slot_ptr(ws, SL_OSLC) + row;
            tk.bshift = 1; tk.allow = mask; tk.need = bits_any(mask, cur + 1); tk.full = bits_all(mask, cur + 1);
        } else {
            tk.qrow = slot_ptr(ws, SL_QBR) + row; tk.orow = slot_ptr(ws, SL_OWIN) + row;
            tk.bshift = 8; tk.allow = 1ull; tk.need = 1ull; tk.full = 1ull;
            tk.ti_lo = qt - 16 < 0 ? 0 : qt - 16; tk.ti_edge = qt - 16; tk.klo = t - 511;
        }
        const int koff = kind == 1 ? 128 : 192, vrow = kind == 1 ? 1280 : 1344;
        if (tid < 256) { gp = slot_ptr(ws, SL_KB4) + (size_t)(b * SEQ + (tid >> 3)) * 256 + koff + 8 * (tid & 7); gstep = (size_t)32 * 256; woff = (tid >> 3) * 144 + (tid & 7) * 16; }
        else { const int t2 = tid - 256; gp = (const bf16_t*)(ws + WS_VT) + (size_t)(vrow + (t2 >> 2)) * T + b * SEQ + 8 * (t2 & 3); gstep = 32; woff = 4608 + (t2 >> 2) * 80 + (t2 & 3) * 16; }
    }
    bf16x8 qf[4]; load_q(qf, tk.qrow, h);
    SmState st; sm_init(st);
    LAS unsigned char* img0 = img; LAS unsigned char* img1 = img + WLDS_BYTES;
    int ti = tbeg;
    u32x4 r0 = *(const GAS u32x4*)(gp + gstep * (size_t)ti);
    u32x4 r1 = *(const GAS u32x4*)(gp + gstep * (size_t)(ti + 1 > tend ? tend : ti + 1));
    *(LAS u32x4*)(img0 + woff) = r0;
    r0 = *(const GAS u32x4*)(gp + gstep * (size_t)(ti + 2 > tend ? tend : ti + 2));
    BLK_BAR();
    Frag F;
    for (;;) {
        if (ti >= tk.ti_lo && ti <= tk.ti_hi && ((tk.need >> (ti >> tk.bshift)) & 1ull)) { frag_from_image(F, img0, lane); sm_step(st, qf, F, tk, ti, h); }
        if (ti == tend) break;
        *(LAS u32x4*)(img1 + woff) = r1;
        r1 = *(const GAS u32x4*)(gp + gstep * (size_t)(ti + 3 > tend ? tend : ti + 3));
        BLK_BAR(); ++ti;
        if (ti >= tk.ti_lo && ti <= tk.ti_hi && ((tk.need >> (ti >> tk.bshift)) & 1ull)) { frag_from_image(F, img1, lane); sm_step(st, qf, F, tk, ti, h); }
        if (ti == tend) break;
        *(LAS u32x4*)(img0 + woff) = r0;
        r0 = *(const GAS u32x4*)(gp + gstep * (size_t)(ti + 3 > tend ? tend : ti + 3));
        BLK_BAR(); ++ti;
    }
    const float lt_ = hsumf_(st.l);
    write_o(tk.orow, st.O, frcp(lt_), h);
}

DI void stick_compute(f32x16 (&O)[2], float& carry, const bf16x8 (&qf)[4], const Frag& f, int kt0, int t, int h) {
    f32x16 S;
#pragma unroll
    for (int i = 0; i < 16; ++i) S[i] = 0.f;
#pragma unroll
    for (int s = 0; s < 4; ++s) S = MFMA32(f.k[s], qf[s], S);
    float lsm[16], ls[16]; float sA = 0.f, sB = 0.f;
    const int key0 = kt0 + 8 * h; const float neg = NEG;
#pragma unroll
    for (int i = 0; i < 16; ++i) {
        const int key = key0 + 16 * (i >> 3) + (i & 7);
        const bool valid = key < t;
        const float z = S[i] * SM_SCALE;
        const float sp = fmaxf(z, 0.f) + flog2(1.f + fexp2(-fabsf(z) * LOG2E)) * LN2;
        lsm[i] = valid ? -sp : 0.f;
        ls[i] = valid ? z - sp : neg;
        if (i < 8) sA += lsm[i]; else sB += lsm[i];
    }
    const float pA = xhalf(sA), pB = xhalf(sB);
    const float baseB = carry + (h == 0 ? pB : 0.f), baseA = carry + sB + pB + (h == 0 ? pA : 0.f);
    float p[16]; float run = baseA;
#pragma unroll
    for (int e = 7; e >= 0; --e) { p[e] = fexp2((ls[e] + run) * LOG2E); run += lsm[e]; }
    run = baseB;
#pragma unroll
    for (int e = 15; e >= 8; --e) { p[e] = fexp2((ls[e] + run) * LOG2E); run += lsm[e]; }
    carry += (sA + sB) + (pA + pB);
    const bf16x8 pf0 = pack8(p), pf1 = pack8(p + 8);
    O[0] = MFMA32(f.v[0][0], pf0, O[0]); O[0] = MFMA32(f.v[0][1], pf1, O[0]);
    O[1] = MFMA32(f.v[1][0], pf0, O[1]); O[1] = MFMA32(f.v[1][1], pf1, O[1]);
}
DI void task_stick(unsigned char* ws, int b, int hh, int qt, int lane, LAS unsigned char* wl) {
    const int r = lane & 31, h = lane >> 5, t0 = 32 * qt, t = t0 + r;
    bf16_t* qrow = slot_ptr(ws, SL_QC) + (size_t)(b * SEQ + t) * 256 + hh * 64;
    bf16x8 qf[4]; load_q(qf, qrow, h);
    const bf16_t* kb = slot_ptr(ws, SL_KC) + (size_t)(b * SEQ + (lane >> 3)) * 256 + hh * 64 + 8 * (lane & 7);
    const bf16_t* vb0 = (const bf16_t*)(ws + WS_VT) + (size_t)(256 + hh * 64 + (lane >> 2)) * T + b * SEQ + 8 * (lane & 3);
    f32x16 O[2];
#pragma unroll
    for (int i = 0; i < 16; ++i) { O[0][i] = 0.f; O[1][i] = 0.f; }
    float carry = 0.f;
    int kt0 = t0;
    FragG GA, GB; Frag F;
    ldg(GA, kb + (size_t)kt0 * 256, 256, vb0 + kt0, T);
    for (;;) {
        int nk = kt0 - 32, lk = nk >= 0 ? nk : kt0;
        ldg(GB, kb + (size_t)lk * 256, 256, vb0 + lk, T);
        __builtin_amdgcn_sched_barrier(0);
        stage(GA, F, wl, lane);
        stick_compute(O, carry, qf, F, kt0, t, h);
        if (nk < 0 || __ballot(carry > -104.f) == 0ull) break;
        kt0 = nk; nk = kt0 - 32; lk = nk >= 0 ? nk : kt0;
        ldg(GA, kb + (size_t)lk * 256, 256, vb0 + lk, T);
        __builtin_amdgcn_sched_barrier(0);
        stage(GB, F, wl, lane);
        stick_compute(O, carry, qf, F, kt0, t, h);
        if (nk < 0 || __ballot(carry > -104.f) == 0ull) break;
        kt0 = nk;
    }
    write_o(qrow, O, 1.f, h);
}

DI void task_cmp(unsigned char* ws, int b, int qt, int lane, LAS float* imp, int hh0, int nh, bool leader) {
    const int r = lane & 31, h = lane >> 5, t0 = 32 * qt, t = t0 + r, cur = t0 >> 6;
    const int nvis = t >= 31 ? ((t - 31) >> 4) + 1 : 0;
    const int nvmax = (t0 >> 4) + 1, ntile = (nvmax + 31) >> 5;
    const bool need_imp = cur >= 16;
    if (leader) { for (int i = lane; i < 32 * 65; i += 64) imp[i] = 0.f; }
    BLK_BAR();
    const bf16_t* kb_ = (const bf16_t*)(ws + WS_KCMP) + (size_t)(b * 256 + kappa(r)) * 64 + 8 * h;
    const bf16_t* vb0_ = (const bf16_t*)(ws + WS_VCMPT) + (size_t)(b * 64 + r) * 256 + 8 * h;
    for (int hh = hh0; hh < hh0 + nh; ++hh) {
        const bf16_t* kb = launder_vp(kb_); const bf16_t* vb0 = launder_vp(vb0_); const bf16_t* vb1 = vb0 + 32 * 256;
        bf16_t* qrow = slot_ptr(ws, SL_QB) + (size_t)(b * SEQ + t) * 256 + hh * 64;
        bf16x8 qf[4]; load_q(qf, qrow, h);
        float m = MFLOOR, l = 0.f;
        bf16x8 kn[4];
#pragma unroll
        for (int s = 0; s < 4; ++s) kn[s] = ldfrag(kb + 16 * s);
        for (int tl = 0; tl < ntile; ++tl) {
            bf16x8 kf[4];
#pragma unroll
            for (int s = 0; s < 4; ++s) kf[s] = kn[s];
            const int nl = tl + 1 < ntile ? tl + 1 : tl;
#pragma unroll
            for (int s = 0; s < 4; ++s) kn[s] = ldfrag(kb + (size_t)(32 * nl) * 64 + 16 * s);
            f32x16 S;
#pragma unroll
            for (int i = 0; i < 16; ++i) S[i] = 0.f;
#pragma unroll
            for (int s = 0; s < 4; ++s) S = MFMA32(kf[s], qf[s], S);
            const float neg = NEG; float mx = MFLOOR;
#pragma unroll
            for (int i = 0; i < 16; ++i) { const int key = 32 * tl + 8 * h + 16 * (i >> 3) + (i & 7); const float v = key < nvis ? S[i] : neg; S[i] = v; mx = fmaxf(mx, v); }
            mx = hmaxf_(mx);
            const float mn = fmaxf(m, mx), mc = mn * SM_C;
            float rs = 0.f;
#pragma unroll
            for (int i = 0; i < 16; ++i) rs += fexp2(S[i] * SM_C - mc);
            l = l * fexp2((m - mn) * SM_C) + rs; m = mn;
        }
        const float lt = hsumf_(l);
        const float inv = nvis > 0 ? frcp(lt) : 0.f, mc = m * SM_C;
        f32x16 O[2];
#pragma unroll
        for (int i = 0; i < 16; ++i) { O[0][i] = 0.f; O[1][i] = 0.f; }
        Frag fn; ld_frag(fn, kb, vb0, vb1);
        for (int tl = 0; tl < ntile; ++tl) {
            bf16x8 kf[4], vf[2][2];
#pragma unroll
            for (int s = 0; s < 4; ++s) kf[s] = fn.k[s];
#pragma unroll
            for (int s = 0; s < 2; ++s) { vf[0][s] = fn.v[0][s]; vf[1][s] = fn.v[1][s]; }
            const int nl = tl + 1 < ntile ? tl + 1 : tl;
            ld_frag(fn, kb + (size_t)(32 * nl) * 64, vb0 + 32 * nl, vb1 + 32 * nl);
            f32x16 S;
#pragma unroll
            for (int i = 0; i < 16; ++i) S[i] = 0.f;
#pragma unroll
            for (int s = 0; s < 4; ++s) S = MFMA32(kf[s], qf[s], S);
            float p[16];
#pragma unroll
            for (int i = 0; i < 16; ++i) { const int key = 32 * tl + 8 * h + 16 * (i >> 3) + (i & 7); p[i] = key < nvis ? fexp2(S[i] * SM_C - mc) * inv : 0.f; }
            if (need_imp) {
#pragma unroll
                for (int a = 0; a < 2; ++a) {
                    const int u = 4 * tl + 2 * a + h; const float* q = p + 8 * a;
                    LAS float* row = imp + r * 65 + 2 * u;
                    atomicAdd((float*)(row + 0), (q[0] + q[1]) + (q[2] + q[3]));
                    atomicAdd((float*)(row + 1), (q[3] + q[4]) + (q[5] + q[6]) + q[7]);
                    if (2 * u + 2 < 64) atomicAdd((float*)(row + 2), q[7]);
                }
            }
            const bf16x8 pf0 = pack8(p), pf1 = pack8(p + 8);
            O[0] = MFMA32(vf[0][0], pf0, O[0]); O[0] = MFMA32(vf[0][1], pf1, O[0]);
            O[1] = MFMA32(vf[1][0], pf0, O[1]); O[1] = MFMA32(vf[1][1], pf1, O[1]);
        }
        write_o(qrow, O, 1.f, h);
    }
    asm volatile("s_waitcnt lgkmcnt(0)" ::: "memory");
    BLK_BAR();
    if (leader) {
        unsigned long long mask;
        if (cur <= 15) mask = (2ull << cur) - 1ull;
        else {
            float v[32];
#pragma unroll
            for (int i = 0; i < 32; ++i) v[i] = imp[r * 65 + 2 * i + h];
            mask = 1ull | (1ull << cur) | (1ull << (cur - 1));
            for (int k = 0; k < 13; ++k) {
                float best = -1.f; int bj = 64;
#pragma unroll
                for (int i = 0; i < 32; ++i) { const int j = 2 * i + h; const bool ok = j >= 1 && j <= cur - 2 && !((mask >> j) & 1ull); if (ok && v[i] > best) { best = v[i]; bj = j; } }
                const float ob = xhalf(best); const int oj = __shfl_xor(bj, 32);
                if (ob > best || (ob == best && oj < bj)) { best = ob; bj = oj; }
                if (bj < 64) mask |= 1ull << bj;
            }
        }
        if (lane < 32) ((GAS unsigned long long*)(ws + WS_NMASK))[b * SEQ + t] = mask;
    }
    asm volatile("s_waitcnt lgkmcnt(0)" ::: "memory");
}

DI void task_moba_gate(unsigned char* ws, int b, int hh, int qt, int lane) {
    const int r = lane & 31, h = lane >> 5, t0 = 32 * qt, t = t0 + r, cb = t0 >> 8;
    unsigned sel = 0u;
    if (cb <= 3) sel = (1u << cb) - 1u;
    else {
        const bf16_t* qrow = slot_ptr(ws, SL_QA) + (size_t)(b * SEQ + t) * 256 + hh * 64 + 32 * h;
        float q[32];
#pragma unroll
        for (int j = 0; j < 4; ++j) { float f[8]; load8(qrow + 8 * j, f);
#pragma unroll
            for (int e = 0; e < 8; ++e) q[8 * j + e] = f[e]; }
        const GAS float* km = (const GAS float*)(ws + WS_KMEAN) + (size_t)((b * 4 + hh) * 16) * 64 + 32 * h;
        float gate[16];
#pragma unroll
        for (int n = 0; n < 16; ++n) {
            float s = 0.f;
            if (n < cb) {
#pragma unroll
                for (int d = 0; d < 32; ++d) s += q[d] * km[n * 64 + d];
            }
            s += xhalf(s);
            gate[n] = n < cb ? s : sconst(-INFINITY);
        }
#pragma unroll
        for (int k = 0; k < 3; ++k) {
            float best = sconst(-INFINITY); int bi = -1;
#pragma unroll
            for (int n = 0; n < 16; ++n) if (!((sel >> n) & 1u) && gate[n] > best) { best = gate[n]; bi = n; }
            if (bi >= 0) sel |= 1u << bi;
        }
    }
    if (lane < 32) ((GAS unsigned*)(ws + WS_MMASK))[(b * 4 + hh) * SEQ + t] = sel | (1u << cb);
}

DI void task_kmean(unsigned char* ws, int b, int hh, int blk, int lane) {
    const bf16_t* kp = slot_ptr(ws, SL_KA) + (size_t)(b * SEQ + 256 * blk + (lane >> 3)) * 256 + hh * 64 + 8 * (lane & 7);
    float s[8];
#pragma unroll
    for (int e = 0; e < 8; ++e) s[e] = 0.f;
#pragma unroll 8
    for (int i = 0; i < 32; ++i) { float f[8]; load8(kp + (size_t)(8 * i) * 256, f);
#pragma unroll
        for (int e = 0; e < 8; ++e) s[e] += f[e]; }
#pragma unroll
    for (int e = 0; e < 8; ++e) { s[e] += __shfl_xor(s[e], 8); s[e] += __shfl_xor(s[e], 16); s[e] += __shfl_xor(s[e], 32); }
    if (lane < 8) {
        GAS float* o = (GAS float*)(ws + WS_KMEAN) + ((b * 4 + hh) * 16 + blk) * 64 + 8 * lane;
#pragma unroll
        for (int e = 0; e < 8; ++e) o[e] = s[e] * (1.f / 256.f);
    }
}

DI void task_mlp_block(unsigned char* ws, int kv, int b, int rt, int wave, int lane, LAS float* part) {
    const int r = lane & 31, h = lane >> 5, n = 32 * rt + r, ne = n > 254 ? 254 : n;
    const bf16_t* xp = slot_ptr(ws, SL_KB4) + (size_t)(b * SEQ + 16 * ne) * 256 + kv * 64 + 8 * h;
    const bf16_t* w1 = (const bf16_t*)(ws + WS_W1T) + (size_t)(kv * 256 + 32 * wave + kappa(r)) * 2048 + 8 * h;
    f32x16 acc;
#pragma unroll
    for (int i = 0; i < 16; ++i) acc[i] = 0.f;
    bf16x8 xa[4], wa[4], xb[4], wb[4];
#pragma unroll
    for (int s = 0; s < 4; ++s) { xa[s] = ldfrag(xp + 16 * s); wa[s] = ldfrag(w1 + 16 * s); }
    for (int l = 0; l < 32; l += 2) {
#pragma unroll
        for (int s = 0; s < 4; ++s) { xb[s] = ldfrag(xp + (size_t)(l + 1) * 256 + 16 * s); wb[s] = ldfrag(w1 + 64 * (l + 1) + 16 * s); }
#pragma unroll
        for (int s = 0; s < 4; ++s) acc = MFMA32(wa[s], xa[s], acc);
        const int l2 = l + 2 < 32 ? l + 2 : l;
#pragma unroll
        for (int s = 0; s < 4; ++s) { xa[s] = ldfrag(xp + (size_t)l2 * 256 + 16 * s); wa[s] = ldfrag(w1 + 64 * l2 + 16 * s); }
#pragma unroll
        for (int s = 0; s < 4; ++s) acc = MFMA32(wb[s], xb[s], acc);
    }
    const GAS float* bias = (const GAS float*)(ws + WS_BIAS) + kv * 256 + 32 * wave;
    const bf16_t* w2 = (const bf16_t*)(ws + WS_W2T) + (size_t)(kv * 64 + r) * 256 + 32 * wave + 8 * h;
    float g[16];
#pragma unroll
    for (int i = 0; i < 16; ++i) {
        const float x = acc[i] + bias[16 * (i >> 3) + 8 * h + (i & 7)];
        const float y = 0.7978845608028654f * (x + 0.044715f * x * x * x);
        const float th = 1.f - 2.f * frcp(1.f + fexp2(2.f * LOG2E * y));
        g[i] = 0.5f * x * (1.f + th);
    }
    const bf16x8 pf0 = pack8(g), pf1 = pack8(g + 8);
    f32x16 out[2];
#pragma unroll
    for (int i = 0; i < 16; ++i) { out[0][i] = 0.f; out[1][i] = 0.f; }
#pragma unroll
    for (int dt = 0; dt < 2; ++dt) {
        out[dt] = MFMA32(ldfrag(w2 + (size_t)(32 * dt) * 256), pf0, out[dt]);
        out[dt] = MFMA32(ldfrag(w2 + (size_t)(32 * dt) * 256 + 16), pf1, out[dt]);
    }
#pragma unroll
    for (int dt = 0; dt < 2; ++dt)
#pragma unroll
        for (int i = 0; i < 16; ++i) part[((wave * 2 + dt) * 16 + i) * 64 + lane] = out[dt][i];
    __syncthreads();
    const int dt = wave >> 2, gq = wave & 3;
    float sum[4];
#pragma unroll
    for (int e = 0; e < 4; ++e) { float a = 0.f;
#pragma unroll
        for (int w = 0; w < 8; ++w) a += part[((w * 2 + dt) * 16 + 4 * gq + e) * 64 + lane];
        sum[e] = n <= 254 ? a : 0.f; }
    const int d0 = 32 * dt + 8 * gq + 4 * h;
    if (kv == 0) store4((bf16_t*)(ws + WS_KCMP) + (size_t)(b * 256 + n) * 64 + d0, sum[0], sum[1], sum[2], sum[3]);
    else {
        bf16_t* vt = (bf16_t*)(ws + WS_VCMPT) + (size_t)(b * 64 + d0) * 256 + n;
#pragma unroll
        for (int e = 0; e < 4; ++e) ((GAS bf16_t*)vt)[e * 256] = (bf16_t)(pk2(sum[e], 0.f) & 0xffffu);
    }
    __syncthreads();
}

#define XB_TMO      128
#define XB_XCNT(j)  (256  + 64 * (j))
#define XB_XSUB(j)  (1280 + 64 * (j))
#define XB_XGEN(j)  (2304 + 64 * (j))
#define XB_TOP      3328
#define XB_TOPGEN   3392
#define XCD_BAR_WORDS 3456
#define XB_SPIN_CAP (1u << 18)

__device__ __forceinline__ unsigned xb_ld(unsigned* p)              { return __hip_atomic_load(p, __ATOMIC_RELAXED, __HIP_MEMORY_SCOPE_AGENT); }
__device__ __forceinline__ unsigned xb_add(unsigned* p, unsigned v) { return __hip_atomic_fetch_add(p, v, __ATOMIC_RELAXED, __HIP_MEMORY_SCOPE_AGENT); }
__device__ __forceinline__ unsigned xb_xcc_id() { return (unsigned)__builtin_amdgcn_s_getreg((3 << 11) | 20) & 0xFu; }
#define XB_SPIN(cond, bar) do { unsigned _sp = 0; while (cond) { __builtin_amdgcn_s_sleep(1); \
    if ((++_sp & 255u) == 0u) { if (xb_ld(&(bar)[XB_TMO])) break; if (_sp > XB_SPIN_CAP) { atomicAdd(&(bar)[XB_TMO], 1u); break; } } } } while (0)

struct XcdBarrier {
    unsigned* bar; unsigned x;
    volatile LAS unsigned* st;
};

__device__ __forceinline__ XcdBarrier xcd_barrier_post(unsigned* bar, volatile LAS unsigned* st) {
    XcdBarrier b; b.bar = bar; b.x = xb_xcc_id(); b.st = st;
    if (threadIdx.x == 0) (void)xb_add(&bar[XB_XCNT(b.x)], 1u);
    return b;
}
__device__ __forceinline__ void xcd_barrier_complete(unsigned* bar, unsigned x, unsigned& nloc, unsigned& nx) {
    const unsigned G = gridDim.x * gridDim.y * gridDim.z;
    unsigned sum, cnt, mine, sp = 0u;
    for (;;) {
        sum = 0u; cnt = 0u; mine = 0u;
#pragma unroll
        for (unsigned j = 0; j < 16; ++j) { const unsigned c = xb_ld(&bar[XB_XCNT(j)]); sum += c; cnt += (c > 0u) ? 1u : 0u; mine = (j == x) ? c : mine; }
        if (sum == G) break;
        __builtin_amdgcn_s_sleep(1);
        if ((++sp & 255u) == 0u) { if (xb_ld(&bar[XB_TMO])) break; if (sp > XB_SPIN_CAP) { atomicAdd(&bar[XB_TMO], 1u); break; } }
    }
    nloc = mine > 0u ? mine : 1u; nx = cnt > 0u ? cnt : 1u;
}

__device__ __forceinline__ void xcd_barrier(const XcdBarrier& b) {
    asm volatile("s_waitcnt vmcnt(0)" ::: "memory");
    __syncthreads();
    if (threadIdx.x == 0) {
        unsigned* bar = b.bar;
        __builtin_amdgcn_s_waitcnt(0);
        unsigned nloc = b.st[0], nx = b.st[1];
        if (nloc == 0u) { xcd_barrier_complete(bar, b.x, nloc, nx); b.st[0] = nloc; b.st[1] = nx; }
        const unsigned old = xb_add(&bar[XB_XSUB(b.x)], 1u);
        const unsigned gen = old / nloc;
        if (old + 1u == (gen + 1u) * nloc) {
            __builtin_amdgcn_fence(__ATOMIC_RELEASE, "agent");
            asm volatile("s_waitcnt vmcnt(0)" ::: "memory");
            const unsigned og = xb_add(&bar[XB_TOP], 1u);
            const unsigned tg = og / nx;
            if (og + 1u == (tg + 1u) * nx) xb_add(&bar[XB_TOPGEN], 1u);
            else XB_SPIN(xb_ld(&bar[XB_TOPGEN]) == tg, bar);
            __builtin_amdgcn_fence(__ATOMIC_ACQUIRE, "agent");
            xb_add(&bar[XB_XGEN(b.x)], 1u);
            asm volatile("s_waitcnt vmcnt(0)" ::: "memory");
        } else {
            XB_SPIN(xb_ld(&bar[XB_XGEN(b.x)]) == gen, bar);
            __builtin_amdgcn_fence(__ATOMIC_ACQUIRE, "agent");
            asm volatile("s_waitcnt vmcnt(0)" ::: "memory");
        }
    }
    __syncthreads();
}

struct Args { const float* in[9]; float* out; unsigned char* ws; int pad0, pad1; };

DI int launder(int x) { asm volatile("" : "+v"(x)); return x; }
DI unsigned char* launder_p(unsigned char* p) { asm volatile("" : "+s"(p)); return (unsigned char*)(__attribute__((address_space(1))) unsigned char*)p; }
#define FRESH() const int tid = launder(tid0), lane = tid & 63, gw = blockIdx.x * NWAVES + wave; (void)gw; (void)lane; unsigned char* ws = launder_p(ws0); (void)ws;
DI int next_task(unsigned* ctr, int lane) {
    int v = 0;
    if (lane == 0) v = (int)atomicAdd(ctr, 1u);
    return __builtin_amdgcn_readfirstlane(v);
}

#ifndef PROBE_A
#define PROBE_A 0
#define PROBE_B 0
#endif
enum { ST_P0 = 0, ST_BIAS, ST_G_QK, ST_G_VT, ST_P2, ST_P3, ST_P4, ST_G_GATE, ST_G_U0, ST_G_M0, ST_G_U1, ST_G_M1, ST_G_U2, ST_G_M2, ST_G_U3, ST_G_M3, ST_G_OUT, NSTEP_LAYER };

__global__ void __launch_bounds__(NWAVES * 64, 2) mega_fwd(Args a) {
    extern __shared__ __attribute__((aligned(16))) unsigned char lds_raw[];
    cg::grid_group grid = cg::this_grid();
    LAS unsigned char* lds = (LAS unsigned char*)lds_raw;
    const int tid0 = threadIdx.x, wave = __builtin_amdgcn_readfirstlane(tid0 >> 6);
    const int G = gridDim.x, NGW = G * NWAVES;
    unsigned char* ws0 = a.ws;

    volatile LAS unsigned* xst = (volatile LAS unsigned*)(lds + 131072 + 64);
    if (threadIdx.x == 0) { xst[0] = 0u; xst[1] = 0u; }
    __syncthreads();
    XcdBarrier xb; xb.bar = (unsigned*)(ws0 + WS_CTL + CTL_BAR); xb.x = 0u; xb.st = xst;
    if (blockIdx.x == 0) { for (int i = tid0; i < CTL_BYTES / 4; i += NWAVES * 64) ((GAS unsigned*)(ws0 + WS_CTL))[i] = 0u; }
    { FRESH();
    for (int e = blockIdx.x * (NWAVES * 64) + tid; e < SEQ * 32; e += G * NWAVES * 64) {
        const int pos = e >> 5, i = e & 31;
        const float inv = (float)exp2(-(double)i * (13.287712379549449 / 32.0));
        const float ang = (float)pos * inv;
        const double x = (double)ang, kq = rint(x * 0.6366197723675814);
        const double rr = (x - kq * 1.5707963267948966) - kq * 6.123233995736766e-17, r2 = rr * rr;
        const double sn = rr * (1.0 + r2 * (-1.0 / 6 + r2 * (1.0 / 120 + r2 * (-1.0 / 5040 + r2 * (1.0 / 362880 + r2 * (-1.0 / 39916800 + r2 * (1.0 / 6227020800.0)))))));
        const double cs = 1.0 + r2 * (-0.5 + r2 * (1.0 / 24 + r2 * (-1.0 / 720 + r2 * (1.0 / 40320 + r2 * (-1.0 / 3628800 + r2 * (1.0 / 479001600 + r2 * (-1.0 / 87178291200.0)))))));
        const int qd = (int)((long long)kq & 3);
        const double s_ = qd == 0 ? sn : qd == 1 ? cs : qd == 2 ? -sn : -cs, c_ = qd == 0 ? cs : qd == 1 ? -sn : qd == 2 ? -cs : sn;
        ((float*)(ws + WS_COS))[e] = (float)c_; ((float*)(ws + WS_SIN))[e] = (float)s_;
    } }

    for (int step = 0; step <= DEPTH * NSTEP_LAYER; ++step) {
        const int layer = step / NSTEP_LAYER, ls = step - layer * NSTEP_LAYER;
#if PROBE_A || PROBE_B
        if (blockIdx.x == 0 && tid0 == 0) ((unsigned long long*)(ws0 + WS_CTL + 2048))[32] = wall_clock64();
#endif
        if (layer == DEPTH) {
            FRESH(); const float* fw = a.in[8];
#if PROBE_A || PROBE_B
            float pa = 0.f, pb = 0.f;
            { const unsigned long long* tacc = (const unsigned long long*)(ws + WS_CTL + 2048);
              for (int k = 0; k < NSTEP_LAYER; ++k) { const float ms = (float)tacc[k] * 1e-5f; if ((PROBE_B >> k) & 1) pb += 0.002f * ms; } }
#endif
            for (int m = gw; m < T; m += 4 * NGW) {
                const GAS f32x4* wr4 = (const GAS f32x4*)fw + lane;
                f32x4 v[4][4]; float ss[4]; int mr[4];
#pragma unroll
                for (int q = 0; q < 4; ++q) { mr[q] = m + q * NGW < T ? m + q * NGW : m;
#pragma unroll
                    for (int j = 0; j < 4; ++j) v[q][j] = ((const GAS f32x4*)(a.out + (size_t)mr[q] * D) + lane)[64 * j]; }
                const float eps = sconst(1e-6f);
#pragma unroll
                for (int q = 0; q < 4; ++q) { float s = 0.f;
#pragma unroll
                    for (int j = 0; j < 4; ++j) s += (v[q][j].x * v[q][j].x + v[q][j].y * v[q][j].y) + (v[q][j].z * v[q][j].z + v[q][j].w * v[q][j].w);
                    ss[q] = rsqrtf(wave_sum(s) * (1.f / D) + eps); }
#pragma unroll
                for (int j = 0; j < 4; ++j) { const f32x4 w = wr4[64 * j];
#pragma unroll
                    for (int q = 0; q < 4; ++q) { f32x4 o = (f32x4){v[q][j].x * ss[q] * w.x, v[q][j].y * ss[q] * w.y, v[q][j].z * ss[q] * w.z, v[q][j].w * ss[q] * w.w};
#if PROBE_A || PROBE_B
                        o = o + ((lane & 1) ? pb : -pb); (void)pa;
#endif
                        if (q == 0 || mr[q] != m) ((GAS f32x4*)(a.out + (size_t)mr[q] * D) + lane)[64 * j] = o; } }
            }
            break;
        }
        const float* xin = layer == 0 ? a.in[0] : a.out;
        bool sync = false;
        if (ls == ST_P0) {
            const float* norm_w = a.in[1] + (size_t)layer * D;
            const float* w_in = a.in[2] + (size_t)layer * D * INW;
            const float* cmp_pos = a.in[3] + (size_t)layer * 2 * 2048;
            const float* cmp_w1 = a.in[4] + (size_t)layer * 2 * 2048 * 256;
            const float* cmp_w2 = a.in[5] + (size_t)layer * 2 * 256 * 64;
            const float* w_up = a.in[6] + (size_t)layer * 4 * 256 * D;
            const float* w_out = a.in[7] + (size_t)layer * D * D;
            FRESH(); LAS float* scr = (LAS float*)(lds + wave * 16384); bf16_t* Hb = (bf16_t*)(ws + WS_H);
            constexpr int I_QK = 16 * (NQK / 32), I_V = 16 * (NV / 32), I_G = 16 * 32, I_M = 16 * 128, I_UP = 4 * 4 * 32, I_OUT = 16 * 32, I_W1 = 2 * 32 * 8, I_W2 = 2 * 4 * 2;
            constexpr int NITEMS = I_QK + I_V + I_G + I_M + I_UP + I_OUT + I_W1 + I_W2;
            for (int it = gw; it < NITEMS; it += NGW) {
                int q = it;
                if (q < I_QK) { const int kb = q / (NQK / 32), nb = q % (NQK / 32); transpose_item(w_in, D, INW, (bf16_t*)(ws + WS_WQK), 64 * kb, 32 * nb, src_qk(32 * nb + (lane & 31)), scr, lane); continue; } q -= I_QK;
                if (q < I_V) { const int kb = q / (NV / 32), nb = q % (NV / 32); transpose_item(w_in, D, INW, (bf16_t*)(ws + WS_WV), 64 * kb, 32 * nb, src_v(32 * nb + (lane & 31)), scr, lane); continue; } q -= I_V;
                if (q < I_G) { const int kb = q / 32, nb = q % 32; transpose_item(w_in, D, INW, (bf16_t*)(ws + WS_WG), 64 * kb, 32 * nb, src_g(32 * nb + (lane & 31)), scr, lane); continue; } q -= I_G;
                if (q < I_M) { const int kb = q / 128, nb = q % 128; transpose_item(w_in, D, INW, (bf16_t*)(ws + WS_WM), 64 * kb, 32 * nb, MRG + 32 * nb + (lane & 31), scr, lane); continue; } q -= I_M;
                if (q < I_UP) { const int br = q / 128, q2 = q % 128, kb = q2 / 32, nb = q2 % 32; transpose_item(w_up + (size_t)br * 256 * D, 256, D, (bf16_t*)(ws + WS_WUP) + (size_t)br * D * 256, 64 * kb, 32 * nb, 32 * nb + (lane & 31), scr, lane); continue; } q -= I_UP;
                if (q < I_OUT) { const int kb = q / 32, nb = q % 32; transpose_item(w_out, D, D, (bf16_t*)(ws + WS_WOUT), 64 * kb, 32 * nb, 32 * nb + (lane & 31), scr, lane); continue; } q -= I_OUT;
                if (q < I_W1) { const int kv = q / 256, q2 = q % 256, kb = q2 / 8, nb = q2 % 8; transpose_item(cmp_w1 + (size_t)kv * 2048 * 256, 2048, 256, (bf16_t*)(ws + WS_W1T) + (size_t)kv * 256 * 2048, 64 * kb, 32 * nb, 32 * nb + (lane & 31), scr, lane); continue; } q -= I_W1;
                { const int kv = q / 8, q2 = q % 8, kb = q2 / 2, nb = q2 % 2; transpose_item(cmp_w2 + (size_t)kv * 256 * 64, 256, 64, (bf16_t*)(ws + WS_W2T) + (size_t)kv * 64 * 256, 64 * kb, 32 * nb, 32 * nb + (lane & 31), scr, lane); }
            }
            for (int it = gw; it < 2 * 4 * 32; it += NGW) {
                const int ch = it & 31, hg = (it >> 5) & 3, kv = it >> 7;
                const float* w1 = cmp_w1 + (size_t)kv * 2048 * 256 + (size_t)(64 * ch) * 256 + 64 * hg + lane; const float* pe = cmp_pos + kv * 2048 + 64 * ch;
                float s = 0.f;
#pragma unroll 8
                for (int f = 0; f < 64; ++f) s += pe[f] * w1[(size_t)f * 256];
                ((float*)(ws + WS_BIASP))[(ch * 2 + kv) * 256 + 64 * hg + lane] = s;
            }
            for (int m = gw; m < T; m += 2 * NGW) {
                const int m1 = m + NGW < T ? m + NGW : m;
                const GAS f32x4* xr0 = (const GAS f32x4*)(xin + (size_t)m * D) + lane; const GAS f32x4* xr1 = (const GAS f32x4*)(xin + (size_t)m1 * D) + lane; const GAS f32x4* wr4 = (const GAS f32x4*)norm_w + lane;
                f32x4 v0[4], v1[4]; float s0 = 0.f, s1 = 0.f;
#pragma unroll
                for (int j = 0; j < 4; ++j) { v0[j] = xr0[64 * j]; v1[j] = xr1[64 * j]; }
#pragma unroll
                for (int j = 0; j < 4; ++j) { s0 += (v0[j].x * v0[j].x + v0[j].y * v0[j].y) + (v0[j].z * v0[j].z + v0[j].w * v0[j].w); s1 += (v1[j].x * v1[j].x + v1[j].y * v1[j].y) + (v1[j].z * v1[j].z + v1[j].w * v1[j].w); }
                const float eps = sconst(1e-6f);
                const float rs0 = rsqrtf(wave_sum(s0) * (1.f / D) + eps), rs1 = rsqrtf(wave_sum(s1) * (1.f / D) + eps);
                GAS u32x2* o80 = (GAS u32x2*)(Hb + (size_t)m * D) + lane; GAS u32x2* o81 = (GAS u32x2*)(Hb + (size_t)m1 * D) + lane;
#pragma unroll
                for (int j = 0; j < 4; ++j) { const f32x4 w = wr4[64 * j]; u32x2 o0, o1;
                    o0.x = pk2(v0[j].x * rs0 * w.x, v0[j].y * rs0 * w.y); o0.y = pk2(v0[j].z * rs0 * w.z, v0[j].w * rs0 * w.w);
                    o1.x = pk2(v1[j].x * rs1 * w.x, v1[j].y * rs1 * w.y); o1.y = pk2(v1[j].z * rs1 * w.z, v1[j].w * rs1 * w.w);
                    o80[64 * j] = o0; if (m1 != m) o81[64 * j] = o1; }
            }
            sync = true;
        } else if (ls == ST_BIAS) {
            FRESH();
            if (blockIdx.x == 0) { float s = 0.f; for (int c = 0; c < 32; ++c) s += ((const float*)(ws + WS_BIASP))[c * 512 + tid]; ((float*)(ws + WS_BIAS))[tid] = s; }
        } else if (ls == ST_P2) {
        } else if (ls == ST_P3 || ls == ST_P4) {
            if (ls == ST_P3) {
                { FRESH();
                  for (int base = 0; base < 1024; base += 4 * G) {
                      const int it = base + blockIdx.x + G * (wave & 3); const int q = it < 1024 ? 1023 - it : 0;
                      task_cmp(ws, q & 7, q >> 3, lane, (LAS float*)(lds + (wave & 3) * 16384), 2 * (wave >> 2), it < 1024 ? 2 : 0, wave < 4 && it < 1024);
                  } }
                { FRESH();
                  for (int q = blockIdx.x + G * (NWAVES - 1 - wave); q < 4096; q += NGW) task_moba_gate(ws, q & 7, (q >> 3) & 3, q >> 5, lane); }
            }
            for (int pool = (ls == ST_P3 ? 0 : 2); pool < (ls == ST_P3 ? 2 : 3); ++pool) {
                FRESH();
                unsigned* ctr = (unsigned*)(ws + WS_CTL) + layer * 64 + 16 * pool;
                const int ngroups = pool == 0 ? 1024 : pool == 1 ? 1536 : 1024;
                volatile LAS int* gslot = (volatile LAS int*)(lds + 131072);
                for (;;) {
                    __syncthreads();
                    if (tid == 0) *gslot = (int)atomicAdd(ctr, 1u);
                    __syncthreads();
                    const int g = __builtin_amdgcn_readfirstlane(*gslot);
                    if (g >= ngroups) break;
                    const int lane = (int)__builtin_amdgcn_mbcnt_hi(~0u, __builtin_amdgcn_mbcnt_lo(~0u, (unsigned)launder(0))), tid = wave * 64 + lane;
                    if (pool == 2) {
                        const int lvl = 15 - (g >> 6), w = g & 63;
                        if (w < 32) run_heavy_group(ws, 0, w & 7, w >> 3, lvl, wave, lane, tid, lds);
                        else run_heavy_group(ws, 1, w & 7, 0, 4 * lvl + 3 - ((w - 32) >> 3), wave, lane, tid, lds);
                    }
                    else if (pool == 0 && g < 512) { task_stick(ws, g & 7, (g >> 3) & 3, 8 * (15 - (g >> 5)) + wave, lane, lds + wave * 16384); }
                    else {
                        if (pool == 1 && g < 512) run_heavy_group(ws, 2, g & 7, 0, 63 - (g >> 3), wave, lane, tid, lds);
                        else {
                        const int kd = pool == 0 ? 3 : 4 + ((g - 512) >> 9), w = g & 511;
                        task_sm(ws, kd, w & 7, (w >> 3) & 3, 8 * (w >> 5) + wave, lane, lds + wave * 16384);
                        }
                    }
                }
            }
            sync = true;
        } else {
            unsigned char* ws = launder_p(ws0); bf16_t* Hb = (bf16_t*)(ws + WS_H);
            pg8::Gemm g; Epi E{0, 0, ws, xin, a.out};
            if (ls == ST_G_QK) { g = pg8::Gemm{Hb, (const bf16_t*)(ws + WS_WQK), T, NQK, D}; E.kind = 0; sync = true; }
            else if (ls == ST_G_VT) { g = pg8::Gemm{(const bf16_t*)(ws + WS_WV), Hb, NV, T, D}; E.kind = 1; sync = true; }
            else if (ls == ST_G_GATE) { g = pg8::Gemm{Hb, (const bf16_t*)(ws + WS_WG), T, D, D}; E.kind = 2; sync = true; }
            else if (ls == ST_G_OUT) { g = pg8::Gemm{(const bf16_t*)(ws + WS_Y), (const bf16_t*)(ws + WS_WOUT), T, D, D}; E.kind = 5; sync = true; }
            else {
                const int k = ls - ST_G_U0, br = k >> 1;
                const int wslot = br == 0 ? SL_QA : br == 1 ? SL_QB : br == 2 ? SL_QC : SL_QD0;
                if ((k & 1) == 0) { g = pg8::Gemm{slot_ptr(ws, wslot), (const bf16_t*)(ws + WS_WUP) + (size_t)br * D * 256, T, D, 256}; E.kind = 3; }
                else { g = pg8::Gemm{Hb, (const bf16_t*)(ws + WS_WM) + (size_t)br * D * D, T, D, D}; E.kind = 4; E.first = (br == 0); sync = (br == 3); }
            }
            pg8::StaticOrder S; S.init(g.M, g.N, G, (int)blockIdx.x);
            if (ls == ST_G_VT) {
                FRESH();
                if (G == 256) {
                    if (blockIdx.x < 128) task_mlp_block(ws, blockIdx.x >> 6, (blockIdx.x >> 3) & 7, blockIdx.x & 7, wave, lane, (LAS float*)lds);
                    else if (blockIdx.x < 192) { const int q = (blockIdx.x - 128) * NWAVES + wave; task_kmean(ws, q >> 6, (q >> 4) & 3, q & 15, lane); }
                    S.split = 128;
                } else {
                    for (int q = gw; q < 512; q += NGW) task_kmean(ws, q >> 6, (q >> 4) & 3, q & 15, lane);
                    for (int it = blockIdx.x; it < 128; it += G) task_mlp_block(ws, it >> 6, (it >> 3) & 7, it & 7, wave, lane, (LAS float*)lds);
                }
                __syncthreads();
            }
            pg8::gemm_phase<Epi, pg8::StaticOrder, true, true>(lds, g, S, E);
        }
        if (sync) { if (step == 0) { grid.sync(); xb = xcd_barrier_post((unsigned*)(ws0 + WS_CTL + CTL_BAR), xst); } else xcd_barrier(xb); }
#if PROBE_A || PROBE_B
        if (blockIdx.x == 0 && tid0 == 0) { unsigned long long* tp = (unsigned long long*)(ws0 + WS_CTL + 2048); tp[ls] += wall_clock64() - tp[32]; }
#endif
    }
}

extern "C" void kernel_launch(void* const* d_in, const int* in_sizes, int n_in, void* d_out, int out_size, void* d_ws, size_t ws_size, hipStream_t stream) {
    static int grid = 0;
    if (grid == 0) {
        int dev = 0, cus = 0, per_cu = 0;
        hipGetDevice(&dev);
        hipDeviceGetAttribute(&cus, hipDeviceAttributeMultiprocessorCount, dev);
        hipFuncSetAttribute((const void*)mega_fwd, hipFuncAttributeMaxDynamicSharedMemorySize, LDS_BYTES);
        hipOccupancyMaxActiveBlocksPerMultiprocessor(&per_cu, (const void*)mega_fwd, NWAVES * 64, LDS_BYTES);
        (void)hipGetLastError();
        grid = cus;
        if (n_in != 9 || out_size != T * D || ws_size < WS_END || per_cu < 1) { fprintf(stderr, "kernel_launch: unexpected problem (n_in %d out %d ws %zu per_cu %d)\n", n_in, out_size, ws_size, per_cu); grid = -1; }
    }
    if (grid < 0) return;
    Args a{};
    for (int i = 0; i < 9; ++i) a.in[i] = (const float*)d_in[i];
    a.out = (float*)d_out; a.ws = (unsigned char*)d_ws;
    void* args[] = {&a};
    hipError_t e = hipLaunchCooperativeKernel((const void*)mega_fwd, dim3(grid), dim3(NWAVES * 64), args, LDS_BYTES, stream);
    if (e != hipSuccess) fprintf(stderr, "cooperative launch failed: %s\n", hipGetErrorString(e));
}
```

```cpp
#include <hip/hip_runtime.h>
#include <hip/hip_cooperative_groups.h>
#include <cstdio>
#include <cstdint>
namespace cg = cooperative_groups;
__device__ __forceinline__ int launder_i(int x) { asm volatile("" : "+v"(x)); return x; }
namespace pg8 {
#define PG8_LAS __attribute__((address_space(3)))
typedef unsigned short bf16_t;
typedef short bf16x8 __attribute__((ext_vector_type(8)));
typedef float f32x4 __attribute__((ext_vector_type(4)));
typedef unsigned u32x4 __attribute__((ext_vector_type(4)));
constexpr int BM = 256, BK = 64, HALF = 128, HTB = HALF * BK * 2  , STAGE_BYTES = 8 * HTB, NXCD = 8, WGM = 8;

__host__ __device__ __forceinline__ int lds_byte(int r, int c) { const int st = (r >> 4) * 2 + (c >> 5), rr = r & 15, cc = c & 31, ob = rr * 64 + cc * 2; return st * 1024 + (ob ^ (((ob >> 9) & 1) << 5)); }
__host__ __device__ __forceinline__ void stage_rc(int b, int& R, int& C) { const int st = b / 1024, sb = b % 1024, swz = sb ^ (((sb >> 9) & 1) << 5); R = (st >> 1) * 16 + swz / 64; C = (st & 1) * 32 + (swz % 64) / 2; }
__host__ __device__ __forceinline__ int perm32(int rho) { const int n = rho >> 4, i = rho & 15; return 8 * (i >> 2) + 4 * n + (i & 3); }

struct Unit { int pm, pn; };
struct Gemm { const bf16_t* A; const bf16_t* Bt; int M, N, K; };

struct StaticOrder {
    int nM, nN, nwg, G, c, split;
    __host__ __device__ void init(int M, int N, int G_, int c_) { nM = M / BM; nN = N / BM; nwg = nM * nN; G = G_; c = c_; split = 0; }
    __host__ __device__ bool next(int i, Unit& u) const {
        if (split) {
            const int per = c < split ? 2 : 4; if (i >= per) return false;
            const int L2 = c < split ? 2 * c + i : 2 * split + 4 * (c - split) + i;
            u.pm = L2 % nM; u.pn = L2 / nM; return true;
        }
        const long L = (long)i * G + c; if (L >= nwg) return false;
        int wgid = (int)L; { const int q = nwg / NXCD, r = nwg % NXCD, xcd = wgid % NXCD, off = wgid / NXCD; wgid = (xcd < r ? xcd * (q + 1) : r * (q + 1) + (xcd - r) * q) + off; }
        const int nig = WGM * nN, gid = wgid / nig, fm = gid * WGM, gsz = (nM - fm) < WGM ? (nM - fm) : WGM;
        u.pm = fm + ((wgid % nig) % gsz); u.pn = (wgid % nig) / gsz; return true;
    }
    __device__ __forceinline__ void a_ready(const Unit&) const {}
    __device__ __forceinline__ void done(const Unit&) const {}
};

__device__ __forceinline__ unsigned cvt_pk_bf16(float lo, float hi) { unsigned r; asm volatile("v_cvt_pk_bf16_f32 %0, %1, %2" : "=v"(r) : "v"(lo), "v"(hi)); return r; }
template <class Epi, class Sched, bool ALIGN_EPI = false, bool SP2 = false>
__device__ __forceinline__ void gemm_phase(PG8_LAS unsigned char* lds, const Gemm g, const Sched& S, const Epi& E) {
    const int tid = launder_i((int)threadIdx.x), wid = __builtin_amdgcn_readfirstlane(tid >> 6), lane = tid & 63, wr = wid >> 2, wc = wid & 3, fr = lane & 15, fq = lane >> 4;
    const int K = g.K, nt = K / BK;
    unsigned voffA[2], voffB[2];
#pragma unroll
    for (int i = 0; i < 2; ++i) { int R, C; stage_rc(tid * 16 + i * 8192, R, C); const int Rb = Epi::PERM ? ((R & ~31) + perm32(R & 31)) : R;
        voffA[i] = (unsigned)(R * K + C) * 2u; voffB[i] = (unsigned)(Rb * K + C) * 2u; }
    const size_t kstep = (size_t)(BK * 2);
    const size_t hstep = (size_t)HALF * K * 2;
    const size_t tstep = 2 * hstep;
    const unsigned ldsw = (unsigned)wid * 1024u;
    const int aoff = lds_byte(wr * 64 + fr, fq * 8), boff = lds_byte(wc * 32 + fr, fq * 8);
#define PG8_SA(b, h) (((b) * 2 + (h)) * HTB)
#define PG8_SB(b, h) ((4 + (b) * 2 + (h)) * HTB)
#define PG8_STAGE(bufoff, gbase, voff) do { _Pragma("unroll") for (int _i = 0; _i < 2; ++_i) \
        __builtin_amdgcn_global_load_lds((const unsigned*)((const char*)(gbase) + (voff)[_i]), (PG8_LAS unsigned*)(lds + (bufoff) + ldsw + _i * 8192), 16, 0, 0); } while (0)
#define PG8_LDA(dst, b, h) do { _Pragma("unroll") for (int m = 0; m < 4; ++m) _Pragma("unroll") for (int k = 0; k < 2; ++k) dst[m][k] = *(const PG8_LAS bf16x8*)(lds + PG8_SA(b, h) + aoff + m * 2048 + k * 1024); } while (0)
#define PG8_LDB(dst, b, h) do { _Pragma("unroll") for (int n = 0; n < 2; ++n) _Pragma("unroll") for (int k = 0; k < 2; ++k) dst[n][k] = *(const PG8_LAS bf16x8*)(lds + PG8_SB(b, h) + boff + n * 2048 + k * 1024); } while (0)
#define PG8_MMA(ai, bj, At, Bt) do { __builtin_amdgcn_s_setprio(1); _Pragma("unroll") for (int m = 0; m < 4; ++m) _Pragma("unroll") for (int n = 0; n < 2; ++n) _Pragma("unroll") for (int k = 0; k < 2; ++k) \
        acc[ai][bj][m][n] = __builtin_amdgcn_mfma_f32_16x16x32_bf16(Bt[n][k], At[m][k], acc[ai][bj][m][n], 0, 0, 0); __builtin_amdgcn_s_setprio(0); } while (0)
#define PG8_WAIT_V(n) asm volatile("s_waitcnt vmcnt(" #n ")" ::: "memory")
#define PG8_WAIT_L(n) asm volatile("s_waitcnt lgkmcnt(" #n ")" ::: "memory")
#define PG8_BAR __builtin_amdgcn_s_barrier()
#define PG8_SCHED __builtin_amdgcn_sched_barrier(0)
    Unit cur, nxt; int ui = 0;
    if (!S.next(0, cur)) return;
    f32x4 acc[2][2][4][2];
#pragma unroll
    for (int a = 0; a < 2; ++a)
#pragma unroll
        for (int b = 0; b < 2; ++b)
#pragma unroll
            for (int m = 0; m < 4; ++m)
#pragma unroll
                for (int n = 0; n < 2; ++n) acc[a][b][m][n] = (f32x4){0.f, 0.f, 0.f, 0.f};
    bf16x8 At[4][2], B0[2][2], B1[2][2];
    const char* cA = (const char*)g.A + (size_t)cur.pm * tstep; const char* cB = (const char*)g.Bt + (size_t)cur.pn * tstep;
    S.a_ready(cur);
    if constexpr (SP2) {
        PG8_STAGE(PG8_SB(0, 0), cB, voffB); PG8_STAGE(PG8_SB(0, 1), cB + hstep, voffB); PG8_STAGE(PG8_SA(0, 0), cA, voffA); PG8_STAGE(PG8_SA(0, 1), cA + hstep, voffA);
        if (wr == 1) PG8_BAR;
        PG8_WAIT_V(2); PG8_BAR;
        PG8_STAGE(PG8_SB(1, 0), cB + kstep, voffB); PG8_STAGE(PG8_SA(1, 0), cA + kstep, voffA); PG8_STAGE(PG8_SB(1, 1), cB + hstep + kstep, voffB);
        PG8_WAIT_V(6); PG8_BAR;
    } else {
        PG8_STAGE(PG8_SB(0, 0), cB, voffB); PG8_STAGE(PG8_SA(0, 0), cA, voffA); PG8_STAGE(PG8_SB(0, 1), cB + hstep, voffB); PG8_STAGE(PG8_SA(0, 1), cA + hstep, voffA);
        if (wr == 1) PG8_BAR;
        PG8_WAIT_V(4); PG8_BAR;
        PG8_STAGE(PG8_SB(1, 0), cB + kstep, voffB); PG8_STAGE(PG8_SA(1, 0), cA + kstep, voffA); PG8_STAGE(PG8_SB(1, 1), cB + hstep + kstep, voffB);
        PG8_WAIT_V(6); PG8_BAR;
    }
    for (;;) {
        const bool has_next = S.next(ui + 1, nxt);
        const char* nA = has_next ? (const char*)g.A + (size_t)nxt.pm * tstep : cA; const char* nB = has_next ? (const char*)g.Bt + (size_t)nxt.pn * tstep : cB;
        for (int t = 0; t < nt; t += 2) {
            const bool last = (t == nt - 2);
            const char* a1 = cA + (size_t)(t + 1) * kstep;
            const char* a2 = last ? nA : cA + (size_t)(t + 2) * kstep; const char* b2 = last ? nB : cB + (size_t)(t + 2) * kstep;
            const char* a3 = a2 + kstep; const char* b3 = b2 + kstep;
            if (last && has_next) S.a_ready(nxt);
            if constexpr (SP2) {
            PG8_LDB(B0, 0, 0); PG8_LDB(B1, 0, 1); PG8_SCHED; PG8_LDA(At, 0, 0); PG8_STAGE(PG8_SA(1, 1), a1 + hstep, voffA);
            PG8_WAIT_V(8); PG8_WAIT_L(0); PG8_BAR; PG8_MMA(0, 0, At, B0); PG8_MMA(0, 1, At, B1); PG8_BAR; PG8_SCHED;
            PG8_LDA(At, 0, 1); PG8_STAGE(PG8_SB(0, 0), b2, voffB); PG8_STAGE(PG8_SB(0, 1), b2 + hstep, voffB); PG8_STAGE(PG8_SA(0, 0), a2, voffA);
            PG8_WAIT_V(8); PG8_WAIT_L(0); PG8_BAR; PG8_MMA(1, 0, At, B0); PG8_MMA(1, 1, At, B1); PG8_BAR; PG8_SCHED;
            PG8_LDB(B0, 1, 0); PG8_LDB(B1, 1, 1); PG8_SCHED; PG8_LDA(At, 1, 0); PG8_STAGE(PG8_SA(0, 1), a2 + hstep, voffA);
            PG8_WAIT_V(8); PG8_WAIT_L(0); PG8_BAR; PG8_MMA(0, 0, At, B0); PG8_MMA(0, 1, At, B1); PG8_BAR; PG8_SCHED;
            PG8_LDA(At, 1, 1); PG8_STAGE(PG8_SB(1, 0), b3, voffB); PG8_STAGE(PG8_SB(1, 1), b3 + hstep, voffB); PG8_STAGE(PG8_SA(1, 0), a3, voffA);
            PG8_WAIT_V(8); PG8_WAIT_L(0); PG8_BAR; PG8_MMA(1, 0, At, B0); PG8_MMA(1, 1, At, B1); PG8_BAR; PG8_SCHED;
            } else {
            PG8_LDB(B0, 0, 0); PG8_SCHED; PG8_LDA(At, 0, 0); PG8_STAGE(PG8_SA(1, 1), a1 + hstep, voffA);
            PG8_WAIT_L(8); PG8_BAR; PG8_WAIT_L(0); PG8_MMA(0, 0, At, B0); PG8_BAR; PG8_SCHED;
            PG8_LDB(B1, 0, 1); PG8_STAGE(PG8_SB(0, 0), b2, voffB);
            PG8_BAR; PG8_WAIT_L(0); PG8_MMA(0, 1, At, B1); PG8_BAR;
            PG8_LDA(At, 0, 1); PG8_STAGE(PG8_SA(0, 0), a2, voffA);
            PG8_BAR; PG8_WAIT_L(0); PG8_MMA(1, 0, At, B0); PG8_BAR; PG8_SCHED;
            PG8_STAGE(PG8_SB(0, 1), b2 + hstep, voffB);
            PG8_WAIT_V(6); PG8_BAR; PG8_MMA(1, 1, At, B1); PG8_BAR;
            PG8_LDB(B0, 1, 0); PG8_SCHED; PG8_LDA(At, 1, 0); PG8_STAGE(PG8_SA(0, 1), a2 + hstep, voffA);
            PG8_WAIT_L(8); PG8_BAR; PG8_WAIT_L(0); PG8_MMA(0, 0, At, B0); PG8_BAR; PG8_SCHED;
            PG8_LDB(B1, 1, 1); PG8_STAGE(PG8_SB(1, 0), b3, voffB);
            PG8_BAR; PG8_WAIT_L(0); PG8_MMA(0, 1, At, B1); PG8_BAR;
            PG8_LDA(At, 1, 1); PG8_STAGE(PG8_SA(1, 0), a3, voffA);
            PG8_BAR; PG8_WAIT_L(0); PG8_MMA(1, 0, At, B0); PG8_BAR; PG8_SCHED;
            PG8_STAGE(PG8_SB(1, 1), b3 + hstep, voffB);
            PG8_WAIT_V(6); PG8_BAR; PG8_MMA(1, 1, At, B1); PG8_BAR;
            }
        }
        if constexpr (ALIGN_EPI) { if (wr == 0) PG8_BAR; }
        if constexpr (!Epi::AFTER_DRAIN) { E(acc, cur, wr, wc, fr, fq); S.done(cur); }
        if (!has_next) break;
#pragma unroll
        for (int a = 0; a < 2; ++a)
#pragma unroll
            for (int b = 0; b < 2; ++b)
#pragma unroll
                for (int m = 0; m < 4; ++m)
#pragma unroll
                    for (int n = 0; n < 2; ++n) acc[a][b][m][n] = (f32x4){0.f, 0.f, 0.f, 0.f};
        cur = nxt; cA = nA; cB = nB; ++ui;
        if constexpr (ALIGN_EPI) { if (wr == 1) PG8_BAR; }
    }
    PG8_WAIT_V(0);
    if constexpr (!ALIGN_EPI) { if (wr == 0) PG8_BAR; }
    PG8_BAR;
    if constexpr (Epi::AFTER_DRAIN) { E.fused(acc, cur, wr, wc, fr, fq, lds, wid, lane); S.done(cur); }
#undef PG8_SA
#undef PG8_SB
#undef PG8_STAGE
#undef PG8_LDA
#undef PG8_LDB
#undef PG8_MMA
#undef PG8_WAIT_V
#undef PG8_WAIT_L
#undef PG8_BAR
#undef PG8_SCHED
}
}

constexpr int NWAVES = 8;
constexpr int LDS_BYTES = 135168;
constexpr int NB = 8, SEQ = 4096, T = NB * SEQ, D = 1024, INW = 9612, DEPTH = 2;
constexpr int A_Q = 0, A_K = 256, A_V = 512, A_G = 768, B_Q = 1024, B_KC = 1280, B_VC = 1344, B_KS = 1408, B_VS = 1472, B_KW = 1536, B_VW = 1600, B_G = 1664, B_NG = 1920,
              C_Q = 1932, C_K = 2188, C_V = 2444, C_G = 2700, D_Q = 2956, D_K = 3724, D_V = 4492, D_G = 5260, MRG = 5516;
constexpr size_t MiB = 1u << 20, KiB = 1024;
constexpr size_t WS_CTL = 0, WS_COS = 1 * MiB, WS_SIN = 1 * MiB + 512 * KiB, WS_KMEAN = 2 * MiB, WS_BIASP = 2 * MiB + 128 * KiB, WS_BIAS = 2 * MiB + 192 * KiB,
                 WS_KCMP = 2 * MiB + 512 * KiB, WS_VCMPT = 2 * MiB + 768 * KiB, WS_MMASK = 3 * MiB, WS_NMASK = 3 * MiB + 512 * KiB, WS_LSE = 4 * MiB,
                 WS_W1T = 6 * MiB, WS_W2T = 8 * MiB, WS_WQK = 9 * MiB, WS_WV = 15 * MiB, WS_WG = 18 * MiB, WS_WM = 20 * MiB, WS_WUP = 28 * MiB, WS_WOUT = 30 * MiB,
                 WS_H = 32 * MiB, WS_QK = 96 * MiB, WS_VT = 320 * MiB, WS_U = 320 * MiB, WS_Y = 224 * MiB, WS_END = 432 * MiB;
constexpr size_t SLOT_BYTES = 16 * MiB;
constexpr int SL_QA = 0, SL_QB = 1, SL_QC = 2, SL_QD0 = 3, SL_QBR = 4, SL_QD1 = 5, SL_QD2 = 6, SL_OWIN = 7, SL_KA = 8, SL_KB4 = 9, SL_KC = 10, SL_KD0 = 11, SL_OSLC = 20;
constexpr int NQK = 3072, NV = 1536;
constexpr int CTL_BYTES = 4096 + 16384;
constexpr size_t CTL_BAR = 4096;

typedef unsigned short bf16_t;
typedef short bf16x8 __attribute__((ext_vector_type(8)));
typedef float f32x4 __attribute__((ext_vector_type(4)));
typedef float f32x2 __attribute__((ext_vector_type(2)));
typedef float f32x16 __attribute__((ext_vector_type(16)));
typedef unsigned u32x4 __attribute__((ext_vector_type(4)));
typedef unsigned u32x2 __attribute__((ext_vector_type(2)));
typedef __bf16 bf16v2 __attribute__((ext_vector_type(2)));
#define LAS __attribute__((address_space(3)))
#define GAS __attribute__((address_space(1)))
#define DI __device__ __forceinline__
#define MFMA32(a, b, c) __builtin_amdgcn_mfma_f32_32x32x16_bf16((a), (b), (c), 0, 0, 0)

constexpr float LOG2E = 1.4426950408889634f, LN2 = 0.6931471805599453f;
DI float sconst(float x) { asm volatile("" : "+s"(x)); return x; }
constexpr float SM_SCALE = 0.125f, SM_C = 0.125f * LOG2E, NEG_C = -1e30f, MFLOOR_C = -30000.f;
#define NEG sconst(NEG_C)
#define MFLOOR sconst(MFLOOR_C)

DI unsigned pk2(float lo, float hi) { const bf16v2 r = __builtin_convertvector((f32x2){lo, hi}, bf16v2); return __builtin_bit_cast(unsigned, r); }
DI float bf_lo(unsigned w) { return __uint_as_float(w << 16); }
DI float bf_hi(unsigned w) { return __uint_as_float(w & 0xffff0000u); }
DI float bf1(bf16_t x) { return __uint_as_float((unsigned)x << 16); }
DI float fexp2(float x) { return __builtin_amdgcn_exp2f(x); }
DI float flog2(float x) { return __builtin_amdgcn_logf(x); }
DI float frcp(float x) { return __builtin_amdgcn_rcpf(x); }
DI float sigmoidf_(float x) { return frcp(1.f + fexp2(-x * LOG2E)); }
DI float wave_sum(float v) {
#pragma unroll
    for (int o = 1; o < 64; o <<= 1) v += __shfl_xor(v, o);
    return v;
}
DI float xhalf(float v) { return __shfl_xor(v, 32); }
DI float hmaxf_(float v) { const auto r = __builtin_amdgcn_permlane32_swap(__float_as_uint(v), __float_as_uint(v), false, false); return fmaxf(__uint_as_float(r[0]), __uint_as_float(r[1])); }
DI float hsumf_(float v) { const auto r = __builtin_amdgcn_permlane32_swap(__float_as_uint(v), __float_as_uint(v), false, false); return __uint_as_float(r[0]) + __uint_as_float(r[1]); }
DI bf16_t* slot_ptr(unsigned char* ws, int s) { return (bf16_t*)(ws + WS_QK + (size_t)s * SLOT_BYTES); }
DI void load8(const bf16_t* p, float (&f)[8]) { const u32x4 w = *(const GAS u32x4*)p; f[0] = bf_lo(w.x); f[1] = bf_hi(w.x); f[2] = bf_lo(w.y); f[3] = bf_hi(w.y); f[4] = bf_lo(w.z); f[5] = bf_hi(w.z); f[6] = bf_lo(w.w); f[7] = bf_hi(w.w); }
DI void store8(bf16_t* p, const float (&f)[8]) { u32x4 w; w.x = pk2(f[0], f[1]); w.y = pk2(f[2], f[3]); w.z = pk2(f[4], f[5]); w.w = pk2(f[6], f[7]); *(GAS u32x4*)p = w; }
DI void store4(bf16_t* p, float a, float b, float c, float d) { u32x2 w; w.x = pk2(a, b); w.y = pk2(c, d); *(GAS u32x2*)p = w; }

struct Epi {
    static constexpr bool PERM = true, AFTER_DRAIN = false;
    int kind, first; unsigned char* ws; const float* xin; float* xout;
    typedef pg8::f32x4 a4;
    DI void operator()(const a4 (&acc)[2][2][4][2], const pg8::Unit& u, int wr, int wc, int fr, int fq) const {
        if (kind == 0) {
            const int tile = u.pn;
            const int slot = (int)((0xDCB653A29180ull >> (4 * tile)) & 15ull);
            bf16_t* dst = slot_ptr(ws, slot); bf16_t* dst2 = slot_ptr(ws, SL_QBR);
            const bool ropeall = (tile <= 1) || (tile >= 6);
            const int g = 4 * (wc & 1) + fq, d0 = 4 * g;
            const float* cosT = (const float*)(ws + WS_COS); const float* sinT = (const float*)(ws + WS_SIN);
#pragma unroll
            for (int ai = 0; ai < 2; ++ai)
#pragma unroll
                for (int m = 0; m < 4; ++m) {
                    const int tok = u.pm * 256 + ai * 128 + wr * 64 + m * 16 + fr, pos = tok & (SEQ - 1);
                    const f32x4 cs = *(const GAS f32x4*)(cosT + pos * 32 + d0), sn = *(const GAS f32x4*)(sinT + pos * 32 + d0);
#pragma unroll
                    for (int bj = 0; bj < 2; ++bj) {
                        const int hs = 2 * bj + (wc >> 1);
                        const a4 v0 = acc[ai][bj][m][0], v1 = acc[ai][bj][m][1];
                        const a4 r0 = v0 * cs - v1 * sn, r1 = v0 * sn + v1 * cs;
                        const size_t off = (size_t)tok * 256 + hs * 64 + d0;
                        const bool rope = ropeall || (tile == 3 && hs >= 2);
                        if (tile == 2) { store4(dst + off, v0[0], v0[1], v0[2], v0[3]); store4(dst + off + 32, v1[0], v1[1], v1[2], v1[3]);
                                         store4(dst2 + off, r0[0], r0[1], r0[2], r0[3]); store4(dst2 + off + 32, r1[0], r1[1], r1[2], r1[3]); }
                        else if (rope) { store4(dst + off, r0[0], r0[1], r0[2], r0[3]); store4(dst + off + 32, r1[0], r1[1], r1[2], r1[3]); }
                        else { store4(dst + off, v0[0], v0[1], v0[2], v0[3]); store4(dst + off + 32, v1[0], v1[1], v1[2], v1[3]); }
                    }
                    asm volatile("" ::: "memory");
                }
        } else if (kind == 1) {
            bf16_t* VT = (bf16_t*)(ws + WS_VT);
#pragma unroll
            for (int ai = 0; ai < 2; ++ai)
#pragma unroll
                for (int m = 0; m < 4; ++m) {
                    const int r = u.pm * 256 + ai * 128 + wr * 64 + m * 16 + fr;
                    bf16_t* rowp = VT + (size_t)r * T;
                    const bool gate = (r >= 1408 && r < 1420);
#pragma unroll
                    for (int bj = 0; bj < 2; ++bj) {
                        const int c0 = u.pn * 256 + bj * 128 + wc * 32 + 8 * fq;
                        const a4 v0 = acc[ai][bj][m][0], v1 = acc[ai][bj][m][1];
                        float v[8] = {v0[0], v0[1], v0[2], v0[3], v1[0], v1[1], v1[2], v1[3]};
                        if (gate) {
#pragma unroll
                            for (int j = 0; j < 8; ++j) v[j] = sigmoidf_(v[j]);
                        }
                        if (u.pm == 3) {
                            const int b = c0 >> 12, p0 = c0 & (SEQ - 1), mm0 = p0 >> 2;
                            bf16_t* q = rowp + b * SEQ + mm0;
#pragma unroll
                            for (int c = 0; c < 4; ++c) *(GAS unsigned*)(q + c * 1024) = pk2(v[c], v[c + 4]);
                        } else if (u.pm == 4) {
                            const int b = c0 >> 12, p0 = c0 & (SEQ - 1), mm = p0 >> 4, cc0 = p0 & 15;
                            bf16_t* q = rowp + b * SEQ + cc0 * 256 + mm;
#pragma unroll
                            for (int j = 0; j < 8; ++j) ((GAS bf16_t*)q)[j * 256] = (bf16_t)(pk2(v[j], 0.f) & 0xffffu);
                        } else store8(rowp + c0, v);
                    }
                    asm volatile("" ::: "memory");
                }
        } else if (kind == 2) {
            const int br = u.pn;
            const bf16_t* VT = (const bf16_t*)(ws + WS_VT);
            const float* LSE = (const float*)(ws + WS_LSE);
#pragma unroll
            for (int ai = 0; ai < 2; ++ai)
#pragma unroll
                for (int m = 0; m < 4; ++m) {
                    const int tok = u.pm * 256 + ai * 128 + wr * 64 + m * 16 + fr;
#pragma unroll
                    for (int bj = 0; bj < 2; ++bj) {
                        const int cb = bj * 128 + wc * 32 + 8 * fq, head = cb >> 6;
                        const a4 v0 = acc[ai][bj][m][0], v1 = acc[ai][bj][m][1];
                        float gt[8] = {v0[0], v0[1], v0[2], v0[3], v1[0], v1[1], v1[2], v1[3]};
                        const size_t off = (size_t)tok * 256 + cb;
                        float o[8];
                        bf16_t* dst;
                        if (br == 0) { dst = slot_ptr(ws, SL_QA) + off; load8(dst, o); }
                        else if (br == 2) { dst = slot_ptr(ws, SL_QC) + off; load8(dst, o); }
                        else if (br == 1) {
                            dst = slot_ptr(ws, SL_QB) + off;
                            float oc[8], os[8], ow[8]; load8(dst, oc); load8(slot_ptr(ws, SL_OSLC) + off, os); load8(slot_ptr(ws, SL_OWIN) + off, ow);
                            const GAS bf16_t* VTg = (const GAS bf16_t*)VT; const float g0 = bf1(VTg[(size_t)(1408 + head) * T + tok]), g1 = bf1(VTg[(size_t)(1412 + head) * T + tok]), g2 = bf1(VTg[(size_t)(1416 + head) * T + tok]);
#pragma unroll
                            for (int j = 0; j < 8; ++j) o[j] = g0 * oc[j] + g1 * os[j] + g2 * ow[j];
                        } else {
                            dst = slot_ptr(ws, SL_QD0) + off;
                            float o0[8], o1[8], o2[8]; load8(dst, o0); load8(slot_ptr(ws, SL_QD1) + off, o1); load8(slot_ptr(ws, SL_QD2) + off, o2);
                            const GAS float* LSEg = (const GAS float*)LSE; const float l0 = LSEg[((size_t)0 * T + tok) * 4 + head], l1 = LSEg[((size_t)1 * T + tok) * 4 + head], l2 = LSEg[((size_t)2 * T + tok) * 4 + head];
                            const float mx = fmaxf(l0, fmaxf(l1, l2));
                            const float e0 = fexp2((l0 - mx) * LOG2E), e1 = fexp2((l1 - mx) * LOG2E), e2 = fexp2((l2 - mx) * LOG2E);
                            const float inv = frcp(e0 + e1 + e2);
#pragma unroll
                            for (int j = 0; j < 8; ++j) o[j] = (e0 * o0[j] + e1 * o1[j] + e2 * o2[j]) * inv;
                        }
#pragma unroll
                        for (int j = 0; j < 8; ++j) o[j] *= gt[j] * sigmoidf_(gt[j]);
                        store8(dst, o);
                        asm volatile("" ::: "memory");
                    }
                }
        } else {
            bf16_t* U = (bf16_t*)(ws + WS_U); bf16_t* Y = (bf16_t*)(ws + WS_Y);
#pragma unroll
            for (int ai = 0; ai < 2; ++ai)
#pragma unroll
                for (int m = 0; m < 4; ++m) {
                    const int tok = u.pm * 256 + ai * 128 + wr * 64 + m * 16 + fr;
#pragma unroll
                    for (int bj = 0; bj < 2; ++bj) {
                        const int col = u.pn * 256 + bj * 128 + wc * 32 + 8 * fq;
                        const a4 v0 = acc[ai][bj][m][0], v1 = acc[ai][bj][m][1];
                        float v[8] = {v0[0], v0[1], v0[2], v0[3], v1[0], v1[1], v1[2], v1[3]};
                        const size_t off = (size_t)tok * D + col;
                        if (kind == 3) store8(U + off, v);
                        else if (kind == 4) {
                            float uu[8]; load8(U + off, uu);
                            float y[8];
                            if (first) {
#pragma unroll
                                for (int j = 0; j < 8; ++j) y[j] = sigmoidf_(v[j]) * uu[j];
                            } else {
                                load8(Y + off, y);
#pragma unroll
                                for (int j = 0; j < 8; ++j) y[j] += sigmoidf_(v[j]) * uu[j];
                            }
                            store8(Y + off, y);
                        } else {
                            const f32x4 x0 = *(const GAS f32x4*)(xin + off), x1 = *(const GAS f32x4*)(xin + off + 4);
                            *(GAS f32x4*)(xout + off) = (f32x4){x0[0] + v[0], x0[1] + v[1], x0[2] + v[2], x0[3] + v[3]};
                            *(GAS f32x4*)(xout + off + 4) = (f32x4){x1[0] + v[4], x1[1] + v[5], x1[2] + v[6], x1[3] + v[7]};
                        }
                        asm volatile("" ::: "memory");
                    }
                }
        }
    }
};

DI void transpose_item(const float* W, int K, int N, bf16_t* WT, int k0, int n0, int sc, LAS float* scr, int lane) {
    const int sc4 = __shfl(sc, 4 * (lane & 7));
#pragma unroll
    for (int i = 0; i < 8; ++i) {
        const int kk = 8 * i + (lane >> 3);
        const f32x4 w = sc4 >= 0 ? *(const GAS f32x4*)(W + (size_t)(k0 + kk) * N + sc4) : (f32x4){0.f, 0.f, 0.f, 0.f};
        LAS float* d = scr + kk * 33 + 4 * (lane & 7);
        d[0] = w.x; d[1] = w.y; d[2] = w.z; d[3] = w.w;
    }
    asm volatile("s_waitcnt lgkmcnt(0)" ::: "memory");
    const int c = lane & 7;
#pragma unroll
    for (int j = 0; j < 4; ++j) { const int n = (lane >> 3) + 8 * j; const LAS float* s = scr + (8 * c) * 33 + n;
        u32x4 o; o.x = pk2(s[0 * 33], s[1 * 33]); o.y = pk2(s[2 * 33], s[3 * 33]); o.z = pk2(s[4 * 33], s[5 * 33]); o.w = pk2(s[6 * 33], s[7 * 33]);
        *(GAS u32x4*)(WT + (size_t)(n0 + n) * K + k0 + 8 * c) = o; }
    asm volatile("s_waitcnt lgkmcnt(0)" ::: "memory");
}
DI int src_qk(int n) {
    const int tile = n >> 8, hs = (n >> 6) & 3, g = (n >> 3) & 7, e = n & 7, d = 4 * g + (e & 3) + 32 * (e >> 2);
    int base;
    switch (tile) {
        case 0: base = A_Q + 64 * hs; break; case 1: base = A_K + 64 * hs; break; case 2: base = B_Q + 64 * hs; break;
        case 3: base = hs == 0 ? B_KC : hs == 1 ? B_VC : hs == 2 ? B_KS : B_KW; break;
        case 4: base = C_Q + 64 * hs; break; case 5: base = C_K + 64 * hs; break;
        case 6: case 7: case 8: base = D_Q + 256 * (tile - 6) + 64 * hs; break;
        default: base = D_K + 256 * (tile - 9) + 64 * hs; break;
    }
    return base + d;
}
DI int src_v(int n) {
    const int slot = n >> 6, d = n & 63;
    if (slot < 4) return A_V + 64 * slot + d;
    if (slot < 8) return C_V + 64 * (slot - 4) + d;
    if (slot < 20) return D_V + 64 * (slot - 8) + d;
    if (slot == 20) return B_VS + d;
    if (slot == 21) return B_VW + d;
    if (slot == 22 && d < 12) return B_NG + d;
    return -1;
}
DI int src_g(int n) { const int br = n >> 8, c = n & 255; return (br == 0 ? A_G : br == 1 ? B_G : br == 2 ? C_G : D_G) + c; }

DI const bf16_t* launder_vp(const bf16_t* p) { asm volatile("" : "+v"(p)); return p; }
DI int kappa(int rho) { return (rho & 16) | ((rho & 4) << 1) | ((rho & 8) >> 1) | (rho & 3); }
DI bf16x8 ldfrag(const bf16_t* p) { return *(const GAS bf16x8*)p; }
DI bf16x8 pack8(const float* p) { u32x4 w; w.x = pk2(p[0], p[1]); w.y = pk2(p[2], p[3]); w.z = pk2(p[4], p[5]); w.w = pk2(p[6], p[7]); return __builtin_bit_cast(bf16x8, w); }

#define BLK_BAR() do { asm volatile("s_waitcnt lgkmcnt(0)" ::: "memory"); __builtin_amdgcn_s_barrier(); asm volatile("" ::: "memory"); } while (0)
struct SmState { f32x16 O[2]; float m, l; };
DI void sm_init(SmState& st) {
#pragma unroll
    for (int i = 0; i < 16; ++i) { st.O[0][i] = 0.f; st.O[1][i] = 0.f; }
    st.m = MFLOOR; st.l = 0.f;
}
struct Frag { bf16x8 k[4], v[2][2]; };
DI void ld_frag(Frag& f, const bf16_t* kp, const bf16_t* v0p, const bf16_t* v1p) {
#pragma unroll
    for (int s = 0; s < 4; ++s) f.k[s] = ldfrag(kp + 16 * s);
#pragma unroll
    for (int s = 0; s < 2; ++s) { f.v[0][s] = ldfrag(v0p + 16 * s); f.v[1][s] = ldfrag(v1p + 16 * s); }
}
struct FragG { u32x4 k[4], v[4]; };
constexpr int WLDS_BYTES = 4608 + 5120;
DI void ldg(FragG& g, const bf16_t* kq, size_t kstride, const bf16_t* vq, size_t vstride) {
#pragma unroll
    for (int j = 0; j < 4; ++j) g.k[j] = *(const GAS u32x4*)(kq + (size_t)(8 * j) * kstride);
#pragma unroll
    for (int j = 0; j < 4; ++j) g.v[j] = *(const GAS u32x4*)(vq + (size_t)(16 * j) * vstride);
}
DI void stage(const FragG& g, Frag& f, LAS unsigned char* wl, int lane) {
    const int r = lane & 31, h = lane >> 5;
    LAS u32x4* kw = (LAS u32x4*)(wl + (lane >> 3) * 144 + (lane & 7) * 16);
    LAS u32x4* vw = (LAS u32x4*)(wl + 4608 + (lane >> 2) * 80 + (lane & 3) * 16);
#pragma unroll
    for (int j = 0; j < 4; ++j) kw[j * 72] = g.k[j];
#pragma unroll
    for (int j = 0; j < 4; ++j) vw[j * 80] = g.v[j];
    asm volatile("" ::: "memory");
    const LAS unsigned char* kr = wl + kappa(r) * 144 + 16 * h;
    const LAS unsigned char* vr = wl + 4608 + r * 80 + 16 * h;
#pragma unroll
    for (int s = 0; s < 4; ++s) f.k[s] = *(const LAS bf16x8*)(kr + 32 * s);
#pragma unroll
    for (int s = 0; s < 2; ++s) { f.v[0][s] = *(const LAS bf16x8*)(vr + 32 * s); f.v[1][s] = *(const LAS bf16x8*)(vr + 32 * 80 + 32 * s); }
    asm volatile("" ::: "memory");
}
template <int MASK>
DI void sm_compute(SmState& st, const bf16x8 (&qf)[4], const Frag& f, int key0, bool allow, int klo, int khi) {
    f32x16 S;
#pragma unroll
    for (int i = 0; i < 16; ++i) S[i] = 0.f;
#pragma unroll
    for (int s = 0; s < 4; ++s) S = MFMA32(f.k[s], qf[s], S);
    const float neg = NEG, mfl = MFLOOR;
    float p[16]; float mx = mfl;
#pragma unroll
    for (int i = 0; i < 16; ++i) {
        float v = S[i];
        if (MASK == 2) { const int key = key0 + 16 * (i >> 3) + (i & 7); v = (allow && key >= klo && key <= khi) ? v : neg; }
        p[i] = v; mx = fmaxf(mx, v);
    }
    if (MASK == 1) mx = allow ? mx : mfl;
    mx = hmaxf_(mx);
    const float mn = fmaxf(st.m, mx), mc = mn * SM_C;
    const float mcl = (MASK == 1 && !allow) ? sconst(INFINITY) : mc;
    const f32x2 c2 = {SM_C, SM_C}, m2 = {mcl, mcl};
    f32x2 rs2 = {0.f, 0.f};
#pragma unroll
    for (int k = 0; k < 8; ++k) {
        const f32x2 x = (f32x2){p[2 * k], p[2 * k + 1]} * c2 - m2;
        const f32x2 e = {fexp2(x.x), fexp2(x.y)};
        p[2 * k] = e.x; p[2 * k + 1] = e.y; rs2 += e;
    }
    const float rs = rs2.x + rs2.y;
    if (__ballot(mn != st.m) != 0ull) {
        const float alpha = fexp2((st.m - mn) * SM_C);
        st.l *= alpha;
#pragma unroll
        for (int i = 0; i < 16; ++i) { st.O[0][i] *= alpha; st.O[1][i] *= alpha; }
    }
    st.l += rs; st.m = mn;
    const bf16x8 pf0 = pack8(p), pf1 = pack8(p + 8);
    st.O[0] = MFMA32(f.v[0][0], pf0, st.O[0]); st.O[0] = MFMA32(f.v[0][1], pf1, st.O[0]);
    st.O[1] = MFMA32(f.v[1][0], pf0, st.O[1]); st.O[1] = MFMA32(f.v[1][1], pf1, st.O[1]);
}
DI void write_o(bf16_t* orow, const f32x16 (&O)[2], float inv, int h) {
#pragma unroll
    for (int dt = 0; dt < 2; ++dt)
#pragma unroll
        for (int g = 0; g < 4; ++g) store4(orow + 32 * dt + 8 * g + 4 * h, O[dt][4 * g] * inv, O[dt][4 * g + 1] * inv, O[dt][4 * g + 2] * inv, O[dt][4 * g + 3] * inv);
}
DI void load_q(bf16x8 (&qf)[4], const bf16_t* qrow, int h) {
#pragma unroll
    for (int s = 0; s < 4; ++s) qf[s] = ldfrag(qrow + 16 * s + 8 * h);
}

struct SmTask { const bf16_t* qrow; const bf16_t* kb; const bf16_t* vb0; bf16_t* orow; float* lse; size_t kstride; int ti_lo, ti_hi, ti_edge, bshift, klo, khi; unsigned long long need, full, allow; };
DI int sm_next(int ti, int ti_hi, int bshift, unsigned long long need) {
    int nt = ti + 1;
    while (nt <= ti_hi) { if ((need >> (nt >> bshift)) & 1ull) return nt; nt = ((nt >> bshift) + 1) << bshift; }
    return -1;
}
DI void sm_step(SmState& st, const bf16x8 (&qf)[4], const Frag& f, const SmTask& tk, int ti, int h) {
    const int blk = ti >> tk.bshift;
    const bool allow = (tk.allow >> blk) & 1ull;
    if ((ti == tk.ti_hi) || (ti == tk.ti_edge)) sm_compute<2>(st, qf, f, 32 * ti + 8 * h, allow, tk.klo, tk.khi);
    else if (!((tk.full >> blk) & 1ull)) sm_compute<1>(st, qf, f, 32 * ti + 8 * h, allow, 0, 0);
    else sm_compute<0>(st, qf, f, 32 * ti + 8 * h, true, 0, 0);
}
DI void run_sm(const SmTask& tk, int lane, LAS unsigned char* wl) {
    const int h = lane >> 5;
    bf16x8 qf[4]; load_q(qf, tk.qrow, h);
    SmState st; sm_init(st);
    int ti = sm_next(tk.ti_lo - 1, tk.ti_hi, tk.bshift, tk.need);
    FragG GA, GB; Frag F;
    ldg(GA, tk.kb + (size_t)(32 * ti) * tk.kstride, tk.kstride, tk.vb0 + 32 * ti, T);
    for (;;) {
        int nt = sm_next(ti, tk.ti_hi, tk.bshift, tk.need); int lt = nt >= 0 ? nt : ti;
        ldg(GB, tk.kb + (size_t)(32 * lt) * tk.kstride, tk.kstride, tk.vb0 + 32 * lt, T);
        __builtin_amdgcn_sched_barrier(0);
        stage(GA, F, wl, lane);
        sm_step(st, qf, F, tk, ti, h);
        if (nt < 0) break;
        ti = nt;
        nt = sm_next(ti, tk.ti_hi, tk.bshift, tk.need); lt = nt >= 0 ? nt : ti;
        ldg(GA, tk.kb + (size_t)(32 * lt) * tk.kstride, tk.kstride, tk.vb0 + 32 * lt, T);
        __builtin_amdgcn_sched_barrier(0);
        stage(GB, F, wl, lane);
        sm_step(st, qf, F, tk, ti, h);
        if (nt < 0) break;
        ti = nt;
    }
    const float lt_ = hsumf_(st.l);
    write_o(tk.orow, st.O, frcp(lt_), h);
    if (tk.lse != nullptr && h == 0) *(GAS float*)tk.lse = st.m * SM_SCALE + flog2(lt_) * LN2;
}
DI unsigned long long bits_any(unsigned long long m, int n) {
    unsigned long long r = 0ull;
    for (int j = 0; j < n; ++j) if (__ballot((m >> j) & 1ull) != 0ull) r |= 1ull << j;
    return r;
}
DI unsigned long long bits_all(unsigned long long m, int n) {
    unsigned long long r = 0ull;
    for (int j = 0; j < n; ++j) if (__ballot((m >> j) & 1ull) == ~0ull) r |= 1ull << j;
    return r;
}
DI void task_sm(unsigned char* ws, int kind, int b, int hh, int qt, int lane, LAS unsigned char* wl) {
    const int r = lane & 31, kr = lane >> 3, kc = 8 * (lane & 7), vd = lane >> 2, vc = 8 * (lane & 3);
    const bf16_t* VT = (const bf16_t*)(ws + WS_VT);
    SmTask tk;
    tk.lse = nullptr; tk.kstride = 256; tk.ti_edge = -1; tk.klo = -1; tk.ti_lo = 0;
    if (kind <= 2) {
        const int t0 = 32 * qt, t = t0 + r; const size_t row = (size_t)(b * SEQ + t) * 256 + hh * 64;
        tk.ti_hi = qt; tk.khi = t;
        if (kind == 0) {
            const int cb = t0 >> 8;
            const unsigned long long mask = ((const GAS unsigned*)(ws + WS_MMASK))[(b * 4 + hh) * SEQ + t];
            tk.qrow = slot_ptr(ws, SL_QA) + row; tk.orow = slot_ptr(ws, SL_QA) + row;
            tk.kb = slot_ptr(ws, SL_KA) + (size_t)(b * SEQ + kr) * 256 + hh * 64 + kc;
            tk.vb0 = VT + (size_t)(hh * 64 + vd) * T + b * SEQ + vc;
            tk.bshift = 3; tk.allow = mask; tk.need = bits_any(mask, cb + 1); tk.full = bits_all(mask, cb + 1);
        } else if (kind == 1) {
            const int cur = t0 >> 6;
            const unsigned long long mask = ((const GAS unsigned long long*)(ws + WS_NMASK))[b * SEQ + t];
            tk.qrow = slot_ptr(ws, SL_QBR) + row; tk.orow = slot_ptr(ws, SL_OSLC) + row;
            tk.kb = slot_ptr(ws, SL_KB4) + (size_t)(b * SEQ + kr) * 256 + 128 + kc;
            tk.vb0 = VT + (size_t)(1280 + vd) * T + b * SEQ + vc;
            tk.bshift = 1; tk.allow = mask; tk.need = bits_any(mask, cur + 1); tk.full = bits_all(mask, cur + 1);
        } else {
            tk.qrow = slot_ptr(ws, SL_QBR) + row; tk.orow = slot_ptr(ws, SL_OWIN) + row;
            tk.kb = slot_ptr(ws, SL_KB4) + (size_t)(b * SEQ + kr) * 256 + 192 + kc;
            tk.vb0 = VT + (size_t)(1344 + vd) * T + b * SEQ + vc;
            tk.bshift = 8; tk.allow = 1ull; tk.need = 1ull; tk.full = 1ull;
            tk.ti_lo = qt - 16 < 0 ? 0 : qt - 16; tk.ti_edge = qt - 16; tk.klo = t - 511;
        }
    } else {
        const int g = kind - 3, dil = g == 0 ? 1 : g == 1 ? 4 : 16, L = SEQ / dil, nsub = 128 / dil, c = qt / nsub, sq = qt - c * nsub;
        const int mq = 32 * sq + r, tok = b * SEQ + mq * dil + c;
        bf16_t* qr = slot_ptr(ws, g == 0 ? SL_QD0 : g == 1 ? SL_QD1 : SL_QD2) + (size_t)tok * 256 + hh * 64;
        tk.qrow = qr; tk.orow = qr; tk.kstride = (size_t)256 * dil;
        tk.kb = slot_ptr(ws, SL_KD0 + g) + (size_t)(b * SEQ + c) * 256 + (size_t)kr * tk.kstride + hh * 64 + kc;
        tk.vb0 = VT + (size_t)(512 + 256 * g + hh * 64 + vd) * T + b * SEQ + (g == 0 ? 0 : c * L) + vc;
        tk.lse = (float*)(ws + WS_LSE) + ((size_t)g * T + tok) * 4 + hh;
        tk.bshift = 8; tk.allow = 1ull; tk.need = 1ull; tk.full = 1ull;
        tk.ti_hi = sq; tk.ti_lo = sq - 4 < 0 ? 0 : sq - 4; tk.ti_edge = sq - 4; tk.klo = mq - 128; tk.khi = mq;
    }
    run_sm(tk, lane, wl);
}

DI void frag_from_image(Frag& f, const LAS unsigned char* img, int lane) {
    const int r = lane & 31, h = lane >> 5;
    const LAS unsigned char* kr = img + kappa(r) * 144 + 16 * h;
    const LAS unsigned char* vr = img + 4608 + r * 80 + 16 * h;
#pragma unroll
    for (int s = 0; s < 4; ++s) f.k[s] = *(const LAS bf16x8*)(kr + 32 * s);
#pragma unroll
    for (int s = 0; s < 2; ++s) { f.v[0][s] = *(const LAS bf16x8*)(vr + 32 * s); f.v[1][s] = *(const LAS bf16x8*)(vr + 32 * 80 + 32 * s); }
}
DI void run_heavy_group(unsigned char* ws, int kind, int b, int hh_in, int qg, int wave, int lane, int tid, LAS unsigned char* img) {
    const int r = lane & 31, h = lane >> 5;
    const bool packed = kind >= 1;
    const int hh = packed ? (wave & 3) : hh_in, qt = packed ? 2 * qg + (wave >> 2) : 8 * qg + wave, t0 = 32 * qt, t = t0 + r;
    const int tend = packed ? 2 * qg + 1 : 8 * qg + 7, tbeg = kind == 2 ? (2 * qg - 16 < 0 ? 0 : 2 * qg - 16) : 0;
    const size_t row = (size_t)(b * SEQ + t) * 256 + hh * 64;
    SmTask tk; tk.lse = nullptr; tk.kstride = 256; tk.ti_edge = -1; tk.klo = -1; tk.ti_lo = 0; tk.ti_hi = qt; tk.khi = t; tk.kb = nullptr; tk.vb0 = nullptr;
    const bf16_t* gp; size_t gstep; int woff;
    if (kind == 0) {
        const int cb = t0 >> 8;
        const unsigned long long mask = ((const GAS unsigned*)(ws + WS_MMASK))[(b * 4 + hh) * SEQ + t];
        tk.qrow = slot_ptr(ws, SL_QA) + row; tk.orow = slot_ptr(ws, SL_QA) + row;
        tk.bshift = 3; tk.allow = mask; tk.need = bits_any(mask, cb + 1); tk.full = bits_all(mask, cb + 1);
        if (tid < 256) { gp = slot_ptr(ws, SL_KA) + (size_t)(b * SEQ + (tid >> 3)) * 256 + hh * 64 + 8 * (tid & 7); gstep = (size_t)32 * 256; woff = (tid >> 3) * 144 + (tid & 7) * 16; }
        else { const int t2 = tid - 256; gp = (const bf16_t*)(ws + WS_VT) + (size_t)(hh * 64 + (t2 >> 2)) * T + b * SEQ + 8 * (t2 & 3); gstep = 32; woff = 4608 + (t2 >> 2) * 80 + (t2 & 3) * 16; }
    } else {
        if (kind == 1) {
            const int cur = t0 >> 6;
            const unsigned long long mask = ((const GAS unsigned long long*)(ws + WS_NMASK))[b * SEQ + t];
            tk.qrow = slot_ptr(ws, SL_QBR) + row; tk.orow = slot_ptr(ws, SL_OSLC) + row;
            tk.bshift = 1; tk.allow = mask; tk.need = bits_any(mask, cur + 1); tk.full = bits_all(mask, cur + 1);
        } else {
            tk.qrow = slot_ptr(ws, SL_QBR) + row; tk.orow = slot_ptr(ws, SL_OWIN) + row;
            tk.bshift = 8; tk.allow = 1ull; tk.need = 1ull; tk.full = 1ull;
            tk.ti_lo = qt - 16 < 0 ? 0 : qt - 16; tk.ti_edge = qt - 16; tk.klo = t - 511;
        }
        const int koff = kind == 1 ? 128 : 192, vrow = kind == 1 ? 1280 : 1344;
        if (tid < 256) { gp = slot_ptr(ws, SL_KB4) + (size_t)(b * SEQ + (tid >> 3)) * 256 + koff + 8 * (tid & 7); gstep = (size_t)32 * 256; woff = (tid >> 3) * 144 + (tid & 7) * 16; }
        else { const int t2 = tid - 256; gp = (const bf16_t*)(ws + WS_VT) + (size_t)(vrow + (t2 >> 2)) * T + b * SEQ + 8 * (t2 & 3); gstep = 32; woff = 4608 + (t2 >> 2) * 80 + (t2 & 3) * 16; }
    }
    bf16x8 qf[4]; load_q(qf, tk.qrow, h);
    SmState st; sm_init(st);
    const int sbeg = tbeg >> 1, send = tend >> 1;
    int si = sbeg;
    u32x4 a0 = *(const GAS u32x4*)(gp + gstep * (size_t)(2 * si)), a1 = *(const GAS u32x4*)(gp + gstep * (size_t)(2 * si + 1));
    *(LAS u32x4*)(img + woff) = a0; *(LAS u32x4*)(img + WLDS_BYTES + woff) = a1;
    { const int s2 = si + 1 > send ? send : si + 1; a0 = *(const GAS u32x4*)(gp + gstep * (size_t)(2 * s2)); a1 = *(const GAS u32x4*)(gp + gstep * (size_t)(2 * s2 + 1)); }
    BLK_BAR();
    Frag F;
    for (int bsel = 0;; bsel ^= 1) {
        LAS unsigned char* cur = img + bsel * (2 * WLDS_BYTES); LAS unsigned char* nxt = img + (bsel ^ 1) * (2 * WLDS_BYTES);
#pragma unroll
        for (int sub = 0; sub < 2; ++sub) {
            const int ti = 2 * si + sub;
            if (ti >= tk.ti_lo && ti <= tk.ti_hi && ((tk.need >> (ti >> tk.bshift)) & 1ull)) { frag_from_image(F, cur + sub * WLDS_BYTES, lane); sm_step(st, qf, F, tk, ti, h); }
        }
        if (si == send) break;
        *(LAS u32x4*)(nxt + woff) = a0; *(LAS u32x4*)(nxt + WLDS_BYTES + woff) = a1;
        { const int s2 = si + 2 > send ? send : si + 2; a0 = *(const GAS u32x4*)(gp + gstep * (size_t)(2 * s2)); a1 = *(const GAS u32x4*)(gp + gstep * (size_t)(2 * s2 + 1)); }
        BLK_BAR(); ++si;
    }
    const float lt_ = hsumf_(st.l);
    write_o(tk.orow, st.O, frcp(lt_), h);
}

DI void stick_compute(f32x16 (&O)[2], float& carry, const bf16x8 (&qf)[4], const Frag& f, int kt0, int t, int h) {
    f32x16 S;
#pragma unroll
    for (int i = 0; i < 16; ++i) S[i] = 0.f;
#pragma unroll
    for (int s = 0; s < 4; ++s) S = MFMA32(f.k[s], qf[s], S);
    float lsm[16], ls[16]; float sA = 0.f, sB = 0.f;
    const int key0 = kt0 + 8 * h; const float neg = NEG;
#pragma unroll
    for (int i = 0; i < 16; ++i) {
        const int key = key0 + 16 * (i >> 3) + (i & 7);
        const bool valid = key < t;
        const float z = S[i] * SM_SCALE;
        const float sp = fmaxf(z, 0.f) + flog2(1.f + fexp2(-fabsf(z) * LOG2E)) * LN2;
        lsm[i] = valid ? -sp : 0.f;
        ls[i] = valid ? z - sp : neg;
        if (i < 8) sA += lsm[i]; else sB += lsm[i];
    }
    const float pA = xhalf(sA), pB = xhalf(sB);
    const float baseB = carry + (h == 0 ? pB : 0.f), baseA = carry + sB + pB + (h == 0 ? pA : 0.f);
    float p[16]; float run = baseA;
#pragma unroll
    for (int e = 7; e >= 0; --e) { p[e] = fexp2((ls[e] + run) * LOG2E); run += lsm[e]; }
    run = baseB;
#pragma unroll
    for (int e = 15; e >= 8; --e) { p[e] = fexp2((ls[e] + run) * LOG2E); run += lsm[e]; }
    carry += (sA + sB) + (pA + pB);
    const bf16x8 pf0 = pack8(p), pf1 = pack8(p + 8);
    O[0] = MFMA32(f.v[0][0], pf0, O[0]); O[0] = MFMA32(f.v[0][1], pf1, O[0]);
    O[1] = MFMA32(f.v[1][0], pf0, O[1]); O[1] = MFMA32(f.v[1][1], pf1, O[1]);
}
DI void task_stick(unsigned char* ws, int b, int hh, int qt, int lane, LAS unsigned char* wl) {
    const int r = lane & 31, h = lane >> 5, t0 = 32 * qt, t = t0 + r;
    bf16_t* qrow = slot_ptr(ws, SL_QC) + (size_t)(b * SEQ + t) * 256 + hh * 64;
    bf16x8 qf[4]; load_q(qf, qrow, h);
    const bf16_t* kb = slot_ptr(ws, SL_KC) + (size_t)(b * SEQ + (lane >> 3)) * 256 + hh * 64 + 8 * (lane & 7);
    const bf16_t* vb0 = (const bf16_t*)(ws + WS_VT) + (size_t)(256 + hh * 64 + (lane >> 2)) * T + b * SEQ + 8 * (lane & 3);
    f32x16 O[2];
#pragma unroll
    for (int i = 0; i < 16; ++i) { O[0][i] = 0.f; O[1][i] = 0.f; }
    float carry = 0.f;
    int kt0 = t0;
    FragG GA, GB; Frag F;
    ldg(GA, kb + (size_t)kt0 * 256, 256, vb0 + kt0, T);
    for (;;) {
        int nk = kt0 - 32, lk = nk >= 0 ? nk : kt0;
        ldg(GB, kb + (size_t)lk * 256, 256, vb0 + lk, T);
        __builtin_amdgcn_sched_barrier(0);
        stage(GA, F, wl, lane);
        stick_compute(O, carry, qf, F, kt0, t, h);
        if (nk < 0 || __ballot(carry > -104.f) == 0ull) break;
        kt0 = nk; nk = kt0 - 32; lk = nk >= 0 ? nk : kt0;
        ldg(GA, kb + (size_t)lk * 256, 256, vb0 + lk, T);
        __builtin_amdgcn_sched_barrier(0);
        stage(GB, F, wl, lane);
        stick_compute(O, carry, qf, F, kt0, t, h);
        if (nk < 0 || __ballot(carry > -104.f) == 0ull) break;
        kt0 = nk;
    }
    write_o(qrow, O, 1.f, h);
}

DI void task_cmp(unsigned char* ws, int b, int qt, int lane, LAS float* imp, int hh0, int nh, bool leader) {
    const int r = lane & 31, h = lane >> 5, t0 = 32 * qt, t = t0 + r, cur = t0 >> 6;
    const int nvis = t >= 31 ? ((t - 31) >> 4) + 1 : 0;
    const int nvmax = (t0 >> 4) + 1, ntile = (nvmax + 31) >> 5;
    const bool need_imp = cur >= 16;
    if (leader) { for (int i = lane; i < 32 * 65; i += 64) imp[i] = 0.f; }
    BLK_BAR();
    const bf16_t* kb_ = (const bf16_t*)(ws + WS_KCMP) + (size_t)(b * 256 + kappa(r)) * 64 + 8 * h;
    const bf16_t* vb0_ = (const bf16_t*)(ws + WS_VCMPT) + (size_t)(b * 64 + r) * 256 + 8 * h;
    for (int hh = hh0; hh < hh0 + nh; ++hh) {
        const bf16_t* kb = launder_vp(kb_); const bf16_t* vb0 = launder_vp(vb0_); const bf16_t* vb1 = vb0 + 32 * 256;
        bf16_t* qrow = slot_ptr(ws, SL_QB) + (size_t)(b * SEQ + t) * 256 + hh * 64;
        bf16x8 qf[4]; load_q(qf, qrow, h);
        float m = MFLOOR, l = 0.f;
        bf16x8 kn[4];
#pragma unroll
        for (int s = 0; s < 4; ++s) kn[s] = ldfrag(kb + 16 * s);
        for (int tl = 0; tl < ntile; ++tl) {
            bf16x8 kf[4];
#pragma unroll
            for (int s = 0; s < 4; ++s) kf[s] = kn[s];
            const int nl = tl + 1 < ntile ? tl + 1 : tl;
#pragma unroll
            for (int s = 0; s < 4; ++s) kn[s] = ldfrag(kb + (size_t)(32 * nl) * 64 + 16 * s);
            f32x16 S;
#pragma unroll
            for (int i = 0; i < 16; ++i) S[i] = 0.f;
#pragma unroll
            for (int s = 0; s < 4; ++s) S = MFMA32(kf[s], qf[s], S);
            const float neg = NEG; float mx = MFLOOR;
#pragma unroll
            for (int i = 0; i < 16; ++i) { const int key = 32 * tl + 8 * h + 16 * (i >> 3) + (i & 7); const float v = key < nvis ? S[i] : neg; S[i] = v; mx = fmaxf(mx, v); }
            mx = hmaxf_(mx);
            const float mn = fmaxf(m, mx), mc = mn * SM_C;
            float rs = 0.f;
#pragma unroll
            for (int i = 0; i < 16; ++i) rs += fexp2(S[i] * SM_C - mc);
            l = l * fexp2((m - mn) * SM_C) + rs; m = mn;
        }
        const float lt = hsumf_(l);
        const float inv = nvis > 0 ? frcp(lt) : 0.f, mc = m * SM_C;
        f32x16 O[2];
#pragma unroll
        for (int i = 0; i < 16; ++i) { O[0][i] = 0.f; O[1][i] = 0.f; }
        Frag fn; ld_frag(fn, kb, vb0, vb1);
        for (int tl = 0; tl < ntile; ++tl) {
            bf16x8 kf[4], vf[2][2];
#pragma unroll
            for (int s = 0; s < 4; ++s) kf[s] = fn.k[s];
#pragma unroll
            for (int s = 0; s < 2; ++s) { vf[0][s] = fn.v[0][s]; vf[1][s] = fn.v[1][s]; }
            const int nl = tl + 1 < ntile ? tl + 1 : tl;
            ld_frag(fn, kb + (size_t)(32 * nl) * 64, vb0 + 32 * nl, vb1 + 32 * nl);
            f32x16 S;
#pragma unroll
            for (int i = 0; i < 16; ++i) S[i] = 0.f;
#pragma unroll
            for (int s = 0; s < 4; ++s) S = MFMA32(kf[s], qf[s], S);
            float p[16];
#pragma unroll
            for (int i = 0; i < 16; ++i) { const int key = 32 * tl + 8 * h + 16 * (i >> 3) + (i & 7); p[i] = key < nvis ? fexp2(S[i] * SM_C - mc) * inv : 0.f; }
            if (need_imp) {
#pragma unroll
                for (int a = 0; a < 2; ++a) {
                    const int u = 4 * tl + 2 * a + h; const float* q = p + 8 * a;
                    LAS float* row = imp + r * 65 + 2 * u;
                    atomicAdd((float*)(row + 0), (q[0] + q[1]) + (q[2] + q[3]));
                    atomicAdd((float*)(row + 1), (q[3] + q[4]) + (q[5] + q[6]) + q[7]);
                    if (2 * u + 2 < 64) atomicAdd((float*)(row + 2), q[7]);
                }
            }
            const bf16x8 pf0 = pack8(p), pf1 = pack8(p + 8);
            O[0] = MFMA32(vf[0][0], pf0, O[0]); O[0] = MFMA32(vf[0][1], pf1, O[0]);
            O[1] = MFMA32(vf[1][0], pf0, O[1]); O[1] = MFMA32(vf[1][1], pf1, O[1]);
        }
        write_o(qrow, O, 1.f, h);
    }
    asm volatile("s_waitcnt lgkmcnt(0)" ::: "memory");
    BLK_BAR();
    if (leader) {
        unsigned long long mask;
        if (cur <= 15) mask = (2ull << cur) - 1ull;
        else {
            float v[32];
#pragma unroll
            for (int i = 0; i < 32; ++i) v[i] = imp[r * 65 + 2 * i + h];
            mask = 1ull | (1ull << cur) | (1ull << (cur - 1));
            for (int k = 0; k < 13; ++k) {
                float best = -1.f; int bj = 64;
#pragma unroll
                for (int i = 0; i < 32; ++i) { const int j = 2 * i + h; const bool ok = j >= 1 && j <= cur - 2 && !((mask >> j) & 1ull); if (ok && v[i] > best) { best = v[i]; bj = j; } }
                const float ob = xhalf(best); const int oj = __shfl_xor(bj, 32);
                if (ob > best || (ob == best && oj < bj)) { best = ob; bj = oj; }
                if (bj < 64) mask |= 1ull << bj;
            }
        }
        if (lane < 32) ((GAS unsigned long long*)(ws + WS_NMASK))[b * SEQ + t] = mask;
    }
    asm volatile("s_waitcnt lgkmcnt(0)" ::: "memory");
}

DI void task_moba_gate(unsigned char* ws, int b, int hh, int qt, int lane) {
    const int r = lane & 31, h = lane >> 5, t0 = 32 * qt, t = t0 + r, cb = t0 >> 8;
    unsigned sel = 0u;
    if (cb <= 3) sel = (1u << cb) - 1u;
    else {
        const bf16_t* qrow = slot_ptr(ws, SL_QA) + (size_t)(b * SEQ + t) * 256 + hh * 64 + 32 * h;
        float q[32];
#pragma unroll
        for (int j = 0; j < 4; ++j) { float f[8]; load8(qrow + 8 * j, f);
#pragma unroll
            for (int e = 0; e < 8; ++e) q[8 * j + e] = f[e]; }
        const GAS float* km = (const GAS float*)(ws + WS_KMEAN) + (size_t)((b * 4 + hh) * 16) * 64 + 32 * h;
        float gate[16];
#pragma unroll
        for (int n = 0; n < 16; ++n) {
            float s = 0.f;
            if (n < cb) {
#pragma unroll
                for (int d = 0; d < 32; ++d) s += q[d] * km[n * 64 + d];
            }
            s += xhalf(s);
            gate[n] = n < cb ? s : sconst(-INFINITY);
        }
#pragma unroll
        for (int k = 0; k < 3; ++k) {
            float best = sconst(-INFINITY); int bi = -1;
#pragma unroll
            for (int n = 0; n < 16; ++n) if (!((sel >> n) & 1u) && gate[n] > best) { best = gate[n]; bi = n; }
            if (bi >= 0) sel |= 1u << bi;
        }
    }
    if (lane < 32) ((GAS unsigned*)(ws + WS_MMASK))[(b * 4 + hh) * SEQ + t] = sel | (1u << cb);
}

DI void task_kmean(unsigned char* ws, int b, int hh, int blk, int lane) {
    const bf16_t* kp = slot_ptr(ws, SL_KA) + (size_t)(b * SEQ + 256 * blk + (lane >> 3)) * 256 + hh * 64 + 8 * (lane & 7);
    float s[8];
#pragma unroll
    for (int e = 0; e < 8; ++e) s[e] = 0.f;
#pragma unroll 8
    for (int i = 0; i < 32; ++i) { float f[8]; load8(kp + (size_t)(8 * i) * 256, f);
#pragma unroll
        for (int e = 0; e < 8; ++e) s[e] += f[e]; }
#pragma unroll
    for (int e = 0; e < 8; ++e) { s[e] += __shfl_xor(s[e], 8); s[e] += __shfl_xor(s[e], 16); s[e] += __shfl_xor(s[e], 32); }
    if (lane < 8) {
        GAS float* o = (GAS float*)(ws + WS_KMEAN) + ((b * 4 + hh) * 16 + blk) * 64 + 8 * lane;
#pragma unroll
        for (int e = 0; e < 8; ++e) o[e] = s[e] * (1.f / 256.f);
    }
}

DI void task_mlp_block(unsigned char* ws, int kv, int b, int rt, int wave, int lane, LAS float* part) {
    const int r = lane & 31, h = lane >> 5, n = 32 * rt + r, ne = n > 254 ? 254 : n;
    const bf16_t* xp = slot_ptr(ws, SL_KB4) + (size_t)(b * SEQ + 16 * ne) * 256 + kv * 64 + 8 * h;
    const bf16_t* w1 = (const bf16_t*)(ws + WS_W1T) + (size_t)(kv * 256 + 32 * wave + kappa(r)) * 2048 + 8 * h;
    f32x16 acc;
#pragma unroll
    for (int i = 0; i < 16; ++i) acc[i] = 0.f;
    bf16x8 xa[4], wa[4], xb[4], wb[4];
#pragma unroll
    for (int s = 0; s < 4; ++s) { xa[s] = ldfrag(xp + 16 * s); wa[s] = ldfrag(w1 + 16 * s); }
    for (int l = 0; l < 32; l += 2) {
#pragma unroll
        for (int s = 0; s < 4; ++s) { xb[s] = ldfrag(xp + (size_t)(l + 1) * 256 + 16 * s); wb[s] = ldfrag(w1 + 64 * (l + 1) + 16 * s); }
#pragma unroll
        for (int s = 0; s < 4; ++s) acc = MFMA32(wa[s], xa[s], acc);
        const int l2 = l + 2 < 32 ? l + 2 : l;
#pragma unroll
        for (int s = 0; s < 4; ++s) { xa[s] = ldfrag(xp + (size_t)l2 * 256 + 16 * s); wa[s] = ldfrag(w1 + 64 * l2 + 16 * s); }
#pragma unroll
        for (int s = 0; s < 4; ++s) acc = MFMA32(wb[s], xb[s], acc);
    }
    const GAS float* bias = (const GAS float*)(ws + WS_BIAS) + kv * 256 + 32 * wave;
    const bf16_t* w2 = (const bf16_t*)(ws + WS_W2T) + (size_t)(kv * 64 + r) * 256 + 32 * wave + 8 * h;
    float g[16];
#pragma unroll
    for (int i = 0; i < 16; ++i) {
        const float x = acc[i] + bias[16 * (i >> 3) + 8 * h + (i & 7)];
        const float y = 0.7978845608028654f * (x + 0.044715f * x * x * x);
        const float th = 1.f - 2.f * frcp(1.f + fexp2(2.f * LOG2E * y));
        g[i] = 0.5f * x * (1.f + th);
    }
    const bf16x8 pf0 = pack8(g), pf1 = pack8(g + 8);
    f32x16 out[2];
#pragma unroll
    for (int i = 0; i < 16; ++i) { out[0][i] = 0.f; out[1][i] = 0.f; }
#pragma unroll
    for (int dt = 0; dt < 2; ++dt) {
        out[dt] = MFMA32(ldfrag(w2 + (size_t)(32 * dt) * 256), pf0, out[dt]);
        out[dt] = MFMA32(ldfrag(w2 + (size_t)(32 * dt) * 256 + 16), pf1, out[dt]);
    }
#pragma unroll
    for (int dt = 0; dt < 2; ++dt)
#pragma unroll
        for (int i = 0; i < 16; ++i) part[((wave * 2 + dt) * 16 + i) * 64 + lane] = out[dt][i];
    __syncthreads();
    const int dt = wave >> 2, gq = wave & 3;
    float sum[4];
#pragma unroll
    for (int e = 0; e < 4; ++e) { float a = 0.f;
#pragma unroll
        for (int w = 0; w < 8; ++w) a += part[((w * 2 + dt) * 16 + 4 * gq + e) * 64 + lane];
        sum[e] = n <= 254 ? a : 0.f; }
    const int d0 = 32 * dt + 8 * gq + 4 * h;
    if (kv == 0) store4((bf16_t*)(ws + WS_KCMP) + (size_t)(b * 256 + n) * 64 + d0, sum[0], sum[1], sum[2], sum[3]);
    else {
        bf16_t* vt = (bf16_t*)(ws + WS_VCMPT) + (size_t)(b * 64 + d0) * 256 + n;
#pragma unroll
        for (int e = 0; e < 4; ++e) ((GAS bf16_t*)vt)[e * 256] = (bf16_t)(pk2(sum[e], 0.f) & 0xffffu);
    }
    __syncthreads();
}

#define XB_TMO      128
#define XB_XCNT(j)  (256  + 64 * (j))
#define XB_XSUB(j)  (1280 + 64 * (j))
#define XB_XGEN(j)  (2304 + 64 * (j))
#define XB_TOP      3328
#define XB_TOPGEN   3392
#define XCD_BAR_WORDS 3456
#define XB_SPIN_CAP (1u << 18)

__device__ __forceinline__ unsigned xb_ld(unsigned* p)              { return __hip_atomic_load(p, __ATOMIC_RELAXED, __HIP_MEMORY_SCOPE_AGENT); }
__device__ __forceinline__ unsigned xb_add(unsigned* p, unsigned v) { return __hip_atomic_fetch_add(p, v, __ATOMIC_RELAXED, __HIP_MEMORY_SCOPE_AGENT); }
__device__ __forceinline__ unsigned xb_xcc_id() { return (unsigned)__builtin_amdgcn_s_getreg((3 << 11) | 20) & 0xFu; }
#define XB_SPIN(cond, bar) do { unsigned _sp = 0; while (cond) { __builtin_amdgcn_s_sleep(1); \
    if ((++_sp & 255u) == 0u) { if (xb_ld(&(bar)[XB_TMO])) break; if (_sp > XB_SPIN_CAP) { atomicAdd(&(bar)[XB_TMO], 1u); break; } } } } while (0)

struct XcdBarrier {
    unsigned* bar; unsigned x;
    volatile LAS unsigned* st;
};

__device__ __forceinline__ XcdBarrier xcd_barrier_post(unsigned* bar, volatile LAS unsigned* st) {
    XcdBarrier b; b.bar = bar; b.x = xb_xcc_id(); b.st = st;
    if (threadIdx.x == 0) (void)xb_add(&bar[XB_XCNT(b.x)], 1u);
    return b;
}
__device__ __forceinline__ void xcd_barrier_complete(unsigned* bar, unsigned x, unsigned& nloc, unsigned& nx) {
    const unsigned G = gridDim.x * gridDim.y * gridDim.z;
    unsigned sum, cnt, mine, sp = 0u;
    for (;;) {
        sum = 0u; cnt = 0u; mine = 0u;
#pragma unroll
        for (unsigned j = 0; j < 16; ++j) { const unsigned c = xb_ld(&bar[XB_XCNT(j)]); sum += c; cnt += (c > 0u) ? 1u : 0u; mine = (j == x) ? c : mine; }
        if (sum == G) break;
        __builtin_amdgcn_s_sleep(1);
        if ((++sp & 255u) == 0u) { if (xb_ld(&bar[XB_TMO])) break; if (sp > XB_SPIN_CAP) { atomicAdd(&bar[XB_TMO], 1u); break; } }
    }
    nloc = mine > 0u ? mine : 1u; nx = cnt > 0u ? cnt : 1u;
}

__device__ __forceinline__ void xcd_barrier(const XcdBarrier& b) {
    asm volatile("s_waitcnt vmcnt(0)" ::: "memory");
    __syncthreads();
    if (threadIdx.x == 0) {
        unsigned* bar = b.bar;
        __builtin_amdgcn_s_waitcnt(0);
        unsigned nloc = b.st[0], nx = b.st[1];
        if (nloc == 0u) { xcd_barrier_complete(bar, b.x, nloc, nx); b.st[0] = nloc; b.st[1] = nx; }
        const unsigned old = xb_add(&bar[XB_XSUB(b.x)], 1u);
        const unsigned gen = old / nloc;
        if (old + 1u == (gen + 1u) * nloc) {
            __builtin_amdgcn_fence(__ATOMIC_RELEASE, "agent");
            asm volatile("s_waitcnt vmcnt(0)" ::: "memory");
            const unsigned og = xb_add(&bar[XB_TOP], 1u);
            const unsigned tg = og / nx;
            if (og + 1u == (tg + 1u) * nx) xb_add(&bar[XB_TOPGEN], 1u);
            else XB_SPIN(xb_ld(&bar[XB_TOPGEN]) == tg, bar);
            __builtin_amdgcn_fence(__ATOMIC_ACQUIRE, "agent");
            xb_add(&bar[XB_XGEN(b.x)], 1u);
            asm volatile("s_waitcnt vmcnt(0)" ::: "memory");
        } else {
            XB_SPIN(xb_ld(&bar[XB_XGEN(b.x)]) == gen, bar);
            __builtin_amdgcn_fence(__ATOMIC_ACQUIRE, "agent");
            asm volatile("s_waitcnt vmcnt(0)" ::: "memory");
        }
    }
    __syncthreads();
}

struct Args { const float* in[9]; float* out; unsigned char* ws; int pad0, pad1; };

DI int launder(int x) { asm volatile("" : "+v"(x)); return x; }
DI unsigned char* launder_p(unsigned char* p) { asm volatile("" : "+s"(p)); return (unsigned char*)(__attribute__((address_space(1))) unsigned char*)p; }
#define FRESH() const int tid = launder(tid0), lane = tid & 63, gw = blockIdx.x * NWAVES + wave; (void)gw; (void)lane; unsigned char* ws = launder_p(ws0); (void)ws;
DI int next_task(unsigned* ctr, int lane) {
    int v = 0;
    if (lane == 0) v = (int)atomicAdd(ctr, 1u);
    return __builtin_amdgcn_readfirstlane(v);
}

#ifndef PROBE_A
#define PROBE_A 0
#define PROBE_B 0
#endif
enum { ST_P0 = 0, ST_BIAS, ST_G_QK, ST_G_VT, ST_P2, ST_P3, ST_P4, ST_G_GATE, ST_G_U0, ST_G_M0, ST_G_U1, ST_G_M1, ST_G_U2, ST_G_M2, ST_G_U3, ST_G_M3, ST_G_OUT, NSTEP_LAYER };

__global__ void __launch_bounds__(NWAVES * 64, 2) mega_fwd(Args a) {
    extern __shared__ __attribute__((aligned(16))) unsigned char lds_raw[];
    cg::grid_group grid = cg::this_grid();
    LAS unsigned char* lds = (LAS unsigned char*)lds_raw;
    const int tid0 = threadIdx.x, wave = __builtin_amdgcn_readfirstlane(tid0 >> 6);
    const int G = gridDim.x, NGW = G * NWAVES;
    unsigned char* ws0 = a.ws;

    volatile LAS unsigned* xst = (volatile LAS unsigned*)(lds + 131072 + 64);
    if (threadIdx.x == 0) { xst[0] = 0u; xst[1] = 0u; }
    __syncthreads();
    XcdBarrier xb; xb.bar = (unsigned*)(ws0 + WS_CTL + CTL_BAR); xb.x = 0u; xb.st = xst;
    if (blockIdx.x == 0) { for (int i = tid0; i < CTL_BYTES / 4; i += NWAVES * 64) ((GAS unsigned*)(ws0 + WS_CTL))[i] = 0u; }
    { FRESH();
    for (int e = blockIdx.x * (NWAVES * 64) + tid; e < SEQ * 32; e += G * NWAVES * 64) {
        const int pos = e >> 5, i = e & 31;
        const float inv = (float)exp2(-(double)i * (13.287712379549449 / 32.0));
        const float ang = (float)pos * inv;
        const double x = (double)ang, kq = rint(x * 0.6366197723675814);
        const double rr = (x - kq * 1.5707963267948966) - kq * 6.123233995736766e-17, r2 = rr * rr;
        const double sn = rr * (1.0 + r2 * (-1.0 / 6 + r2 * (1.0 / 120 + r2 * (-1.0 / 5040 + r2 * (1.0 / 362880 + r2 * (-1.0 / 39916800 + r2 * (1.0 / 6227020800.0)))))));
        const double cs = 1.0 + r2 * (-0.5 + r2 * (1.0 / 24 + r2 * (-1.0 / 720 + r2 * (1.0 / 40320 + r2 * (-1.0 / 3628800 + r2 * (1.0 / 479001600 + r2 * (-1.0 / 87178291200.0)))))));
        const int qd = (int)((long long)kq & 3);
        const double s_ = qd == 0 ? sn : qd == 1 ? cs : qd == 2 ? -sn : -cs, c_ = qd == 0 ? cs : qd == 1 ? -sn : qd == 2 ? -cs : sn;
        ((float*)(ws + WS_COS))[e] = (float)c_; ((float*)(ws + WS_SIN))[e] = (float)s_;
    } }

    for (int step = 0; step <= DEPTH * NSTEP_LAYER; ++step) {
        const int layer = step / NSTEP_LAYER, ls = step - layer * NSTEP_LAYER;
#if PROBE_A || PROBE_B
        if (blockIdx.x == 0 && tid0 == 0) ((unsigned long long*)(ws0 + WS_CTL + 2048))[32] = wall_clock64();
#endif
        if (layer == DEPTH) {
            FRESH(); const float* fw = a.in[8];
#if PROBE_A || PROBE_B
            float pa = 0.f, pb = 0.f;
            { const unsigned long long* tacc = (const unsigned long long*)(ws + WS_CTL + 2048);
              for (int k = 0; k < NSTEP_LAYER; ++k) { const float ms = (float)tacc[k] * 1e-5f; if ((PROBE_B >> k) & 1) pb += 0.002f * ms; } }
#endif
            for (int m = gw; m < T; m += 4 * NGW) {
                const GAS f32x4* wr4 = (const GAS f32x4*)fw + lane;
                f32x4 v[4][4]; float ss[4]; int mr[4];
#pragma unroll
                for (int q = 0; q < 4; ++q) { mr[q] = m + q * NGW < T ? m + q * NGW : m;
#pragma unroll
                    for (int j = 0; j < 4; ++j) v[q][j] = ((const GAS f32x4*)(a.out + (size_t)mr[q] * D) + lane)[64 * j]; }
                const float eps = sconst(1e-6f);
#pragma unroll
                for (int q = 0; q < 4; ++q) { float s = 0.f;
#pragma unroll
                    for (int j = 0; j < 4; ++j) s += (v[q][j].x * v[q][j].x + v[q][j].y * v[q][j].y) + (v[q][j].z * v[q][j].z + v[q][j].w * v[q][j].w);
                    ss[q] = rsqrtf(wave_sum(s) * (1.f / D) + eps); }
#pragma unroll
                for (int j = 0; j < 4; ++j) { const f32x4 w = wr4[64 * j];
#pragma unroll
                    for (int q = 0; q < 4; ++q) { f32x4 o = (f32x4){v[q][j].x * ss[q] * w.x, v[q][j].y * ss[q] * w.y, v[q][j].z * ss[q] * w.z, v[q][j].w * ss[q] * w.w};
#if PROBE_A || PROBE_B
                        o = o + ((lane & 1) ? pb : -pb); (void)pa;
#endif
                        if (q == 0 || mr[q] != m) ((GAS f32x4*)(a.out + (size_t)mr[q] * D) + lane)[64 * j] = o; } }
            }
            break;
        }
        const float* xin = layer == 0 ? a.in[0] : a.out;
        bool sync = false;
        if (ls == ST_P0) {
            const float* norm_w = a.in[1] + (size_t)layer * D;
            const float* w_in = a.in[2] + (size_t)layer * D * INW;
            const float* cmp_pos = a.in[3] + (size_t)layer * 2 * 2048;
            const float* cmp_w1 = a.in[4] + (size_t)layer * 2 * 2048 * 256;
            const float* cmp_w2 = a.in[5] + (size_t)layer * 2 * 256 * 64;
            const float* w_up = a.in[6] + (size_t)layer * 4 * 256 * D;
            const float* w_out = a.in[7] + (size_t)layer * D * D;
            FRESH(); LAS float* scr = (LAS float*)(lds + wave * 16384); bf16_t* Hb = (bf16_t*)(ws + WS_H);
            constexpr int I_QK = 16 * (NQK / 32), I_V = 16 * (NV / 32), I_G = 16 * 32, I_M = 16 * 128, I_UP = 4 * 4 * 32, I_OUT = 16 * 32, I_W1 = 2 * 32 * 8, I_W2 = 2 * 4 * 2;
            constexpr int NITEMS = I_QK + I_V + I_G + I_M + I_UP + I_OUT + I_W1 + I_W2;
            for (int it = gw; it < NITEMS; it += NGW) {
                int q = it;
                if (q < I_QK) { const int kb = q / (NQK / 32), nb = q % (NQK / 32); transpose_item(w_in, D, INW, (bf16_t*)(ws + WS_WQK), 64 * kb, 32 * nb, src_qk(32 * nb + (lane & 31)), scr, lane); continue; } q -= I_QK;
                if (q < I_V) { const int kb = q / (NV / 32), nb = q % (NV / 32); transpose_item(w_in, D, INW, (bf16_t*)(ws + WS_WV), 64 * kb, 32 * nb, src_v(32 * nb + (lane & 31)), scr, lane); continue; } q -= I_V;
                if (q < I_G) { const int kb = q / 32, nb = q % 32; transpose_item(w_in, D, INW, (bf16_t*)(ws + WS_WG), 64 * kb, 32 * nb, src_g(32 * nb + (lane & 31)), scr, lane); continue; } q -= I_G;
                if (q < I_M) { const int kb = q / 128, nb = q % 128; transpose_item(w_in, D, INW, (bf16_t*)(ws + WS_WM), 64 * kb, 32 * nb, MRG + 32 * nb + (lane & 31), scr, lane); continue; } q -= I_M;
                if (q < I_UP) { const int br = q / 128, q2 = q % 128, kb = q2 / 32, nb = q2 % 32; transpose_item(w_up + (size_t)br * 256 * D, 256, D, (bf16_t*)(ws + WS_WUP) + (size_t)br * D * 256, 64 * kb, 32 * nb, 32 * nb + (lane & 31), scr, lane); continue; } q -= I_UP;
                if (q < I_OUT) { const int kb = q / 32, nb = q % 32; transpose_item(w_out, D, D, (bf16_t*)(ws + WS_WOUT), 64 * kb, 32 * nb, 32 * nb + (lane & 31), scr, lane); continue; } q -= I_OUT;
                if (q < I_W1) { const int kv = q / 256, q2 = q % 256, kb = q2 / 8, nb = q2 % 8; transpose_item(cmp_w1 + (size_t)kv * 2048 * 256, 2048, 256, (bf16_t*)(ws + WS_W1T) + (size_t)kv * 256 * 2048, 64 * kb, 32 * nb, 32 * nb + (lane & 31), scr, lane); continue; } q -= I_W1;
                { const int kv = q / 8, q2 = q % 8, kb = q2 / 2, nb = q2 % 2; transpose_item(cmp_w2 + (size_t)kv * 256 * 64, 256, 64, (bf16_t*)(ws + WS_W2T) + (size_t)kv * 64 * 256, 64 * kb, 32 * nb, 32 * nb + (lane & 31), scr, lane); }
            }
            for (int it = gw; it < 2 * 4 * 32; it += NGW) {
                const int ch = it & 31, hg = (it >> 5) & 3, kv = it >> 7;
                const float* w1 = cmp_w1 + (size_t)kv * 2048 * 256 + (size_t)(64 * ch) * 256 + 64 * hg + lane; const float* pe = cmp_pos + kv * 2048 + 64 * ch;
                float s = 0.f;
#pragma unroll 8
                for (int f = 0; f < 64; ++f) s += pe[f] * w1[(size_t)f * 256];
                ((float*)(ws + WS_BIASP))[(ch * 2 + kv) * 256 + 64 * hg + lane] = s;
            }
            for (int m = gw; m < T; m += 2 * NGW) {
                const int m1 = m + NGW < T ? m + NGW : m;
                const GAS f32x4* xr0 = (const GAS f32x4*)(xin + (size_t)m * D) + lane; const GAS f32x4* xr1 = (const GAS f32x4*)(xin + (size_t)m1 * D) + lane; const GAS f32x4* wr4 = (const GAS f32x4*)norm_w + lane;
                f32x4 v0[4], v1[4]; float s0 = 0.f, s1 = 0.f;
#pragma unroll
                for (int j = 0; j < 4; ++j) { v0[j] = xr0[64 * j]; v1[j] = xr1[64 * j]; }
#pragma unroll
                for (int j = 0; j < 4; ++j) { s0 += (v0[j].x * v0[j].x + v0[j].y * v0[j].y) + (v0[j].z * v0[j].z + v0[j].w * v0[j].w); s1 += (v1[j].x * v1[j].x + v1[j].y * v1[j].y) + (v1[j].z * v1[j].z + v1[j].w * v1[j].w); }
                const float eps = sconst(1e-6f);
                const float rs0 = rsqrtf(wave_sum(s0) * (1.f / D) + eps), rs1 = rsqrtf(wave_sum(s1) * (1.f / D) + eps);
                GAS u32x2* o80 = (GAS u32x2*)(Hb + (size_t)m * D) + lane; GAS u32x2* o81 = (GAS u32x2*)(Hb + (size_t)m1 * D) + lane;
#pragma unroll
                for (int j = 0; j < 4; ++j) { const f32x4 w = wr4[64 * j]; u32x2 o0, o1;
                    o0.x = pk2(v0[j].x * rs0 * w.x, v0[j].y * rs0 * w.y); o0.y = pk2(v0[j].z * rs0 * w.z, v0[j].w * rs0 * w.w);
                    o1.x = pk2(v1[j].x * rs1 * w.x, v1[j].y * rs1 * w.y); o1.y = pk2(v1[j].z * rs1 * w.z, v1[j].w * rs1 * w.w);
                    o80[64 * j] = o0; if (m1 != m) o81[64 * j] = o1; }
            }
            sync = true;
        } else if (ls == ST_BIAS) {
            FRESH();
            if (blockIdx.x == 0) { float s = 0.f; for (int c = 0; c < 32; ++c) s += ((const float*)(ws + WS_BIASP))[c * 512 + tid]; ((float*)(ws + WS_BIAS))[tid] = s; }
        } else if (ls == ST_P2) {
        } else if (ls == ST_P3 || ls == ST_P4) {
            if (ls == ST_P3) {
                { FRESH();
                  for (int base = 0; base < 1024; base += 4 * G) {
                      const int it = base + blockIdx.x + G * (wave & 3); const int q = it < 1024 ? 1023 - it : 0;
                      task_cmp(ws, q & 7, q >> 3, lane, (LAS float*)(lds + (wave & 3) * 16384), 2 * (wave >> 2), it < 1024 ? 2 : 0, wave < 4 && it < 1024);
                  } }
                { FRESH();
                  for (int q = blockIdx.x + G * (NWAVES - 1 - wave); q < 4096; q += NGW) task_moba_gate(ws, q & 7, (q >> 3) & 3, q >> 5, lane); }
            }
            for (int pool = (ls == ST_P3 ? 0 : 2); pool < (ls == ST_P3 ? 2 : 3); ++pool) {
                FRESH();
                unsigned* ctr = (unsigned*)(ws + WS_CTL) + layer * 64 + 16 * pool;
                const int ngroups = pool == 0 ? 1024 : pool == 1 ? 1536 : 1024;
                volatile LAS int* gslot = (volatile LAS int*)(lds + 131072);
                for (;;) {
                    __syncthreads();
                    if (tid == 0) *gslot = (int)atomicAdd(ctr, 1u);
                    __syncthreads();
                    const int g = __builtin_amdgcn_readfirstlane(*gslot);
                    if (g >= ngroups) break;
                    const int lane = (int)__builtin_amdgcn_mbcnt_hi(~0u, __builtin_amdgcn_mbcnt_lo(~0u, (unsigned)launder(0))), tid = wave * 64 + lane;
                    if (pool == 2) {
                        const int lvl = 15 - (g >> 6), w = g & 63;
                        if (w < 32) run_heavy_group(ws, 0, w & 7, w >> 3, lvl, wave, lane, tid, lds);
                        else run_heavy_group(ws, 1, w & 7, 0, 4 * lvl + 3 - ((w - 32) >> 3), wave, lane, tid, lds);
                    }
                    else if (pool == 0 && g < 512) { task_stick(ws, g & 7, (g >> 3) & 3, 8 * (15 - (g >> 5)) + wave, lane, lds + wave * 16384); }
                    else {
                        if (pool == 1 && g < 512) run_heavy_group(ws, 2, g & 7, 0, 63 - (g >> 3), wave, lane, tid, lds);
                        else {
                        const int kd = pool == 0 ? 3 : 4 + ((g - 512) >> 9), w = g & 511;
                        task_sm(ws, kd, w & 7, (w >> 3) & 3, 8 * (w >> 5) + wave, lane, lds + wave * 16384);
                        }
                    }
                }
            }
            sync = true;
        } else {
            unsigned char* ws = launder_p(ws0); bf16_t* Hb = (bf16_t*)(ws + WS_H);
            pg8::Gemm g; Epi E{0, 0, ws, xin, a.out};
            if (ls == ST_G_QK) { g = pg8::Gemm{Hb, (const bf16_t*)(ws + WS_WQK), T, NQK, D}; E.kind = 0; sync = true; }
            else if (ls == ST_G_VT) { g = pg8::Gemm{(const bf16_t*)(ws + WS_WV), Hb, NV, T, D}; E.kind = 1; sync = true; }
            else if (ls == ST_G_GATE) { g = pg8::Gemm{Hb, (const bf16_t*)(ws + WS_WG), T, D, D}; E.kind = 2; sync = true; }
            else if (ls == ST_G_OUT) { g = pg8::Gemm{(const bf16_t*)(ws + WS_Y), (const bf16_t*)(ws + WS_WOUT), T, D, D}; E.kind = 5; sync = true; }
            else {
                const int k = ls - ST_G_U0, br = k >> 1;
                const int wslot = br == 0 ? SL_QA : br == 1 ? SL_QB : br == 2 ? SL_QC : SL_QD0;
                if ((k & 1) == 0) { g = pg8::Gemm{slot_ptr(ws, wslot), (const bf16_t*)(ws + WS_WUP) + (size_t)br * D * 256, T, D, 256}; E.kind = 3; }
                else { g = pg8::Gemm{Hb, (const bf16_t*)(ws + WS_WM) + (size_t)br * D * D, T, D, D}; E.kind = 4; E.first = (br == 0); sync = (br == 3); }
            }
            pg8::StaticOrder S; S.init(g.M, g.N, G, (int)blockIdx.x);
            if (ls == ST_G_VT) {
                FRESH();
                if (G == 256) {
                    if (blockIdx.x < 128) task_mlp_block(ws, blockIdx.x >> 6, (blockIdx.x >> 3) & 7, blockIdx.x & 7, wave, lane, (LAS float*)lds);
                    else if (blockIdx.x < 192) { const int q = (blockIdx.x - 128) * NWAVES + wave; task_kmean(ws, q >> 6, (q >> 4) & 3, q & 15, lane); }
                    S.split = 128;
                } else {
                    for (int q = gw; q < 512; q += NGW) task_kmean(ws, q >> 6, (q >> 4) & 3, q & 15, lane);
                    for (int it = blockIdx.x; it < 128; it += G) task_mlp_block(ws, it >> 6, (it >> 3) & 7, it & 7, wave, lane, (LAS float*)lds);
                }
                __syncthreads();
            }
            pg8::gemm_phase<Epi, pg8::StaticOrder, true, true>(lds, g, S, E);
        }
        if (sync) { if (step == 0) { grid.sync(); xb = xcd_barrier_post((unsigned*)(ws0 + WS_CTL + CTL_BAR), xst); } else xcd_barrier(xb); }
#if PROBE_A || PROBE_B
        if (blockIdx.x == 0 && tid0 == 0) { unsigned long long* tp = (unsigned long long*)(ws0 + WS_CTL + 2048); tp[ls] += wall_clock64() - tp[32]; }
#endif
    }
}

extern "C" void kernel_launch(void* const* d_in, const int* in_sizes, int n_in, void* d_out, int out_size, void* d_ws, size_t ws_size, hipStream_t stream) {
    static int grid = 0;
    if (grid == 0) {
        int dev = 0, cus = 0, per_cu = 0;
        hipGetDevice(&dev);
        hipDeviceGetAttribute(&cus, hipDeviceAttributeMultiprocessorCount, dev);
        hipFuncSetAttribute((const void*)mega_fwd, hipFuncAttributeMaxDynamicSharedMemorySize, LDS_BYTES);
        hipOccupancyMaxActiveBlocksPerMultiprocessor(&per_cu, (const void*)mega_fwd, NWAVES * 64, LDS_BYTES);
        (void)hipGetLastError();
        grid = cus;
        if (n_in != 9 || out_size != T * D || ws_size < WS_END || per_cu < 1) { fprintf(stderr, "kernel_launch: unexpected problem (n_in %d out %d ws %zu per_cu %d)\n", n_in, out_size, ws_size, per_cu); grid = -1; }
    }
    if (grid < 0) return;
    Args a{};
    for (int i = 0; i < 9; ++i) a.in[i] = (const float*)d_in[i];
    a.out = (float*)d_out; a.ws = (unsigned char*)d_ws;
    void* args[] = {&a};
    hipError_t e = hipLaunchCooperativeKernel((const void*)mega_fwd, dim3(grid), dim3(NWAVES * 64), args, LDS_BYTES, stream);
    if (e != hipSuccess) fprintf(stderr, "cooperative launch failed: %s\n", hipGetErrorString(e));
}
```
